# Optimizing an MI355X kernel written in HIP

```python
import math
import jax, jax.numpy as jnp
from jax import lax
import numpy as np

D_MODEL = 2048
BATCH = 8
SEQ = 2048
DEPTH = 1

NORM_EPS = 1e-6
HG_HEADS = 16
HG_HEAD_DIM = D_MODEL // HG_HEADS
HG_WIDTH = HG_HEADS * HG_HEAD_DIM
HG_CHUNK = 32
ATT_GROUPS = ((128, 1), (512, 4), (2048, 16))
ATT_HEADS_PER_GROUP = 4
ATT_HEAD_DIM = 128
ATT_HEADS = len(ATT_GROUPS) * ATT_HEADS_PER_GROUP
ATT_WIDTH = ATT_HEADS * ATT_HEAD_DIM
ATT_OUT_WIDTH = ATT_HEADS_PER_GROUP * ATT_HEAD_DIM
ATT_BLOCK = 128
REL_BUCKETS = 32
REL_MAX_DIST = 2048
IN_SPLITS = (HG_WIDTH, HG_WIDTH, HG_WIDTH, HG_WIDTH, ATT_WIDTH, ATT_WIDTH, ATT_WIDTH, D_MODEL, D_MODEL)
IN_WIDTH = sum(IN_SPLITS)
MOE_GROUPS = 8
MOE_EXPERTS_PER_GROUP = 8
MOE_EXPERTS = MOE_GROUPS * MOE_EXPERTS_PER_GROUP
MOE_TOPK = 2
MOE_FF = 512
MOE_BLOCK = 128

kernel_name = "hybrid_hgrn2_dilated_attn_hiermoe"


def rms_norm(x, gain):
    xf = x.astype(jnp.float32)
    y = xf * lax.rsqrt(jnp.mean(xf * xf, axis=-1, keepdims=True) + NORM_EPS)
    return (y * gain.astype(jnp.float32)).astype(x.dtype)


def hgrn2(q, f_pre, i_in, g, lower_bound, norm_gain):
    B, S, _ = q.shape
    H, E, C = HG_HEADS, HG_HEAD_DIM, HG_CHUNK
    nc = S // C
    f = lower_bound + (1.0 - lower_bound) * jax.nn.sigmoid(f_pre.astype(jnp.float32))
    log_f = jnp.log(f)
    k = 1.0 - f

    def chunks(t):
        return t.astype(jnp.float32).reshape(B, nc, C, H, E).transpose(1, 0, 3, 2, 4)

    causal = jnp.tril(jnp.ones((C, C), dtype=bool))

    def step(state, inp):
        qc, kc, vc, lc = inp
        b = jnp.cumsum(lc, axis=2)
        o_inter = jnp.einsum("bhtk,bhkv->bhtv", qc * jnp.exp(b), state)
        diff = b[:, :, :, None, :] - b[:, :, None, :, :]
        decay = jnp.exp(jnp.where(causal[:, :, None], diff, -jnp.inf))
        scores = jnp.einsum("bhtk,bhsk,bhtsk->bhts", qc, kc, decay)
        o_intra = jnp.einsum("bhts,bhsv->bhtv", scores, vc)
        b_last = b[:, :, -1]
        state = jnp.exp(b_last)[..., None] * state + jnp.einsum(
            "bhsk,bhsv->bhkv", kc * jnp.exp(b_last[:, :, None] - b), vc)
        return state, o_inter + o_intra

    s0 = jnp.zeros((B, H, E, E), jnp.float32)
    _, o = lax.scan(step, s0, (chunks(q), chunks(k), chunks(i_in), chunks(log_f)))
    o = o.transpose(1, 0, 3, 2, 4).reshape(B, S, H, E)
    o = o * lax.rsqrt(jnp.mean(o * o, axis=-1, keepdims=True) + NORM_EPS)
    o = o.reshape(B, S, H * E) * norm_gain.astype(jnp.float32) * jax.nn.sigmoid(g.astype(jnp.float32))
    return o.astype(q.dtype)


def t5_bucket(dist):
    exact = REL_BUCKETS // 2
    d_f = jnp.maximum(dist, 1).astype(jnp.float32)
    log_b = exact + (jnp.log(d_f / exact) / math.log(REL_MAX_DIST / exact)
                     * (REL_BUCKETS - exact)).astype(jnp.int32)
    return jnp.where(dist < exact, dist, jnp.minimum(log_b, REL_BUCKETS - 1))


def dilated_group_attention(q, k, v, rel_bias, window, dilation):
    B, S, H, E = q.shape
    n_back = window // dilation
    L = S // dilation
    blk = min(ATT_BLOCK, L)
    nb = -(-L // blk)
    Lp = nb * blk

    def to_blocks(t):
        t = t.astype(jnp.float32).reshape(B, L, dilation, H, E).transpose(0, 2, 3, 1, 4)
        t = jnp.pad(t, ((0, 0), (0, 0), (0, 0), (0, Lp - L), (0, 0)))
        return t.reshape(B, dilation, H, nb, blk, E)

    def with_prev(t):
        prev = jnp.pad(t[:, :, :, :-1], ((0, 0), (0, 0), (0, 0), (1, 0), (0, 0), (0, 0)))
        return jnp.concatenate([prev, t], axis=4)

    qb = to_blocks(q)
    kc = with_prev(to_blocks(k))
    vc = with_prev(to_blocks(v))
    i = jnp.arange(blk)[:, None]
    c = jnp.arange(2 * blk)[None, :]
    delta = i + blk - c
    n = jnp.arange(nb)[:, None, None]
    valid = (delta >= 0) & (delta <= n_back) & (n * blk + c - blk >= 0)
    bias = rel_bias[t5_bucket(jnp.maximum(delta, 0) * dilation)]
    bias = jnp.transpose(bias, (2, 0, 1)).astype(jnp.float32)[:, None]
    logits = jnp.einsum("brhnqe,brhnke->brhnqk", qb, kc) * (E ** -0.5) + bias
    logits = jnp.where(valid, logits, -1e30)
    m = jnp.max(logits, axis=-1, keepdims=True)
    p = jnp.exp(logits - m)
    den = jnp.sum(p, axis=-1)
    o = jnp.einsum("brhnqk,brhnke->brhnqe", p, vc) / den[..., None]
    lse = m[..., 0] + jnp.log(den)
    o = o.reshape(B, dilation, H, Lp, E)[:, :, :, :L].transpose(0, 3, 1, 2, 4).reshape(B, S, H, E)
    lse = lse.reshape(B, dilation, H, Lp)[..., :L].transpose(0, 3, 1, 2).reshape(B, S, H)
    return o, lse


def dilated_attention(q, k, v, rel_bias):
    B, S = q.shape[:2]
    outs, lses = [], []
    for gi, (window, dilation) in enumerate(ATT_GROUPS):
        hs = slice(gi * ATT_HEADS_PER_GROUP, (gi + 1) * ATT_HEADS_PER_GROUP)
        o, lse = dilated_group_attention(q[:, :, hs], k[:, :, hs], v[:, :, hs],
                                         rel_bias[:, hs], window, dilation)
        outs.append(o)
        lses.append(lse)
    alpha = jax.nn.softmax(jnp.stack(lses, axis=0), axis=0)
    o = jnp.einsum("gbsh,gbshe->bshe", alpha, jnp.stack(outs, axis=0))
    return o.reshape(B, S, ATT_OUT_WIDTH)


def hybrid_mixer(h, w_in, lower_bound, hg_norm_gain, rel_bias, w_branch_a, w_branch_b, w_out):
    B, S, _ = h.shape
    proj = h @ w_in
    split_points = np.cumsum(IN_SPLITS)[:-1].tolist()
    q_a, f_a, i_a, g_a, q_b, k_b, v_b, gate_a, gate_b = jnp.split(proj, split_points, axis=-1)
    y_a = hgrn2(q_a, f_a, i_a, g_a, lower_bound, hg_norm_gain)
    heads = lambda t: t.reshape(B, S, ATT_HEADS, ATT_HEAD_DIM)
    y_b = dilated_attention(heads(q_b), heads(k_b), heads(v_b), rel_bias).astype(h.dtype)
    merged = jax.nn.sigmoid(gate_a) * (y_a @ w_branch_a) + jax.nn.sigmoid(gate_b) * (y_b @ w_branch_b)
    return merged @ w_out


def hierarchical_moe(h, w_rg, b_rg, w_re, b_re, w_gate, w_up, w_down):
    B, S, D = h.shape
    T = B * S
    hf = h.reshape(T, D)
    h32 = hf.astype(jnp.float32)
    lg_group = h32 @ w_rg.astype(jnp.float32) + b_rg.astype(jnp.float32)
    p_group = jax.nn.softmax(lg_group, axis=-1)
    g_sel = jnp.argmax(lg_group, axis=-1).astype(jnp.int32)
    pg = jnp.take_along_axis(p_group, g_sel[:, None], axis=-1)
    lg_exp = (h32 @ w_re.astype(jnp.float32) + b_re.astype(jnp.float32)).reshape(
        T, MOE_GROUPS, MOE_EXPERTS_PER_GROUP)
    lg_in = jnp.take_along_axis(lg_exp, g_sel[:, None, None], axis=1)[:, 0]
    top_v, top_i = lax.top_k(lg_in, MOE_TOPK)
    gate = pg * jax.nn.softmax(top_v, axis=-1)
    expert = g_sel[:, None] * MOE_EXPERTS_PER_GROUP + top_i

    A = T * MOE_TOPK
    eid = expert.reshape(A)
    tok = jnp.repeat(jnp.arange(T, dtype=jnp.int32), MOE_TOPK)
    wts = gate.reshape(A)
    order = jnp.argsort(eid)
    e_s, tok_s, w_s = eid[order], tok[order], wts[order]
    counts = jnp.bincount(eid, length=MOE_EXPERTS)
    offs = jnp.cumsum(counts) - counts
    pcounts = (counts + MOE_BLOCK - 1) // MOE_BLOCK * MOE_BLOCK
    pends = jnp.cumsum(pcounts)
    poffs = pends - pcounts
    dest = poffs[e_s] + (jnp.arange(A) - offs[e_s])
    n_blocks = -(-A // MOE_BLOCK) + MOE_EXPERTS
    P = n_blocks * MOE_BLOCK
    buf_tok = jnp.full((P,), T, jnp.int32).at[dest].set(tok_s)
    buf_w = jnp.zeros((P,), jnp.float32).at[dest].set(w_s)
    block_expert = jnp.minimum(jnp.searchsorted(pends, jnp.arange(n_blocks) * MOE_BLOCK, side="right"),
                               MOE_EXPERTS - 1).astype(jnp.int32)
    h_pad = jnp.concatenate([hf, jnp.zeros((1, D), hf.dtype)], axis=0)

    def run_block(args):
        e, tk = args
        xb = h_pad[tk]
        u = jax.nn.silu(xb @ w_gate[e]) * (xb @ w_up[e])
        return u @ w_down[e]

    y_blocks = lax.map(run_block, (block_expert, buf_tok.reshape(n_blocks, MOE_BLOCK)))
    y_rows = y_blocks.reshape(P, D) * buf_w[:, None].astype(y_blocks.dtype)
    y = jnp.zeros((T + 1, D), y_blocks.dtype).at[buf_tok].add(y_rows)
    return y[:T].reshape(B, S, D)


def setup_inputs(seed: int = 0) -> dict:
    key = jax.random.key(seed)
    ks = jax.random.split(key, 18)
    f32 = jnp.float32
    D, F, G, E = D_MODEL, MOE_FF, MOE_GROUPS, MOE_EXPERTS

    def nrm(k, shape, scale):
        return jax.random.normal(k, shape, f32) * scale

    return {
        "x": nrm(ks[0], (BATCH, SEQ, D), 1.0),
        "norm1_gain": 1.0 + nrm(ks[1], (DEPTH, D), 0.02),
        "w_in": nrm(ks[2], (DEPTH, D, IN_WIDTH), D ** -0.5),
        "hg_lb_logits": nrm(ks[3], (DEPTH + 1, HG_WIDTH), 0.5),
        "hg_norm_gain": 1.0 + nrm(ks[4], (DEPTH, HG_WIDTH), 0.02),
        "rel_bias": nrm(ks[5], (REL_BUCKETS, ATT_HEADS), 0.5),
        "w_branch_a": nrm(ks[6], (DEPTH, HG_WIDTH, D), HG_WIDTH ** -0.5),
        "w_branch_b": nrm(ks[7], (DEPTH, ATT_OUT_WIDTH, D), ATT_OUT_WIDTH ** -0.5),
        "w_out": nrm(ks[8], (DEPTH, D, D), D ** -0.5),
        "norm2_gain": 1.0 + nrm(ks[9], (DEPTH, D), 0.02),
        "w_router_group": nrm(ks[10], (DEPTH, D, G), D ** -0.5),
        "b_router_group": nrm(ks[11], (DEPTH, G), 0.01),
        "w_router_expert": nrm(ks[12], (DEPTH, D, E), D ** -0.5),
        "b_router_expert": nrm(ks[13], (DEPTH, E), 0.01),
        "w_exp_gate": nrm(ks[14], (DEPTH, E, D, F), D ** -0.5),
        "w_exp_up": nrm(ks[15], (DEPTH, E, D, F), D ** -0.5),
        "w_exp_down": nrm(ks[16], (DEPTH, E, F, D), F ** -0.5),
        "final_norm_gain": 1.0 + nrm(ks[17], (D,), 0.02),
    }


def reference(x, norm1_gain, w_in, hg_lb_logits, hg_norm_gain, rel_bias, w_branch_a, w_branch_b,
              w_out, norm2_gain, w_router_group, b_router_group, w_router_expert, b_router_expert,
              w_exp_gate, w_exp_up, w_exp_down, final_norm_gain):
    lower_bounds = jnp.cumsum(jax.nn.softmax(hg_lb_logits.astype(jnp.float32), axis=0), axis=0)
    for layer in range(DEPTH):
        h = rms_norm(x, norm1_gain[layer])
        x = x + hybrid_mixer(h, w_in[layer], lower_bounds[layer], hg_norm_gain[layer], rel_bias,
                             w_branch_a[layer], w_branch_b[layer], w_out[layer])
        h = rms_norm(x, norm2_gain[layer])
        x = x + hierarchical_moe(h, w_router_group[layer], b_router_group[layer],
                                 w_router_expert[layer], b_router_expert[layer],
                                 w_exp_gate[layer], w_exp_up[layer], w_exp_down[layer])
    return rms_norm(x, final_norm_gain)
```

```cpp
#include <hip/hip_runtime.h>
#include <cstdio>
#include <cstdint>

#ifndef MK_N_LAUNCHES
#define MK_N_LAUNCHES 12
#endif

#define DI __device__ __forceinline__
#define GAS __attribute__((address_space(1)))
#define LAS __attribute__((address_space(3)))
typedef unsigned short bf16_t;
typedef short bf16x8 __attribute__((ext_vector_type(8)));
typedef float f32x4 __attribute__((ext_vector_type(4)));
typedef unsigned u32x4 __attribute__((ext_vector_type(4)));
typedef unsigned u32x2 __attribute__((ext_vector_type(2)));

constexpr int NB = 8, SEQ = 2048, T = NB * SEQ, D = 2048;
constexpr int INW = 16896;
constexpr int NE = 64, FF = 512;
constexpr int PMAX = 49152;
constexpr float EPS = 1e-6f;
constexpr int NWAVES = 8, NTHREADS = 512;

constexpr size_t MiB = 1u << 20;
constexpr size_t WS_CTL = 0, CTL_ZERO_BYTES = 1 * MiB;
constexpr size_t WS_EID = 1 * MiB, WS_GWT = WS_EID + 256 * 1024, WS_R2 = WS_GWT + 256 * 1024;
constexpr size_t WS_ROWTOK = 2 * MiB, WS_ROWDST = WS_ROWTOK + 256 * 1024, WS_ROWW = WS_ROWDST + 256 * 1024, WS_ROWR2 = WS_ROWW + 256 * 1024;
constexpr size_t WS_LSE = 3 * MiB;
constexpr size_t WS_WA = 8 * MiB, WS_WB = 16 * MiB, WS_WOUT = 18 * MiB;
constexpr size_t WS_WIN = 32 * MiB, WS_H = 98 * MiB;
constexpr size_t WS_QA = 162 * MiB, WS_LF = 226 * MiB, WS_IA = 290 * MiB, WS_SG = 354 * MiB;
constexpr size_t WS_QB = 418 * MiB, WS_KB = 466 * MiB, WS_VT = 514 * MiB, WS_GA = 562 * MiB, WS_GB = 626 * MiB;
constexpr size_t WS_OH = 690 * MiB, WS_OG = 754 * MiB;
constexpr size_t WS_YA = 803 * MiB, WS_YB = 867 * MiB, WS_TMP = 883 * MiB, WS_MERGED = 947 * MiB, WS_END = 1011 * MiB;
constexpr size_t WS_X1 = 162 * MiB, WS_X1B = 290 * MiB, WS_WGU = 354 * MiB, WS_WD = 610 * MiB, WS_U = 738 * MiB, WS_YK = 32 * MiB;
static_assert(WS_U + (size_t)PMAX * FF * 2 <= WS_YA, "ws map");
constexpr int CW_BAR = 4096;
constexpr int CW_CNT = 16384;
constexpr int CW_FILL = 16384 + 64;

constexpr int RING_BYTES = 131072;
constexpr int LDSCTL_OFF = RING_BYTES;
constexpr int MISC_OFF = LDSCTL_OFF + 1024;
constexpr int LDS_BYTES = 147456;

DI unsigned f2bf(float f) { unsigned u = __builtin_bit_cast(unsigned, f); return (u + 0x7fffu + ((u >> 16) & 1u)) >> 16; }
DI unsigned pk2(float lo, float hi) { return f2bf(lo) | (f2bf(hi) << 16); }
DI float bflo(unsigned w) { return __builtin_bit_cast(float, w << 16); }
DI float bfhi(unsigned w) { return __builtin_bit_cast(float, w & 0xffff0000u); }
DI float bf1(bf16_t b) { return __builtin_bit_cast(float, (unsigned)b << 16); }
DI float sigmoidf_(float x) { return 1.0f / (1.0f + __expf(-x)); }
#define LDS_WAIT() asm volatile("s_waitcnt lgkmcnt(0)" ::: "memory")
#define VM_WAIT() asm volatile("s_waitcnt vmcnt(0)" ::: "memory")

namespace pg8 {
constexpr int BM = 256, BK = 64, HALF = 128, HTB = HALF * BK * 2, STAGE_BYTES = 8 * HTB, NXCD = 8, WGM = 8;
__host__ __device__ __forceinline__ int lds_byte(int r, int c) { const int st = (r >> 4) * 2 + (c >> 5), rr = r & 15, cc = c & 31, ob = rr * 64 + cc * 2; return st * 1024 + (ob ^ (((ob >> 9) & 1) << 5)); }
__host__ __device__ __forceinline__ void stage_rc(int b, int& R, int& C) { const int st = b / 1024, sb = b % 1024, swz = sb ^ (((sb >> 9) & 1) << 5); R = (st >> 1) * 16 + swz / 64; C = (st & 1) * 32 + (swz % 64) / 2; }
__host__ __device__ __forceinline__ int perm32(int rho) { const int n = rho >> 4, i = rho & 15; return 8 * (i >> 2) + 4 * n + (i & 3); }

struct Unit { int pm, pn; };
struct Gemm { const bf16_t* A; const bf16_t* Bt; int K; const int* rowtok; };

struct StaticOrder {
    int nM, nN, nwg, G, c;
    __host__ __device__ void init(int M, int N, int G_, int c_) { nM = M / BM; nN = N / BM; nwg = nM * nN; G = G_; c = c_; }
    __host__ __device__ bool next(int i, Unit& u) const {
        const long L = (long)i * G + c; if (L >= nwg) return false;
        int wgid = (int)L; { const int q = nwg / NXCD, r = nwg % NXCD, xcd = wgid % NXCD, off = wgid / NXCD; wgid = (xcd < r ? xcd * (q + 1) : r * (q + 1) + (xcd - r) * q) + off; }
        const int nig = WGM * nN, gid = wgid / nig, fm = gid * WGM, gsz = (nM - fm) < WGM ? (nM - fm) : WGM;
        u.pm = fm + ((wgid % nig) % gsz); u.pn = (wgid % nig) / gsz; return true;
    }
};
struct MoeOrder {
    const LAS int* rbe; int nrb, NT, G, vcu;
    DI bool next(int i, Unit& u) const {
        const int L = i * G + vcu; if (L >= nrb * NT) return false;
        const int rb = L / NT, pnr = L - rb * NT; u.pm = rb; u.pn = rbe[rb] * NT + pnr; return true;
    }
};

DI unsigned cvt_pk_bf16(float lo, float hi) { unsigned r; asm volatile("v_cvt_pk_bf16_f32 %0, %1, %2" : "=v"(r) : "v"(lo), "v"(hi)); return r; }

template <class Epi, class Sched, bool ALIGN_EPI, bool SP2, bool GATHER>
DI void gemm_phase(LAS unsigned char* lds, const Gemm g, const Sched& S, const Epi& E) {
    const int tid = threadIdx.x, wid = __builtin_amdgcn_readfirstlane(tid >> 6), lane = tid & 63, wr = wid >> 2, wc = wid & 3, fr = lane & 15, fq = lane >> 4;
    const int K = g.K, nt = K / BK;
    unsigned voffA[2], voffB[2]; int RA[2], CA[2];
#pragma unroll
    for (int i = 0; i < 2; ++i) { int R, C; stage_rc(tid * 16 + i * 8192, R, C); const int Rb = Epi::PERM ? ((R & ~31) + perm32(R & 31)) : R;
        voffA[i] = (unsigned)(R * K + C) * 2u; voffB[i] = (unsigned)(Rb * K + C) * 2u; RA[i] = R; CA[i] = C; }
    const size_t kstep = (size_t)(BK * 2);
    const size_t hstep = (size_t)HALF * K * 2;
    const size_t tstep = 2 * hstep;
    const size_t hstepA = GATHER ? 0 : hstep;
    const unsigned ldsw = (unsigned)wid * 1024u;
    const int aoff = lds_byte(wr * 64 + fr, fq * 8), boff = lds_byte(wc * 32 + fr, fq * 8);
#define PG8_SA(b, h) (((b) * 2 + (h)) * HTB)
#define PG8_SB(b, h) ((4 + (b) * 2 + (h)) * HTB)
#define PG8_STAGE2(bufoff, gbase, v0, v1) do { \
        __builtin_amdgcn_global_load_lds((const unsigned*)((const char*)(gbase) + (v0)), (LAS unsigned*)(lds + (bufoff) + ldsw), 16, 0, 0); \
        __builtin_amdgcn_global_load_lds((const unsigned*)((const char*)(gbase) + (v1)), (LAS unsigned*)(lds + (bufoff) + ldsw + 8192), 16, 0, 0); } while (0)
#define PG8_STAGE(bufoff, gbase, voff) PG8_STAGE2(bufoff, gbase, (voff)[0], (voff)[1])
#define PG8_LDA(dst, b, h) do { _Pragma("unroll") for (int m = 0; m < 4; ++m) _Pragma("unroll") for (int k = 0; k < 2; ++k) dst[m][k] = *(const LAS bf16x8*)(lds + PG8_SA(b, h) + aoff + m * 2048 + k * 1024); } while (0)
#define PG8_LDB(dst, b, h) do { _Pragma("unroll") for (int n = 0; n < 2; ++n) _Pragma("unroll") for (int k = 0; k < 2; ++k) dst[n][k] = *(const LAS bf16x8*)(lds + PG8_SB(b, h) + boff + n * 2048 + k * 1024); } while (0)
#define PG8_MMA(ai, bj, At, Bt) do { __builtin_amdgcn_s_setprio(1); _Pragma("unroll") for (int m = 0; m < 4; ++m) _Pragma("unroll") for (int n = 0; n < 2; ++n) _Pragma("unroll") for (int k = 0; k < 2; ++k) \
        acc[ai][bj][m][n] = __builtin_amdgcn_mfma_f32_16x16x32_bf16(Bt[n][k], At[m][k], acc[ai][bj][m][n], 0, 0, 0); __builtin_amdgcn_s_setprio(0); } while (0)
#define PG8_WAIT_V(n) asm volatile("s_waitcnt vmcnt(" #n ")" ::: "memory")
#define PG8_WAIT_L(n) asm volatile("s_waitcnt lgkmcnt(" #n ")" ::: "memory")
#define PG8_BAR __builtin_amdgcn_s_barrier()
#define PG8_SCHED __builtin_amdgcn_sched_barrier(0)
#define PG8_GATHER(u, dst) do { _Pragma("unroll") for (int _h = 0; _h < 2; ++_h) _Pragma("unroll") for (int _i = 0; _i < 2; ++_i) { \
        const int _tok = g.rowtok[(u).pm * BM + _h * HALF + RA[_i]]; dst[_h][_i] = (unsigned)(_tok * K + CA[_i]) * 2u; } } while (0)
    Unit cur, nxt; int ui = 0;
    if (!S.next(0, cur)) return;
    f32x4 acc[2][2][4][2];
#pragma unroll
    for (int a = 0; a < 2; ++a)
#pragma unroll
        for (int b = 0; b < 2; ++b)
#pragma unroll
            for (int m = 0; m < 4; ++m)
#pragma unroll
                for (int n = 0; n < 2; ++n) acc[a][b][m][n] = (f32x4){0.f, 0.f, 0.f, 0.f};
    bf16x8 At[4][2], B0[2][2], B1[2][2];
    unsigned gC[2][2], gN[2][2];
    if constexpr (GATHER) { PG8_GATHER(cur, gC); } else { gC[0][0] = voffA[0]; gC[0][1] = voffA[1]; gC[1][0] = voffA[0]; gC[1][1] = voffA[1]; }
#pragma unroll
    for (int h = 0; h < 2; ++h) { gN[h][0] = gC[h][0]; gN[h][1] = gC[h][1]; }
    const char* cA = (const char*)g.A + (GATHER ? 0 : (size_t)cur.pm * tstep); const char* cB = (const char*)g.Bt + (size_t)cur.pn * tstep;
    static_assert(SP2, "only the SP2 loop is kept in this file");
    PG8_STAGE(PG8_SB(0, 0), cB, voffB); PG8_STAGE(PG8_SB(0, 1), cB + hstep, voffB); PG8_STAGE2(PG8_SA(0, 0), cA, gC[0][0], gC[0][1]); PG8_STAGE2(PG8_SA(0, 1), cA + hstepA, gC[1][0], gC[1][1]);
    if (wr == 1) PG8_BAR;
    PG8_WAIT_V(2); PG8_BAR;
    PG8_STAGE(PG8_SB(1, 0), cB + kstep, voffB); PG8_STAGE2(PG8_SA(1, 0), cA + kstep, gC[0][0], gC[0][1]); PG8_STAGE(PG8_SB(1, 1), cB + hstep + kstep, voffB);
    PG8_WAIT_V(6); PG8_BAR;
    for (;;) {
        const bool has_next = S.next(ui + 1, nxt);
        const char* nA = (has_next && !GATHER) ? (const char*)g.A + (size_t)nxt.pm * tstep : cA; const char* nB = has_next ? (const char*)g.Bt + (size_t)nxt.pn * tstep : cB;
        if constexpr (GATHER) { if (has_next) { PG8_GATHER(nxt, gN); } else {
#pragma unroll
            for (int h = 0; h < 2; ++h) { gN[h][0] = gC[h][0]; gN[h][1] = gC[h][1]; } } }
        for (int t = 0; t < nt; t += 2) {
            const bool last = (t == nt - 2);
            const char* a1 = cA + (size_t)(t + 1) * kstep;
            const char* a2 = last ? nA : cA + (size_t)(t + 2) * kstep; const char* b2 = last ? nB : cB + (size_t)(t + 2) * kstep;
            const char* a3 = a2 + kstep; const char* b3 = b2 + kstep;
            unsigned x00 = gC[0][0], x01 = gC[0][1], x10 = gC[1][0], x11 = gC[1][1];
            if constexpr (GATHER) { if (last) { x00 = gN[0][0]; x01 = gN[0][1]; x10 = gN[1][0]; x11 = gN[1][1]; } }
            PG8_LDB(B0, 0, 0); PG8_LDB(B1, 0, 1); PG8_SCHED; PG8_LDA(At, 0, 0); PG8_STAGE2(PG8_SA(1, 1), a1 + hstepA, gC[1][0], gC[1][1]);
            PG8_WAIT_V(8); PG8_WAIT_L(0); PG8_BAR; PG8_MMA(0, 0, At, B0); PG8_MMA(0, 1, At, B1); PG8_BAR; PG8_SCHED;
            PG8_LDA(At, 0, 1); PG8_STAGE(PG8_SB(0, 0), b2, voffB); PG8_STAGE(PG8_SB(0, 1), b2 + hstep, voffB); PG8_STAGE2(PG8_SA(0, 0), a2, x00, x01);
            PG8_WAIT_V(8); PG8_WAIT_L(0); PG8_BAR; PG8_MMA(1, 0, At, B0); PG8_MMA(1, 1, At, B1); PG8_BAR; PG8_SCHED;
            PG8_LDB(B0, 1, 0); PG8_LDB(B1, 1, 1); PG8_SCHED; PG8_LDA(At, 1, 0); PG8_STAGE2(PG8_SA(0, 1), a2 + hstepA, x10, x11);
            PG8_WAIT_V(8); PG8_WAIT_L(0); PG8_BAR; PG8_MMA(0, 0, At, B0); PG8_MMA(0, 1, At, B1); PG8_BAR; PG8_SCHED;
            PG8_LDA(At, 1, 1); PG8_STAGE(PG8_SB(1, 0), b3, voffB); PG8_STAGE(PG8_SB(1, 1), b3 + hstep, voffB); PG8_STAGE2(PG8_SA(1, 0), a3, x00, x01);
            PG8_WAIT_V(8); PG8_WAIT_L(0); PG8_BAR; PG8_MMA(1, 0, At, B0); PG8_MMA(1, 1, At, B1); PG8_BAR; PG8_SCHED;
        }
        if constexpr (ALIGN_EPI) { if (wr == 0) PG8_BAR; }
        E(acc, cur, wr, wc, fr, fq);
        if (!has_next) break;
#pragma unroll
        for (int a = 0; a < 2; ++a)
#pragma unroll
            for (int b = 0; b < 2; ++b)
#pragma unroll
                for (int m = 0; m < 4; ++m)
#pragma unroll
                    for (int n = 0; n < 2; ++n) acc[a][b][m][n] = (f32x4){0.f, 0.f, 0.f, 0.f};
        cur = nxt; cA = nA; cB = nB; ++ui;
#pragma unroll
        for (int h = 0; h < 2; ++h) { gC[h][0] = gN[h][0]; gC[h][1] = gN[h][1]; }
        if constexpr (ALIGN_EPI) { if (wr == 1) PG8_BAR; }
    }
    PG8_WAIT_V(0);
    if constexpr (!ALIGN_EPI) { if (wr == 0) PG8_BAR; }
    PG8_BAR;
#undef PG8_SA
#undef PG8_SB
#undef PG8_STAGE
#undef PG8_STAGE2
#undef PG8_LDA
#undef PG8_LDB
#undef PG8_MMA
#undef PG8_WAIT_V
#undef PG8_WAIT_L
#undef PG8_BAR
#undef PG8_SCHED
#undef PG8_GATHER
}
}

#define XB_TMO      128
#define XB_XCNT(j)  (256  + 64 * (j))
#define XB_XSUB(j)  (1280 + 64 * (j))
#define XB_XGEN(j)  (2304 + 64 * (j))
#define XB_TOP      3328
#define XB_TOPGEN   3392
#define XCD_BAR_WORDS 3456
#define XB_SPIN_CAP (1u << 18)
__device__ __forceinline__ unsigned xb_ld(unsigned* p)              { return __hip_atomic_load(p, __ATOMIC_RELAXED, __HIP_MEMORY_SCOPE_AGENT); }
__device__ __forceinline__ unsigned xb_add(unsigned* p, unsigned v) { return __hip_atomic_fetch_add(p, v, __ATOMIC_RELAXED, __HIP_MEMORY_SCOPE_AGENT); }
__device__ __forceinline__ unsigned xb_xcc_id() { return (unsigned)__builtin_amdgcn_s_getreg((3 << 11) | 20) & 0xFu; }
#define XB_SPIN(cond, bar) do { unsigned _sp = 0; while (cond) { __builtin_amdgcn_s_sleep(1); \
    if ((++_sp & 255u) == 0u) { if (xb_ld(&(bar)[XB_TMO])) break; if (_sp > XB_SPIN_CAP) { atomicAdd(&(bar)[XB_TMO], 1u); break; } } } } while (0)
struct XcdBarrier { unsigned* bar; unsigned x; volatile LAS unsigned* st; };
__device__ __forceinline__ XcdBarrier xcd_barrier_post(unsigned* bar, volatile LAS unsigned* st) {
    XcdBarrier b; b.bar = bar; b.x = xb_xcc_id(); b.st = st;
    if (threadIdx.x == 0) (void)xb_add(&bar[XB_XCNT(b.x)], 1u);
    return b;
}
__device__ __forceinline__ void xcd_barrier_complete(unsigned* bar, unsigned x, unsigned& nloc, unsigned& nx) {
    const unsigned G = gridDim.x * gridDim.y * gridDim.z;
    unsigned sum, cnt, mine, sp = 0u;
    for (;;) {
        sum = 0u; cnt = 0u; mine = 0u;
#pragma unroll
        for (unsigned j = 0; j < 16; ++j) { const unsigned c = xb_ld(&bar[XB_XCNT(j)]); sum += c; cnt += (c > 0u) ? 1u : 0u; mine = (j == x) ? c : mine; }
        if (sum == G) break;
        __builtin_amdgcn_s_sleep(1);
        if ((++sp & 255u) == 0u) { if (xb_ld(&bar[XB_TMO])) break; if (sp > XB_SPIN_CAP) { atomicAdd(&bar[XB_TMO], 1u); break; } }
    }
    nloc = mine > 0u ? mine : 1u; nx = cnt > 0u ? cnt : 1u;
}
__device__ __forceinline__ void xcd_barrier(const XcdBarrier& b) {
    asm volatile("s_waitcnt vmcnt(0)" ::: "memory");
    __syncthreads();
    if (threadIdx.x == 0) {
        unsigned* bar = b.bar;
        __builtin_amdgcn_s_waitcnt(0);
        unsigned nloc = b.st[0], nx = b.st[1];
        if (nloc == 0u) { xcd_barrier_complete(bar, b.x, nloc, nx); b.st[0] = nloc; b.st[1] = nx; }
        const unsigned old = xb_add(&bar[XB_XSUB(b.x)], 1u);
        const unsigned gen = old / nloc;
        if (old + 1u == (gen + 1u) * nloc) {
            __builtin_amdgcn_fence(__ATOMIC_RELEASE, "agent");
            asm volatile("s_waitcnt vmcnt(0)" ::: "memory");
            const unsigned og = xb_add(&bar[XB_TOP], 1u);
            const unsigned tg = og / nx;
            if (og + 1u == (tg + 1u) * nx) xb_add(&bar[XB_TOPGEN], 1u);
            else XB_SPIN(xb_ld(&bar[XB_TOPGEN]) == tg, bar);
            __builtin_amdgcn_fence(__ATOMIC_ACQUIRE, "agent");
            xb_add(&bar[XB_XGEN(b.x)], 1u);
            asm volatile("s_waitcnt vmcnt(0)" ::: "memory");
        } else {
            XB_SPIN(xb_ld(&bar[XB_XGEN(b.x)]) == gen, bar);
            __builtin_amdgcn_fence(__ATOMIC_ACQUIRE, "agent");
            asm volatile("s_waitcnt vmcnt(0)" ::: "memory");
        }
    }
    __syncthreads();
}

struct Frame {
    LAS unsigned char* lds;
    int tid, lane, wave, vcu, G;
    unsigned char* ws;
    float* out;
};
struct Args { const float* in[18]; float* out; unsigned char* ws; int ph_lo, ph_hi, li, pad; };
DI float wave_sum(float v) {
#pragma unroll
    for (int o = 1; o < 64; o <<= 1) v += __shfl_xor(v, o);
    return v;
}
DI float wave_max(float v) {
#pragma unroll
    for (int o = 1; o < 64; o <<= 1) v = fmaxf(v, __shfl_xor(v, o));
    return v;
}

template <int MAP>
DI void cvt_item(const float* W, int N, int K, bf16_t* WT, const float* gain, LAS unsigned* scr, int kb, int nb, int lane) {
    const int nq = lane & 15, kr = lane >> 4, k0 = kb * 64, n0 = nb * 64;
    f32x4 v[8][2];
#pragma unroll
    for (int j = 0; j < 8; ++j)
#pragma unroll
        for (int e = 0; e < 2; ++e) v[j][e] = *(const f32x4*)(W + (size_t)(k0 + 8 * j + 2 * kr + e) * N + n0 + 4 * nq);
    if (gain) {
#pragma unroll
        for (int j = 0; j < 8; ++j) { const float g0 = gain[k0 + 8 * j + 2 * kr], g1 = gain[k0 + 8 * j + 2 * kr + 1]; v[j][0] = v[j][0] * g0; v[j][1] = v[j][1] * g1; }
    }
#pragma unroll
    for (int j = 0; j < 8; ++j)
#pragma unroll
        for (int i = 0; i < 4; ++i) scr[(4 * nq + i) * 32 + ((j ^ (nq & 7)) << 2) + kr] = pk2(v[j][0][i], v[j][1][i]);
    LDS_WAIT(); asm volatile("" ::: "memory");
#pragma unroll
    for (int jj = 0; jj < 8; ++jj) {
        const int nl = (lane >> 3) + 8 * jj, c = lane & 7;
        const u32x4 o = *(const LAS u32x4*)(scr + nl * 32 + ((c ^ ((nl >> 2) & 7)) << 2));
        const int n = n0 + nl;
        const int row = (MAP == 0) ? n : ((n >> 2) * 8 + (MAP == 2 ? 4 : 0) + (n & 3));
        *(u32x4*)(WT + (size_t)row * K + k0 + 8 * c) = o;
    }
    LDS_WAIT(); asm volatile("" ::: "memory");
}

DI void p0_prologue(Frame& F, const Args& A) {
    LAS unsigned* scr = (LAS unsigned*)(F.lds + F.wave * 8192);
    const int gw = F.vcu * NWAVES + F.wave, NGW = F.G * NWAVES;
    constexpr int I_IN = 32 * 264, I_A = 32 * 32, I_B = 8 * 32, I_O = 32 * 32;
    for (int it = gw; it < I_IN + I_A + I_B + I_O; it += NGW) {
        int r = it;
        if (r < I_IN) { cvt_item<0>(A.in[2], INW, D, (bf16_t*)(F.ws + WS_WIN), nullptr, scr, r / 264, r % 264, F.lane); continue; } r -= I_IN;
        if (r < I_A) { cvt_item<0>(A.in[6], D, D, (bf16_t*)(F.ws + WS_WA), nullptr, scr, r / 32, r % 32, F.lane); continue; } r -= I_A;
        if (r < I_B) { cvt_item<0>(A.in[7], D, 512, (bf16_t*)(F.ws + WS_WB), nullptr, scr, r / 32, r % 32, F.lane); continue; } r -= I_B;
        cvt_item<0>(A.in[8], D, D, (bf16_t*)(F.ws + WS_WOUT), nullptr, scr, r / 32, r % 32, F.lane);
    }
    const float* x = A.in[0]; const float* g1 = A.in[1]; bf16_t* H = (bf16_t*)(F.ws + WS_H);
    for (int row = gw; row < T; row += NGW) {
        const f32x4* xr = (const f32x4*)(x + (size_t)row * D) + F.lane;
        f32x4 v[8]; float ss = 0.f;
#pragma unroll
        for (int j = 0; j < 8; ++j) { v[j] = xr[64 * j]; ss += (v[j][0] * v[j][0] + v[j][1] * v[j][1]) + (v[j][2] * v[j][2] + v[j][3] * v[j][3]); }
        const float r = rsqrtf(wave_sum(ss) * (1.0f / D) + EPS);
        u32x2* o = (u32x2*)(H + (size_t)row * D) + F.lane;
#pragma unroll
        for (int j = 0; j < 8; ++j) { const f32x4 g = ((const f32x4*)g1)[F.lane + 64 * j]; u32x2 w; w.x = pk2(v[j][0] * r * g[0], v[j][1] * r * g[1]); w.y = pk2(v[j][2] * r * g[2], v[j][3] * r * g[3]); o[64 * j] = w; }
    }
}

struct EpiProj {
    static constexpr bool PERM = true;
    unsigned char* ws; const float* lbl;
    DI void operator()(const f32x4 (&acc)[2][2][4][2], const pg8::Unit& u, int wr, int wc, int fr, int fq) const {
        const int pn = u.pn, row0 = u.pm * 256 + wr * 64 + fr, cw = wc * 32 + 8 * fq;
        if (pn < 32 || pn >= 50) {
            size_t off; int tile, mode;
            if (pn < 8) { off = WS_QA; tile = pn; mode = 0; } else if (pn < 16) { off = WS_LF; tile = pn - 8; mode = 1; } else if (pn < 24) { off = WS_IA; tile = pn - 16; mode = 0; }
            else if (pn < 32) { off = WS_SG; tile = pn - 24; mode = 2; } else if (pn < 58) { off = WS_GA; tile = pn - 50; mode = 2; } else { off = WS_GB; tile = pn - 58; mode = 2; }
            bf16_t* base = (bf16_t*)(ws + off);
#pragma unroll
            for (int bj = 0; bj < 2; ++bj) {
                const int col = tile * 256 + bj * 128 + cw;
                float lb[8];
                if (mode == 1) {
#pragma unroll
                    for (int e = 0; e < 8; ++e) lb[e] = 1.0f / (1.0f + __expf(lbl[2048 + col + e] - lbl[col + e]));
                }
#pragma unroll
                for (int ai = 0; ai < 2; ++ai)
#pragma unroll
                    for (int m = 0; m < 4; ++m) {
                        const int row = row0 + ai * 128 + m * 16;
                        float v[8];
#pragma unroll
                        for (int e = 0; e < 4; ++e) { v[e] = acc[ai][bj][m][0][e]; v[4 + e] = acc[ai][bj][m][1][e]; }
                        if (mode == 1) {
#pragma unroll
                            for (int e = 0; e < 8; ++e) v[e] = __logf(lb[e] + (1.0f - lb[e]) * sigmoidf_(v[e]));
                        } else if (mode == 2) {
#pragma unroll
                            for (int e = 0; e < 8; ++e) v[e] = sigmoidf_(v[e]);
                        }
                        u32x4 w; w.x = pg8::cvt_pk_bf16(v[0], v[1]); w.y = pg8::cvt_pk_bf16(v[2], v[3]); w.z = pg8::cvt_pk_bf16(v[4], v[5]); w.w = pg8::cvt_pk_bf16(v[6], v[7]);
                        *(u32x4*)(base + (size_t)row * D + col) = w;
                    }
            }
        } else {
            const int a = pn - 32, kind = a / 6, ht = a - kind * 6;
#pragma unroll
            for (int bj = 0; bj < 2; ++bj) {
                const int head = ht * 2 + bj, sh = 2 * (head >> 2);
#pragma unroll
                for (int ai = 0; ai < 2; ++ai)
#pragma unroll
                    for (int m = 0; m < 4; ++m) {
                        const int row = row0 + ai * 128 + m * 16, b = row >> 11, s = row & 2047;
                        const int pos = ((s & ((1 << sh) - 1)) << (11 - sh)) + (s >> sh);
                        float v[8];
#pragma unroll
                        for (int e = 0; e < 4; ++e) { v[e] = acc[ai][bj][m][0][e]; v[4 + e] = acc[ai][bj][m][1][e]; }
                        if (kind < 2) {
                            const float sc = (kind == 0) ? 0.08838834764831845f : 1.0f;
                            u32x4 w; w.x = pg8::cvt_pk_bf16(v[0] * sc, v[1] * sc); w.y = pg8::cvt_pk_bf16(v[2] * sc, v[3] * sc); w.z = pg8::cvt_pk_bf16(v[4] * sc, v[5] * sc); w.w = pg8::cvt_pk_bf16(v[6] * sc, v[7] * sc);
                            bf16_t* base = (bf16_t*)(ws + (kind == 0 ? WS_QB : WS_KB));
                            *(u32x4*)(base + ((size_t)(b * 12 + head) * 2048 + pos) * 128 + cw) = w;
                        } else {
                            bf16_t* base = (bf16_t*)(ws + WS_VT) + ((size_t)(b * 12 + head) * 128 + cw) * 2048 + pos;
#pragma unroll
                            for (int e = 0; e < 8; ++e) base[(size_t)e * 2048] = (bf16_t)f2bf(v[e]);
                        }
                    }
            }
        }
    }
};

DI void p2_hgrn_simple(Frame& F, const Args& A) {
    LAS float* qs = (LAS float*)F.lds; LAS float* fs = qs + 16 * 128; LAS float* is = fs + 16 * 128; LAS float* red = is + 16 * 128;
    const bf16_t* QA = (const bf16_t*)(F.ws + WS_QA); const bf16_t* LF = (const bf16_t*)(F.ws + WS_LF); const bf16_t* IA = (const bf16_t*)(F.ws + WS_IA); bf16_t* OH = (bf16_t*)(F.ws + WS_OH);
    const int tid = F.tid, v = tid & 127, kq = __builtin_amdgcn_readfirstlane(tid >> 7), lt = tid >> 5, c4 = tid & 31;
    for (int item = F.vcu; item < 128; item += F.G) {
        const int b = item >> 4, h = item & 15;
        float S[32];
#pragma unroll
        for (int k = 0; k < 32; ++k) S[k] = 0.f;
        for (int t0 = 0; t0 < SEQ; t0 += 16) {
            {
                const size_t g = ((size_t)(b * SEQ + t0 + lt)) * D + h * 128 + 4 * c4;
                const u32x2 q2 = *(const u32x2*)(QA + g), f2 = *(const u32x2*)(LF + g), i2 = *(const u32x2*)(IA + g);
                *(LAS f32x4*)(qs + lt * 128 + 4 * c4) = (f32x4){bflo(q2.x), bfhi(q2.x), bflo(q2.y), bfhi(q2.y)};
                *(LAS f32x4*)(fs + lt * 128 + 4 * c4) = (f32x4){__expf(bflo(f2.x)), __expf(bfhi(f2.x)), __expf(bflo(f2.y)), __expf(bfhi(f2.y))};
                *(LAS f32x4*)(is + lt * 128 + 4 * c4) = (f32x4){bflo(i2.x), bfhi(i2.x), bflo(i2.y), bfhi(i2.y)};
            }
            __syncthreads();
#pragma unroll 2
            for (int t = 0; t < 16; ++t) {
                const float iv = is[t * 128 + v]; float o = 0.f;
#pragma unroll
                for (int k4 = 0; k4 < 8; ++k4) {
                    const f32x4 f = *(const LAS f32x4*)(fs + t * 128 + kq * 32 + 4 * k4), q = *(const LAS f32x4*)(qs + t * 128 + kq * 32 + 4 * k4);
#pragma unroll
                    for (int e = 0; e < 4; ++e) { float s = S[4 * k4 + e]; s = iv + f[e] * (s - iv); S[4 * k4 + e] = s; o += s * q[e]; }
                }
                red[(kq * 16 + t) * 128 + v] = o;
            }
            __syncthreads();
            {
                f32x4 s = *(const LAS f32x4*)(red + (0 * 16 + lt) * 128 + 4 * c4);
#pragma unroll
                for (int q = 1; q < 4; ++q) s = s + *(const LAS f32x4*)(red + (q * 16 + lt) * 128 + 4 * c4);
                u32x2 w; w.x = pk2(s[0], s[1]); w.y = pk2(s[2], s[3]);
                *(u32x2*)(OH + ((size_t)(b * SEQ + t0 + lt)) * D + h * 128 + 4 * c4) = w;
            }
        }
        __syncthreads();
    }
}

DI int t5_bucket(int dist) {
    if (dist < 16) return dist;
    int b = 16;
    b += (dist >= 22); b += (dist >= 30); b += (dist >= 40); b += (dist >= 54); b += (dist >= 73); b += (dist >= 99); b += (dist >= 134); b += (dist >= 182);
    b += (dist >= 246); b += (dist >= 332); b += (dist >= 450); b += (dist >= 609); b += (dist >= 825); b += (dist >= 1117); b += (dist >= 1513);
    return b;
}
DI void p3_attn_simple(Frame& F, const Args& A) {
    const bf16_t* QB = (const bf16_t*)(F.ws + WS_QB); const bf16_t* KB = (const bf16_t*)(F.ws + WS_KB); const bf16_t* VT = (const bf16_t*)(F.ws + WS_VT);
    bf16_t* OG = (bf16_t*)(F.ws + WS_OG); float* LSE = (float*)(F.ws + WS_LSE); const float* relb = A.in[5];
    LAS float* pb = (LAS float*)F.lds + F.wave * 320; LAS float* qf = pb + 192;
    const int gw = F.vcu * NWAVES + F.wave, NGW = F.G * NWAVES, lane = F.lane;
    for (int idx = gw; idx < NB * 12 * SEQ; idx += NGW) {
        const int pos = idx & 2047, bh = idx >> 11, head = bh % 12, b = bh / 12, g = head >> 2, sh = 2 * g;
        const int r = pos >> (11 - sh), l = pos & ((2048 >> sh) - 1), s = (l << sh) + r;
        { const unsigned qw = *(const unsigned*)(QB + (size_t)idx * 128 + 2 * lane); qf[2 * lane] = bflo(qw); qf[2 * lane + 1] = bfhi(qw); }
        LDS_WAIT(); asm volatile("" ::: "memory");
        float mx = -3.0e38f;
#pragma unroll 1
        for (int rr = 0; rr < 3; ++rr) {
            const int j = rr * 64 + lane; const bool valid = (j <= 128) && (j <= l);
            const bf16_t* kp = KB + (size_t)(valid ? idx - j : idx) * 128;
            float d = 0.f;
#pragma unroll
            for (int i = 0; i < 16; ++i) { const u32x4 k = *(const u32x4*)(kp + 8 * i); const f32x4 qa = *(const LAS f32x4*)(qf + 8 * i), qb = *(const LAS f32x4*)(qf + 8 * i + 4);
                d += qa[0] * bflo(k.x) + qa[1] * bfhi(k.x) + qa[2] * bflo(k.y) + qa[3] * bfhi(k.y)
                   + qb[0] * bflo(k.z) + qb[1] * bfhi(k.z) + qb[2] * bflo(k.w) + qb[3] * bfhi(k.w); }
            const float bias = relb[t5_bucket((valid ? j : 0) << sh) * 12 + head];
            const float lgv = valid ? d + bias : -3.0e38f;
            pb[rr * 64 + lane] = lgv;
            mx = fmaxf(mx, lgv);
        }
        mx = wave_max(mx);
        float den = 0.f;
#pragma unroll 1
        for (int rr = 0; rr < 3; ++rr) { const float lgv = pb[rr * 64 + lane]; const float p = (lgv > -1.0e38f) ? __expf(lgv - mx) : 0.f; den += p; pb[rr * 64 + lane] = p; }
        den = wave_sum(den);
        LDS_WAIT(); asm volatile("" ::: "memory");
        const int nk = (l < 128 ? l : 128) + 1;
        const bf16_t* v0 = VT + ((size_t)(b * 12 + head) * 128 + lane) * 2048 + pos;
        const bf16_t* v1 = v0 + (size_t)64 * 2048;
        float o0 = 0.f, o1 = 0.f;
        for (int j = 0; j < nk; ++j) { const float p = pb[j]; o0 += p * bf1(*(v0 - j)); o1 += p * bf1(*(v1 - j)); }
        const float inv = 1.0f / den;
        const size_t orow = (size_t)g * T + (size_t)b * SEQ + s;
        OG[orow * 512 + (head & 3) * 128 + lane] = (bf16_t)f2bf(o0 * inv);
        OG[orow * 512 + (head & 3) * 128 + 64 + lane] = (bf16_t)f2bf(o1 * inv);
        if (lane == 0) LSE[orow * 4 + (head & 3)] = mx + __logf(den);
        LDS_WAIT(); asm volatile("" ::: "memory");
    }
}

DI void p4_fixups(Frame& F, const Args& A) {
    const bf16_t* OH = (const bf16_t*)(F.ws + WS_OH); const bf16_t* SG = (const bf16_t*)(F.ws + WS_SG); const float* hg = A.in[4];
    const bf16_t* OG = (const bf16_t*)(F.ws + WS_OG); const float* LSE = (const float*)(F.ws + WS_LSE);
    bf16_t* YA = (bf16_t*)(F.ws + WS_YA); bf16_t* YB = (bf16_t*)(F.ws + WS_YB);
    const int gw = F.vcu * NWAVES + F.wave, NGW = F.G * NWAVES, lane = F.lane;
    for (int row = gw; row < T; row += NGW) {
#pragma unroll
        for (int j = 0; j < 4; ++j) {
            const int c0 = 512 * j + 8 * lane;
            const u32x4 o = *(const u32x4*)(OH + (size_t)row * D + c0), sg = *(const u32x4*)(SG + (size_t)row * D + c0);
            float v[8] = {bflo(o.x), bfhi(o.x), bflo(o.y), bfhi(o.y), bflo(o.z), bfhi(o.z), bflo(o.w), bfhi(o.w)};
            const float s[8] = {bflo(sg.x), bfhi(sg.x), bflo(sg.y), bfhi(sg.y), bflo(sg.z), bfhi(sg.z), bflo(sg.w), bfhi(sg.w)};
            float ss = 0.f;
#pragma unroll
            for (int e = 0; e < 8; ++e) ss += v[e] * v[e];
            ss += __shfl_xor(ss, 1); ss += __shfl_xor(ss, 2); ss += __shfl_xor(ss, 4); ss += __shfl_xor(ss, 8);
            const float rinv = rsqrtf(ss * (1.0f / 128.0f) + EPS);
            const f32x4 g0 = *(const f32x4*)(hg + c0), g1 = *(const f32x4*)(hg + c0 + 4);
#pragma unroll
            for (int e = 0; e < 4; ++e) { v[e] = v[e] * rinv * g0[e] * s[e]; v[4 + e] = v[4 + e] * rinv * g1[e] * s[4 + e]; }
            u32x4 w; w.x = pk2(v[0], v[1]); w.y = pk2(v[2], v[3]); w.z = pk2(v[4], v[5]); w.w = pk2(v[6], v[7]);
            *(u32x4*)(YA + (size_t)row * D + c0) = w;
        }
        {
            const int c0 = 8 * lane, hs = lane >> 4;
            const float l0 = LSE[((size_t)0 * T + row) * 4 + hs], l1 = LSE[((size_t)1 * T + row) * 4 + hs], l2 = LSE[((size_t)2 * T + row) * 4 + hs];
            const float mx = fmaxf(l0, fmaxf(l1, l2)); float a0 = __expf(l0 - mx), a1 = __expf(l1 - mx), a2 = __expf(l2 - mx);
            const float inv = 1.0f / (a0 + a1 + a2); a0 *= inv; a1 *= inv; a2 *= inv;
            const u32x4 x0 = *(const u32x4*)(OG + ((size_t)0 * T + row) * 512 + c0), x1 = *(const u32x4*)(OG + ((size_t)1 * T + row) * 512 + c0), x2 = *(const u32x4*)(OG + ((size_t)2 * T + row) * 512 + c0);
            u32x4 w;
            w.x = pk2(a0 * bflo(x0.x) + a1 * bflo(x1.x) + a2 * bflo(x2.x), a0 * bfhi(x0.x) + a1 * bfhi(x1.x) + a2 * bfhi(x2.x));
            w.y = pk2(a0 * bflo(x0.y) + a1 * bflo(x1.y) + a2 * bflo(x2.y), a0 * bfhi(x0.y) + a1 * bfhi(x1.y) + a2 * bfhi(x2.y));
            w.z = pk2(a0 * bflo(x0.z) + a1 * bflo(x1.z) + a2 * bflo(x2.z), a0 * bfhi(x0.z) + a1 * bfhi(x1.z) + a2 * bfhi(x2.z));
            w.w = pk2(a0 * bflo(x0.w) + a1 * bflo(x1.w) + a2 * bflo(x2.w), a0 * bfhi(x0.w) + a1 * bfhi(x1.w) + a2 * bfhi(x2.w));
            *(u32x4*)(YB + (size_t)row * 512 + c0) = w;
        }
    }
}

template <int MODE> struct EpiGate {
    static constexpr bool PERM = true;
    const bf16_t* gate; bf16_t* tmp; bf16_t* outp;
    DI void operator()(const f32x4 (&acc)[2][2][4][2], const pg8::Unit& u, int wr, int wc, int fr, int fq) const {
        const int row0 = u.pm * 256 + wr * 64 + fr, col0 = u.pn * 256 + wc * 32 + 8 * fq;
#pragma unroll
        for (int ai = 0; ai < 2; ++ai)
#pragma unroll
            for (int m = 0; m < 4; ++m)
#pragma unroll
                for (int bj = 0; bj < 2; ++bj) {
                    const size_t o = (size_t)(row0 + ai * 128 + m * 16) * D + col0 + bj * 128;
                    const u32x4 gt = *(const u32x4*)(gate + o);
                    float v[8];
#pragma unroll
                    for (int e = 0; e < 4; ++e) { v[e] = acc[ai][bj][m][0][e]; v[4 + e] = acc[ai][bj][m][1][e]; }
                    v[0] *= bflo(gt.x); v[1] *= bfhi(gt.x); v[2] *= bflo(gt.y); v[3] *= bfhi(gt.y); v[4] *= bflo(gt.z); v[5] *= bfhi(gt.z); v[6] *= bflo(gt.w); v[7] *= bfhi(gt.w);
                    if (MODE == 1) { const u32x4 tp = *(const u32x4*)(tmp + o);
                        v[0] += bflo(tp.x); v[1] += bfhi(tp.x); v[2] += bflo(tp.y); v[3] += bfhi(tp.y); v[4] += bflo(tp.z); v[5] += bfhi(tp.z); v[6] += bflo(tp.w); v[7] += bfhi(tp.w); }
                    u32x4 w; w.x = pg8::cvt_pk_bf16(v[0], v[1]); w.y = pg8::cvt_pk_bf16(v[2], v[3]); w.z = pg8::cvt_pk_bf16(v[4], v[5]); w.w = pg8::cvt_pk_bf16(v[6], v[7]);
                    *(u32x4*)((MODE == 1 ? outp : tmp) + o) = w;
                }
    }
};
struct EpiOut {
    static constexpr bool PERM = true;
    const float* x; float* x1; bf16_t* x1b;
    DI void operator()(const f32x4 (&acc)[2][2][4][2], const pg8::Unit& u, int wr, int wc, int fr, int fq) const {
        const int row0 = u.pm * 256 + wr * 64 + fr, col0 = u.pn * 256 + wc * 32 + 8 * fq;
#pragma unroll
        for (int ai = 0; ai < 2; ++ai)
#pragma unroll
            for (int m = 0; m < 4; ++m)
#pragma unroll
                for (int bj = 0; bj < 2; ++bj) {
                    const size_t o = (size_t)(row0 + ai * 128 + m * 16) * D + col0 + bj * 128;
                    const f32x4 a0 = *(const f32x4*)(x + o) + acc[ai][bj][m][0], a1 = *(const f32x4*)(x + o + 4) + acc[ai][bj][m][1];
                    *(f32x4*)(x1 + o) = a0; *(f32x4*)(x1 + o + 4) = a1;
                    u32x4 w; w.x = pg8::cvt_pk_bf16(a0[0], a0[1]); w.y = pg8::cvt_pk_bf16(a0[2], a0[3]); w.z = pg8::cvt_pk_bf16(a1[0], a1[1]); w.w = pg8::cvt_pk_bf16(a1[2], a1[3]);
                    *(u32x4*)(x1b + o) = w;
                }
    }
};

DI void p7_router(Frame& F, const Args& A) {
    const float* X1 = (const float*)(F.ws + WS_X1); const float* g2 = A.in[9]; const float* wrg = A.in[10]; const float* brg = A.in[11]; const float* wre = A.in[12]; const float* bre = A.in[13];
    int* EID = (int*)(F.ws + WS_EID); float* GWT = (float*)(F.ws + WS_GWT); float* R2 = (float*)(F.ws + WS_R2);
    unsigned* cnt = (unsigned*)(F.ws + WS_CTL) + CW_CNT;
    int* rowtok = (int*)(F.ws + WS_ROWTOK); int* rowdst = (int*)(F.ws + WS_ROWDST);
    const int gw = F.vcu * NWAVES + F.wave, NGW = F.G * NWAVES, lane = F.lane;
    for (int p = F.vcu * NTHREADS + F.tid; p < PMAX; p += F.G * NTHREADS) { rowtok[p] = 0; rowdst[p] = -1; }
    for (int row = gw; row < T; row += NGW) {
        const f32x4* xr = (const f32x4*)(X1 + (size_t)row * D) + lane;
        f32x4 v[8]; float ss = 0.f;
#pragma unroll
        for (int j = 0; j < 8; ++j) { v[j] = xr[64 * j]; ss += (v[j][0] * v[j][0] + v[j][1] * v[j][1]) + (v[j][2] * v[j][2] + v[j][3] * v[j][3]); }
        const float r = rsqrtf(wave_sum(ss) * (1.0f / D) + EPS);
#pragma unroll
        for (int j = 0; j < 8; ++j) { const f32x4 g = ((const f32x4*)g2)[lane + 64 * j]; v[j] = v[j] * r * g; }
        float a[8];
#pragma unroll
        for (int e = 0; e < 8; ++e) a[e] = 0.f;
#pragma unroll
        for (int j = 0; j < 8; ++j)
#pragma unroll
            for (int i = 0; i < 4; ++i) { const int c = 4 * lane + 256 * j + i; const f32x4 w0 = *(const f32x4*)(wrg + (size_t)c * 8), w1 = *(const f32x4*)(wrg + (size_t)c * 8 + 4); const float h = v[j][i];
#pragma unroll
                for (int e = 0; e < 4; ++e) { a[e] += h * w0[e]; a[4 + e] += h * w1[e]; }
                if (i == 3) __builtin_amdgcn_sched_barrier(0); }
        int gsel = 0; float gmax = -3.0e38f;
#pragma unroll
        for (int e = 0; e < 8; ++e) { a[e] = wave_sum(a[e]) + brg[e]; if (a[e] > gmax) { gmax = a[e]; gsel = e; } }
        float gden = 0.f;
#pragma unroll
        for (int e = 0; e < 8; ++e) gden += __expf(a[e] - gmax);
        const float pg = 1.0f / gden;
        gsel = __builtin_amdgcn_readfirstlane(gsel);
#pragma unroll
        for (int e = 0; e < 8; ++e) a[e] = 0.f;
#pragma unroll
        for (int j = 0; j < 8; ++j)
#pragma unroll
            for (int i = 0; i < 4; ++i) { const int c = 4 * lane + 256 * j + i; const f32x4 w0 = *(const f32x4*)(wre + (size_t)c * 64 + gsel * 8), w1 = *(const f32x4*)(wre + (size_t)c * 64 + gsel * 8 + 4); const float h = v[j][i];
#pragma unroll
                for (int e = 0; e < 4; ++e) { a[e] += h * w0[e]; a[4 + e] += h * w1[e]; }
                if (i == 3) __builtin_amdgcn_sched_barrier(0); }
        int i1 = 0; float v1 = -3.0e38f;
#pragma unroll
        for (int e = 0; e < 8; ++e) { a[e] = wave_sum(a[e]) + bre[gsel * 8 + e]; if (a[e] > v1) { v1 = a[e]; i1 = e; } }
        int i2 = 0; float v2 = -3.0e38f;
#pragma unroll
        for (int e = 0; e < 8; ++e) { if (e != i1 && a[e] > v2) { v2 = a[e]; i2 = e; } }
        const float e2 = __expf(v2 - v1), p1 = 1.0f / (1.0f + e2), p2 = e2 * p1;
        if (lane == 0) {
            const int ea = gsel * 8 + i1, eb = gsel * 8 + i2;
            EID[row * 2] = ea; EID[row * 2 + 1] = eb; GWT[row * 2] = pg * p1; GWT[row * 2 + 1] = pg * p2; R2[row] = r;
            atomicAdd(&cnt[ea], 1u); atomicAdd(&cnt[eb], 1u);
        }
    }
    LAS unsigned* scr = (LAS unsigned*)(F.lds + F.wave * 8192);
    constexpr int I_G = NE * 32 * 8, I_D = NE * 8 * 32;
    for (int it = gw; it < 2 * I_G + I_D; it += NGW) {
        int r_ = it;
        if (r_ < 2 * I_G) { const int up = r_ >= I_G; if (up) r_ -= I_G; const int e = r_ >> 8, rem = r_ & 255;
            const float* W = (up ? A.in[15] : A.in[14]) + (size_t)e * D * FF; bf16_t* WT = (bf16_t*)(F.ws + WS_WGU) + (size_t)e * 1024 * D;
            if (up) cvt_item<2>(W, FF, D, WT, g2, scr, rem >> 3, rem & 7, lane); else cvt_item<1>(W, FF, D, WT, g2, scr, rem >> 3, rem & 7, lane);
            continue; }
        r_ -= 2 * I_G; { const int e = r_ >> 8, rem = r_ & 255;
            cvt_item<0>(A.in[16] + (size_t)e * FF * D, D, FF, (bf16_t*)(F.ws + WS_WD) + (size_t)e * D * FF, nullptr, scr, rem >> 5, rem & 31, lane); }
    }
}

DI int moe_tables(Frame& F, LAS int* rbe, LAS int* bstart) {
    const unsigned* cnt = (const unsigned*)(F.ws + WS_CTL) + CW_CNT;
    __syncthreads();
    if (F.tid == 0) {
        int acc = 0;
        for (int e = 0; e < NE; ++e) { const int c = (int)__hip_atomic_load(cnt + e, __ATOMIC_RELAXED, __HIP_MEMORY_SCOPE_AGENT); const int nb = (c + 255) >> 8; bstart[e] = acc; for (int k = 0; k < nb; ++k) rbe[acc + k] = e; acc += nb; }
        bstart[NE] = acc;
    }
    __syncthreads();
    return bstart[NE];
}

DI void p8_scatter(Frame& F, const Args& A) {
    LAS int* rbe = (LAS int*)(F.lds + LDSCTL_OFF); LAS int* bstart = (LAS int*)(F.lds);
    (void)moe_tables(F, rbe, bstart);
    const int* EID = (const int*)(F.ws + WS_EID); const float* GWT = (const float*)(F.ws + WS_GWT); const float* R2 = (const float*)(F.ws + WS_R2);
    unsigned* fill = (unsigned*)(F.ws + WS_CTL) + CW_FILL;
    int* rowtok = (int*)(F.ws + WS_ROWTOK); int* rowdst = (int*)(F.ws + WS_ROWDST); float* roww = (float*)(F.ws + WS_ROWW); float* rowr2 = (float*)(F.ws + WS_ROWR2);
    for (int a = F.vcu * NTHREADS + F.tid; a < 2 * T; a += F.G * NTHREADS) {
        const int e = EID[a]; const unsigned k = atomicAdd(&fill[e], 1u); const int p = bstart[e] * 256 + (int)k;
        rowtok[p] = a >> 1; rowdst[p] = a; roww[p] = GWT[a]; rowr2[p] = R2[a >> 1];
    }
    __syncthreads();
}

struct EpiGU {
    static constexpr bool PERM = true;
    const float* rowr2; bf16_t* U;
    DI void operator()(const f32x4 (&acc)[2][2][4][2], const pg8::Unit& u, int wr, int wc, int fr, int fq) const {
        const int row0 = u.pm * 256 + wr * 64 + fr, pnr = u.pn & 3;
#pragma unroll
        for (int ai = 0; ai < 2; ++ai)
#pragma unroll
            for (int m = 0; m < 4; ++m) {
                const int p = row0 + ai * 128 + m * 16; const float r = rowr2[p];
#pragma unroll
                for (int bj = 0; bj < 2; ++bj) {
                    const int f0 = 128 * pnr + 64 * bj + 16 * wc + 4 * fq;
                    float o[4];
#pragma unroll
                    for (int e = 0; e < 4; ++e) { const float g = acc[ai][bj][m][0][e] * r, up = acc[ai][bj][m][1][e] * r; o[e] = g * sigmoidf_(g) * up; }
                    u32x2 w; w.x = pg8::cvt_pk_bf16(o[0], o[1]); w.y = pg8::cvt_pk_bf16(o[2], o[3]);
                    *(u32x2*)(U + (size_t)p * FF + f0) = w;
                }
            }
    }
};
struct EpiDown {
    static constexpr bool PERM = true;
    const int* rowdst; const float* roww; bf16_t* YK;
    DI void operator()(const f32x4 (&acc)[2][2][4][2], const pg8::Unit& u, int wr, int wc, int fr, int fq) const {
        const int row0 = u.pm * 256 + wr * 64 + fr, col0 = (u.pn & 7) * 256 + wc * 32 + 8 * fq;
#pragma unroll
        for (int ai = 0; ai < 2; ++ai)
#pragma unroll
            for (int m = 0; m < 4; ++m) {
                const int p = row0 + ai * 128 + m * 16; const int dst = rowdst[p]; const float w = roww[p];
                if (dst >= 0) {
#pragma unroll
                    for (int bj = 0; bj < 2; ++bj) {
                        const f32x4 a0 = acc[ai][bj][m][0] * w, a1 = acc[ai][bj][m][1] * w;
                        u32x4 o; o.x = pg8::cvt_pk_bf16(a0[0], a0[1]); o.y = pg8::cvt_pk_bf16(a0[2], a0[3]); o.z = pg8::cvt_pk_bf16(a1[0], a1[1]); o.w = pg8::cvt_pk_bf16(a1[2], a1[3]);
                        *(u32x4*)(YK + (size_t)dst * D + col0 + bj * 128) = o;
                    }
                }
            }
    }
};

DI void p11_final(Frame& F, const Args& A) {
    const float* X1 = (const float*)(F.ws + WS_X1); const bf16_t* YK = (const bf16_t*)(F.ws + WS_YK); const float* gf = A.in[17];
    const int gw = F.vcu * NWAVES + F.wave, NGW = F.G * NWAVES, lane = F.lane;
    for (int row = gw; row < T; row += NGW) {
        float v[32]; float ss = 0.f;
#pragma unroll
        for (int j = 0; j < 4; ++j) {
            const int c0 = 512 * j + 8 * lane;
            const f32x4 a0 = *(const f32x4*)(X1 + (size_t)row * D + c0), a1 = *(const f32x4*)(X1 + (size_t)row * D + c0 + 4);
            const u32x4 y0 = *(const u32x4*)(YK + (size_t)(2 * row) * D + c0), y1 = *(const u32x4*)(YK + (size_t)(2 * row + 1) * D + c0);
            v[8 * j + 0] = a0[0] + (bflo(y0.x) + bflo(y1.x)); v[8 * j + 1] = a0[1] + (bfhi(y0.x) + bfhi(y1.x)); v[8 * j + 2] = a0[2] + (bflo(y0.y) + bflo(y1.y)); v[8 * j + 3] = a0[3] + (bfhi(y0.y) + bfhi(y1.y));
            v[8 * j + 4] = a1[0] + (bflo(y0.z) + bflo(y1.z)); v[8 * j + 5] = a1[1] + (bfhi(y0.z) + bfhi(y1.z)); v[8 * j + 6] = a1[2] + (bflo(y0.w) + bflo(y1.w)); v[8 * j + 7] = a1[3] + (bfhi(y0.w) + bfhi(y1.w));
#pragma unroll
            for (int e = 0; e < 8; ++e) ss += v[8 * j + e] * v[8 * j + e];
        }
        const float r = rsqrtf(wave_sum(ss) * (1.0f / D) + EPS);
#pragma unroll
        for (int j = 0; j < 4; ++j) {
            const int c0 = 512 * j + 8 * lane;
            const f32x4 g0 = *(const f32x4*)(gf + c0), g1 = *(const f32x4*)(gf + c0 + 4);
            *(f32x4*)(F.out + (size_t)row * D + c0) = (f32x4){v[8 * j] * r * g0[0], v[8 * j + 1] * r * g0[1], v[8 * j + 2] * r * g0[2], v[8 * j + 3] * r * g0[3]};
            *(f32x4*)(F.out + (size_t)row * D + c0 + 4) = (f32x4){v[8 * j + 4] * r * g1[0], v[8 * j + 5] * r * g1[1], v[8 * j + 6] * r * g1[2], v[8 * j + 7] * r * g1[3]};
        }
    }
}

constexpr int N_PHASES = 12;
__global__ void __launch_bounds__(NTHREADS, 2) fwd(Args args) {
    extern __shared__ __attribute__((aligned(16))) unsigned char lds_raw[];
    Frame F;
    F.lds = (LAS unsigned char*)lds_raw;
    F.tid = threadIdx.x; F.lane = F.tid & 63; F.wave = __builtin_amdgcn_readfirstlane(F.tid >> 6);
    F.G = gridDim.x; { const int bx = blockIdx.x; F.vcu = (F.G % 8 == 0) ? (bx % 8) * (F.G / 8) + bx / 8 : bx; }
    F.ws = args.ws; F.out = args.out;
    volatile LAS unsigned* MISC = (volatile LAS unsigned*)(F.lds + MISC_OFF);
    for (int u = F.tid; u < (LDS_BYTES - LDSCTL_OFF) / 4; u += NTHREADS) ((LAS unsigned*)(F.lds + LDSCTL_OFF))[u] = 0u;
    __syncthreads();
    unsigned* ctl = (unsigned*)(F.ws + WS_CTL);
    XcdBarrier bar; bar.bar = ctl + CW_BAR; bar.x = 0; bar.st = nullptr;
    if (MK_N_LAUNCHES == 1) bar = xcd_barrier_post(ctl + CW_BAR, MISC + 8);
#define GRID_BAR() do { if (MK_N_LAUNCHES == 1) xcd_barrier(bar); } while (0)
    const int lo = args.ph_lo, hi = args.ph_hi;
#ifndef PHASE_MASK
#define PHASE_MASK 0xFFF
#endif
#define IN(k) (((PHASE_MASK >> (k)) & 1) && lo <= (k) && (k) < hi)
#define BOTH(k) (IN(k) && IN((k) + 1))

    if (IN(0)) { p0_prologue(F, args); if (BOTH(0)) GRID_BAR(); }
    if (IN(1)) {
        pg8::Gemm g{(const bf16_t*)(F.ws + WS_H), (const bf16_t*)(F.ws + WS_WIN), D, nullptr}; pg8::StaticOrder S; S.init(T, INW, F.G, (int)blockIdx.x);
        EpiProj E{F.ws, args.in[3]};
        pg8::gemm_phase<EpiProj, pg8::StaticOrder, true, true, false>(F.lds, g, S, E);
        if (BOTH(1)) GRID_BAR();
    }
    if (IN(2)) { p2_hgrn_simple(F, args); }
    if (IN(3)) { p3_attn_simple(F, args); if (BOTH(3)) GRID_BAR(); }
    if (IN(4)) { p4_fixups(F, args); if (BOTH(4)) GRID_BAR(); }
    if (IN(5)) {
        {   pg8::Gemm g{(const bf16_t*)(F.ws + WS_YB), (const bf16_t*)(F.ws + WS_WB), 512, nullptr}; pg8::StaticOrder S; S.init(T, D, F.G, (int)blockIdx.x);
            EpiGate<0> E{(const bf16_t*)(F.ws + WS_GB), (bf16_t*)(F.ws + WS_TMP), nullptr};
            pg8::gemm_phase<EpiGate<0>, pg8::StaticOrder, true, true, false>(F.lds, g, S, E); }
        VM_WAIT(); __syncthreads();
        {   pg8::Gemm g{(const bf16_t*)(F.ws + WS_YA), (const bf16_t*)(F.ws + WS_WA), D, nullptr}; pg8::StaticOrder S; S.init(T, D, F.G, (int)blockIdx.x);
            EpiGate<1> E{(const bf16_t*)(F.ws + WS_GA), (bf16_t*)(F.ws + WS_TMP), (bf16_t*)(F.ws + WS_MERGED)};
            pg8::gemm_phase<EpiGate<1>, pg8::StaticOrder, true, true, false>(F.lds, g, S, E); }
        if (BOTH(5)) GRID_BAR();
    }
    if (IN(6)) {
        pg8::Gemm g{(const bf16_t*)(F.ws + WS_MERGED), (const bf16_t*)(F.ws + WS_WOUT), D, nullptr}; pg8::StaticOrder S; S.init(T, D, F.G, (int)blockIdx.x);
        EpiOut E{args.in[0], (float*)(F.ws + WS_X1), (bf16_t*)(F.ws + WS_X1B)};
        pg8::gemm_phase<EpiOut, pg8::StaticOrder, true, true, false>(F.lds, g, S, E);
        if (BOTH(6)) GRID_BAR();
    }
    if (IN(7)) { p7_router(F, args); if (BOTH(7)) GRID_BAR(); }
    if (IN(8)) { p8_scatter(F, args); if (BOTH(8)) GRID_BAR(); }
    if (IN(9)) {
        LAS int* rbe = (LAS int*)(F.lds + LDSCTL_OFF); LAS int* bstart = (LAS int*)(F.lds + LDSCTL_OFF + 768 + 256 + 64);
        const int nrb = moe_tables(F, rbe, bstart);
        pg8::Gemm g{(const bf16_t*)(F.ws + WS_X1B), (const bf16_t*)(F.ws + WS_WGU), D, (const int*)(F.ws + WS_ROWTOK)};
        pg8::MoeOrder S{rbe, nrb, 4, F.G, F.vcu};
        EpiGU E{(const float*)(F.ws + WS_ROWR2), (bf16_t*)(F.ws + WS_U)};
        pg8::gemm_phase<EpiGU, pg8::MoeOrder, true, true, true>(F.lds, g, S, E);
        if (BOTH(9)) GRID_BAR();
    }
    if (IN(10)) {
        LAS int* rbe = (LAS int*)(F.lds + LDSCTL_OFF); LAS int* bstart = (LAS int*)(F.lds + LDSCTL_OFF + 768 + 256 + 64);
        const int nrb = moe_tables(F, rbe, bstart);
        pg8::Gemm g{(const bf16_t*)(F.ws + WS_U), (const bf16_t*)(F.ws + WS_WD), FF, nullptr};
        pg8::MoeOrder S{rbe, nrb, 8, F.G, F.vcu};
        EpiDown E{(const int*)(F.ws + WS_ROWDST), (const float*)(F.ws + WS_ROWW), (bf16_t*)(F.ws + WS_YK)};
        pg8::gemm_phase<EpiDown, pg8::MoeOrder, true, true, false>(F.lds, g, S, E);
        if (BOTH(10)) GRID_BAR();
    }
    if (IN(11)) { p11_final(F, args); }
#undef IN
#undef BOTH
}

extern "C" void kernel_launch(void* const* d_in, const int* in_sizes, int n_in, void* d_out, int out_size, void* d_ws, size_t ws_size, hipStream_t stream) {
    static int grid = 0;
    if (grid == 0) {
        if (n_in != 18 || in_sizes[0] != T * D || out_size != T * D || ws_size < WS_END) { fprintf(stderr, "kernel_launch: unexpected shapes: n_in %d in0 %d out %d ws %zu (need %zu)\n", n_in, n_in > 0 ? in_sizes[0] : -1, out_size, ws_size, (size_t)WS_END); grid = -1; return; }
        int dev = 0, cus = 0, per_cu = 0;
        if (hipGetDevice(&dev) != hipSuccess || hipDeviceGetAttribute(&cus, hipDeviceAttributeMultiprocessorCount, dev) != hipSuccess) { grid = -1; return; }
        if (hipFuncSetAttribute((const void*)fwd, hipFuncAttributeMaxDynamicSharedMemorySize, LDS_BYTES) != hipSuccess) { fprintf(stderr, "kernel_launch: hipFuncSetAttribute failed\n"); grid = -1; return; }
        if (hipOccupancyMaxActiveBlocksPerMultiprocessor(&per_cu, (const void*)fwd, NTHREADS, LDS_BYTES) != hipSuccess || per_cu < 1) fprintf(stderr, "kernel_launch: occupancy query reports %d\n", per_cu);
        (void)hipGetLastError();
        grid = cus;
        fprintf(stderr, "kernel_launch: grid %d, occupancy query %d, ws %zu\n", grid, per_cu, ws_size);
    }
    if (grid < 0) return;
    if (hipMemsetAsync((char*)d_ws + WS_CTL, 0, CTL_ZERO_BYTES, stream) != hipSuccess) return;
    Args a{};
    for (int i = 0; i < 18; ++i) a.in[i] = (const float*)d_in[i];
    a.out = (float*)d_out; a.ws = (unsigned char*)d_ws;
    const int nl = MK_N_LAUNCHES;
    for (int li = 0; li < nl; ++li) {
        a.ph_lo = (nl == 1) ? 0 : li; a.ph_hi = (nl == 1) ? N_PHASES : li + 1; a.li = li; a.pad = 0;
        hipLaunchKernelGGL(fwd, dim3(grid), dim3(NTHREADS), LDS_BYTES, stream, a);
        const hipError_t le = hipPeekAtLastError();
        if (le != hipSuccess) { fprintf(stderr, "kernel_launch: launch %d failed: %s\n", li, hipGetErrorName(le)); break; }
    }
}
```

```cpp
#include <hip/hip_runtime.h>
#include <cstdio>
#include <cstdint>

#ifndef MK_N_LAUNCHES
#define MK_N_LAUNCHES 1
#endif

#define DI __device__ __forceinline__
#define GAS __attribute__((address_space(1)))
#define LAS __attribute__((address_space(3)))
typedef unsigned short bf16_t;
typedef short bf16x8 __attribute__((ext_vector_type(8)));
typedef float f32x4 __attribute__((ext_vector_type(4)));
typedef unsigned u32x4 __attribute__((ext_vector_type(4)));
typedef unsigned u32x2 __attribute__((ext_vector_type(2)));

constexpr int NB = 8, SEQ = 2048, T = NB * SEQ, D = 2048;
constexpr int INW = 16896;
constexpr int NE = 64, FF = 512;
constexpr int PMAX = 49152;
constexpr float EPS = 1e-6f;
constexpr int NWAVES = 8, NTHREADS = 512;

constexpr size_t MiB = 1u << 20;
constexpr size_t WS_CTL = 0, CTL_ZERO_BYTES = 1 * MiB;
constexpr size_t WS_EID = 1 * MiB, WS_GWT = WS_EID + 256 * 1024, WS_R2 = WS_GWT + 256 * 1024;
constexpr size_t WS_ROWTOK = 2 * MiB, WS_ROWDST = WS_ROWTOK + 256 * 1024, WS_ROWW = WS_ROWDST + 256 * 1024, WS_ROWR2 = WS_ROWW + 256 * 1024;
constexpr size_t WS_LSE = 3 * MiB;
constexpr size_t WS_WA = 8 * MiB, WS_WB = 16 * MiB, WS_WOUT = 18 * MiB;
constexpr size_t WS_WIN = 32 * MiB, WS_H = 98 * MiB;
constexpr size_t WS_QA = 162 * MiB, WS_LF = 226 * MiB, WS_IA = 290 * MiB, WS_SG = 354 * MiB;
constexpr size_t WS_QB = 418 * MiB, WS_KB = 466 * MiB, WS_VT = 514 * MiB, WS_GA = 562 * MiB, WS_GB = 626 * MiB;
constexpr size_t WS_OH = 690 * MiB, WS_OG = 754 * MiB;
constexpr size_t WS_YA = 803 * MiB, WS_YB = 867 * MiB, WS_TMP = 883 * MiB, WS_MERGED = 947 * MiB, WS_END = 1011 * MiB;
constexpr size_t WS_X1 = 162 * MiB, WS_X1B = 290 * MiB, WS_WGU = 354 * MiB, WS_WD = 610 * MiB, WS_U = 738 * MiB, WS_YK = 32 * MiB;
static_assert(WS_U + (size_t)PMAX * FF * 2 <= WS_YA, "ws map");
constexpr int CW_BAR = 4096;
constexpr int CW_CNT = 16384;
constexpr int CW_FILL = 16384 + 64;

constexpr int RING_BYTES = 131072;
constexpr int LDSCTL_OFF = RING_BYTES;
constexpr int MISC_OFF = LDSCTL_OFF + 1024;
constexpr int LDS_BYTES = 147456;

DI unsigned f2bf(float f) { unsigned u = __builtin_bit_cast(unsigned, f); return (u + 0x7fffu + ((u >> 16) & 1u)) >> 16; }
DI unsigned pk2(float lo, float hi) { return f2bf(lo) | (f2bf(hi) << 16); }
DI float bflo(unsigned w) { return __builtin_bit_cast(float, w << 16); }
DI float bfhi(unsigned w) { return __builtin_bit_cast(float, w & 0xffff0000u); }
DI float bf1(bf16_t b) { return __builtin_bit_cast(float, (unsigned)b << 16); }
DI float sigmoidf_(float x) { return 1.0f / (1.0f + __expf(-x)); }
#define LDS_WAIT() asm volatile("s_waitcnt lgkmcnt(0)" ::: "memory")
#define VM_WAIT() asm volatile("s_waitcnt vmcnt(0)" ::: "memory")

namespace pg8 {
constexpr int BM = 256, BK = 64, HALF = 128, HTB = HALF * BK * 2, STAGE_BYTES = 8 * HTB, NXCD = 8, WGM = 8;
__host__ __device__ __forceinline__ int lds_byte(int r, int c) { const int st = (r >> 4) * 2 + (c >> 5), rr = r & 15, cc = c & 31, ob = rr * 64 + cc * 2; return st * 1024 + (ob ^ (((ob >> 9) & 1) << 5)); }
__host__ __device__ __forceinline__ void stage_rc(int b, int& R, int& C) { const int st = b / 1024, sb = b % 1024, swz = sb ^ (((sb >> 9) & 1) << 5); R = (st >> 1) * 16 + swz / 64; C = (st & 1) * 32 + (swz % 64) / 2; }
__host__ __device__ __forceinline__ int perm32(int rho) { const int n = rho >> 4, i = rho & 15; return 8 * (i >> 2) + 4 * n + (i & 3); }

struct Unit { int pm, pn; };
struct Gemm { const bf16_t* A; const bf16_t* Bt; int K; const int* rowtok; };

struct StaticOrder {
    int nM, nN, nwg, G, c;
    __host__ __device__ void init(int M, int N, int G_, int c_) { nM = M / BM; nN = N / BM; nwg = nM * nN; G = G_; c = c_; }
    __host__ __device__ bool next(int i, Unit& u) const {
        const long L = (long)i * G + c; if (L >= nwg) return false;
        int wgid = (int)L; { const int q = nwg / NXCD, r = nwg % NXCD, xcd = wgid % NXCD, off = wgid / NXCD; wgid = (xcd < r ? xcd * (q + 1) : r * (q + 1) + (xcd - r) * q) + off; }
        const int nig = WGM * nN, gid = wgid / nig, fm = gid * WGM, gsz = (nM - fm) < WGM ? (nM - fm) : WGM;
        u.pm = fm + ((wgid % nig) % gsz); u.pn = (wgid % nig) / gsz; return true;
    }
};
struct MoeOrder {
    const LAS int* rbe; int nrb, NT, G, vcu;
    DI bool next(int i, Unit& u) const {
        const int L = i * G + vcu; if (L >= nrb * NT) return false;
        const int rb = L / NT, pnr = L - rb * NT; u.pm = rb; u.pn = rbe[rb] * NT + pnr; return true;
    }
};

DI unsigned cvt_pk_bf16(float lo, float hi) { unsigned r; asm volatile("v_cvt_pk_bf16_f32 %0, %1, %2" : "=v"(r) : "v"(lo), "v"(hi)); return r; }

template <class Epi, class Sched, bool ALIGN_EPI, bool SP2, bool GATHER>
DI void gemm_phase(LAS unsigned char* lds, const Gemm g, const Sched& S, const Epi& E) {
    const int tid = threadIdx.x, wid = __builtin_amdgcn_readfirstlane(tid >> 6), lane = tid & 63, wr = wid >> 2, wc = wid & 3, fr = lane & 15, fq = lane >> 4;
    const int K = g.K, nt = K / BK;
    unsigned voffA[2], voffB[2]; int RA[2], CA[2];
#pragma unroll
    for (int i = 0; i < 2; ++i) { int R, C; stage_rc(tid * 16 + i * 8192, R, C); const int Rb = Epi::PERM ? ((R & ~31) + perm32(R & 31)) : R;
        voffA[i] = (unsigned)(R * K + C) * 2u; voffB[i] = (unsigned)(Rb * K + C) * 2u; RA[i] = R; CA[i] = C; }
    const size_t kstep = (size_t)(BK * 2);
    const size_t hstep = (size_t)HALF * K * 2;
    const size_t tstep = 2 * hstep;
    const size_t hstepA = GATHER ? 0 : hstep;
    const unsigned ldsw = (unsigned)wid * 1024u;
    const int aoff = lds_byte(wr * 64 + fr, fq * 8), boff = lds_byte(wc * 32 + fr, fq * 8);
#define PG8_SA(b, h) (((b) * 2 + (h)) * HTB)
#define PG8_SB(b, h) ((4 + (b) * 2 + (h)) * HTB)
#define PG8_STAGE2(bufoff, gbase, v0, v1) do { \
        __builtin_amdgcn_global_load_lds((const unsigned*)((const char*)(gbase) + (v0)), (LAS unsigned*)(lds + (bufoff) + ldsw), 16, 0, 0); \
        __builtin_amdgcn_global_load_lds((const unsigned*)((const char*)(gbase) + (v1)), (LAS unsigned*)(lds + (bufoff) + ldsw + 8192), 16, 0, 0); } while (0)
#define PG8_STAGE(bufoff, gbase, voff) PG8_STAGE2(bufoff, gbase, (voff)[0], (voff)[1])
#define PG8_LDA(dst, b, h) do { _Pragma("unroll") for (int m = 0; m < 4; ++m) _Pragma("unroll") for (int k = 0; k < 2; ++k) dst[m][k] = *(const LAS bf16x8*)(lds + PG8_SA(b, h) + aoff + m * 2048 + k * 1024); } while (0)
#define PG8_LDB(dst, b, h) do { _Pragma("unroll") for (int n = 0; n < 2; ++n) _Pragma("unroll") for (int k = 0; k < 2; ++k) dst[n][k] = *(const LAS bf16x8*)(lds + PG8_SB(b, h) + boff + n * 2048 + k * 1024); } while (0)
#define PG8_MMA(ai, bj, At, Bt) do { __builtin_amdgcn_s_setprio(1); _Pragma("unroll") for (int m = 0; m < 4; ++m) _Pragma("unroll") for (int n = 0; n < 2; ++n) _Pragma("unroll") for (int k = 0; k < 2; ++k) \
        acc[ai][bj][m][n] = __builtin_amdgcn_mfma_f32_16x16x32_bf16(Bt[n][k], At[m][k], acc[ai][bj][m][n], 0, 0, 0); __builtin_amdgcn_s_setprio(0); } while (0)
#define PG8_WAIT_V(n) asm volatile("s_waitcnt vmcnt(" #n ")" ::: "memory")
#define PG8_WAIT_L(n) asm volatile("s_waitcnt lgkmcnt(" #n ")" ::: "memory")
#define PG8_BAR __builtin_amdgcn_s_barrier()
#define PG8_SCHED __builtin_amdgcn_sched_barrier(0)
#define PG8_GATHER(u, dst) do { _Pragma("unroll") for (int _h = 0; _h < 2; ++_h) _Pragma("unroll") for (int _i = 0; _i < 2; ++_i) { \
        const int _tok = g.rowtok[(u).pm * BM + _h * HALF + RA[_i]]; dst[_h][_i] = (unsigned)(_tok * K + CA[_i]) * 2u; } } while (0)
    Unit cur, nxt; int ui = 0;
    if (!S.next(0, cur)) return;
    f32x4 acc[2][2][4][2];
#pragma unroll
    for (int a = 0; a < 2; ++a)
#pragma unroll
        for (int b = 0; b < 2; ++b)
#pragma unroll
            for (int m = 0; m < 4; ++m)
#pragma unroll
                for (int n = 0; n < 2; ++n) acc[a][b][m][n] = (f32x4){0.f, 0.f, 0.f, 0.f};
    bf16x8 At[4][2], B0[2][2], B1[2][2];
    unsigned gC[2][2], gN[2][2];
    if constexpr (GATHER) { PG8_GATHER(cur, gC); } else { gC[0][0] = voffA[0]; gC[0][1] = voffA[1]; gC[1][0] = voffA[0]; gC[1][1] = voffA[1]; }
#pragma unroll
    for (int h = 0; h < 2; ++h) { gN[h][0] = gC[h][0]; gN[h][1] = gC[h][1]; }
    const char* cA = (const char*)g.A + (GATHER ? 0 : (size_t)cur.pm * tstep); const char* cB = (const char*)g.Bt + (size_t)cur.pn * tstep;
    static_assert(SP2, "only the SP2 loop is kept in this file");
    PG8_STAGE(PG8_SB(0, 0), cB, voffB); PG8_STAGE(PG8_SB(0, 1), cB + hstep, voffB); PG8_STAGE2(PG8_SA(0, 0), cA, gC[0][0], gC[0][1]); PG8_STAGE2(PG8_SA(0, 1), cA + hstepA, gC[1][0], gC[1][1]);
    if (wr == 1) PG8_BAR;
    PG8_WAIT_V(2); PG8_BAR;
    PG8_STAGE(PG8_SB(1, 0), cB + kstep, voffB); PG8_STAGE2(PG8_SA(1, 0), cA + kstep, gC[0][0], gC[0][1]); PG8_STAGE(PG8_SB(1, 1), cB + hstep + kstep, voffB);
    PG8_WAIT_V(6); PG8_BAR;
    for (;;) {
        const bool has_next = S.next(ui + 1, nxt);
        const char* nA = (has_next && !GATHER) ? (const char*)g.A + (size_t)nxt.pm * tstep : cA; const char* nB = has_next ? (const char*)g.Bt + (size_t)nxt.pn * tstep : cB;
        if constexpr (GATHER) { if (has_next) { PG8_GATHER(nxt, gN); } else {
#pragma unroll
            for (int h = 0; h < 2; ++h) { gN[h][0] = gC[h][0]; gN[h][1] = gC[h][1]; } } }
        for (int t = 0; t < nt; t += 2) {
            const bool last = (t == nt - 2);
            const char* a1 = cA + (size_t)(t + 1) * kstep;
            const char* a2 = last ? nA : cA + (size_t)(t + 2) * kstep; const char* b2 = last ? nB : cB + (size_t)(t + 2) * kstep;
            const char* a3 = a2 + kstep; const char* b3 = b2 + kstep;
            unsigned x00 = gC[0][0], x01 = gC[0][1], x10 = gC[1][0], x11 = gC[1][1];
            if constexpr (GATHER) { if (last) { x00 = gN[0][0]; x01 = gN[0][1]; x10 = gN[1][0]; x11 = gN[1][1]; } }
            PG8_LDB(B0, 0, 0); PG8_LDB(B1, 0, 1); PG8_SCHED; PG8_LDA(At, 0, 0); PG8_STAGE2(PG8_SA(1, 1), a1 + hstepA, gC[1][0], gC[1][1]);
            PG8_WAIT_V(8); PG8_WAIT_L(0); PG8_BAR; PG8_MMA(0, 0, At, B0); PG8_MMA(0, 1, At, B1); PG8_BAR; PG8_SCHED;
            PG8_LDA(At, 0, 1); PG8_STAGE(PG8_SB(0, 0), b2, voffB); PG8_STAGE(PG8_SB(0, 1), b2 + hstep, voffB); PG8_STAGE2(PG8_SA(0, 0), a2, x00, x01);
            PG8_WAIT_V(8); PG8_WAIT_L(0); PG8_BAR; PG8_MMA(1, 0, At, B0); PG8_MMA(1, 1, At, B1); PG8_BAR; PG8_SCHED;
            PG8_LDB(B0, 1, 0); PG8_LDB(B1, 1, 1); PG8_SCHED; PG8_LDA(At, 1, 0); PG8_STAGE2(PG8_SA(0, 1), a2 + hstepA, x10, x11);
            PG8_WAIT_V(8); PG8_WAIT_L(0); PG8_BAR; PG8_MMA(0, 0, At, B0); PG8_MMA(0, 1, At, B1); PG8_BAR; PG8_SCHED;
            PG8_LDA(At, 1, 1); PG8_STAGE(PG8_SB(1, 0), b3, voffB); PG8_STAGE(PG8_SB(1, 1), b3 + hstep, voffB); PG8_STAGE2(PG8_SA(1, 0), a3, x00, x01);
            PG8_WAIT_V(8); PG8_WAIT_L(0); PG8_BAR; PG8_MMA(1, 0, At, B0); PG8_MMA(1, 1, At, B1); PG8_BAR; PG8_SCHED;
        }
        if constexpr (ALIGN_EPI) { if (wr == 0) PG8_BAR; }
        E(acc, cur, wr, wc, fr, fq);
        if (!has_next) break;
#pragma unroll
        for (int a = 0; a < 2; ++a)
#pragma unroll
            for (int b = 0; b < 2; ++b)
#pragma unroll
                for (int m = 0; m < 4; ++m)
#pragma unroll
                    for (int n = 0; n < 2; ++n) acc[a][b][m][n] = (f32x4){0.f, 0.f, 0.f, 0.f};
        cur = nxt; cA = nA; cB = nB; ++ui;
#pragma unroll
        for (int h = 0; h < 2; ++h) { gC[h][0] = gN[h][0]; gC[h][1] = gN[h][1]; }
        if constexpr (ALIGN_EPI) { if (wr == 1) PG8_BAR; }
    }
    PG8_WAIT_V(0);
    if constexpr (!ALIGN_EPI) { if (wr == 0) PG8_BAR; }
    PG8_BAR;
#undef PG8_SA
#undef PG8_SB
#undef PG8_STAGE
#undef PG8_STAGE2
#undef PG8_LDA
#undef PG8_LDB
#undef PG8_MMA
#undef PG8_WAIT_V
#undef PG8_WAIT_L
#undef PG8_BAR
#undef PG8_SCHED
#undef PG8_GATHER
}
}

#define XB_TMO      128
#define XB_XCNT(j)  (256  + 64 * (j))
#define XB_XSUB(j)  (1280 + 64 * (j))
#define XB_XGEN(j)  (2304 + 64 * (j))
#define XB_TOP      3328
#define XB_TOPGEN   3392
#define XCD_BAR_WORDS 3456
#define XB_SPIN_CAP (1u << 18)
__device__ __forceinline__ unsigned xb_ld(unsigned* p)              { return __hip_atomic_load(p, __ATOMIC_RELAXED, __HIP_MEMORY_SCOPE_AGENT); }
__device__ __forceinline__ unsigned xb_add(unsigned* p, unsigned v) { return __hip_atomic_fetch_add(p, v, __ATOMIC_RELAXED, __HIP_MEMORY_SCOPE_AGENT); }
__device__ __forceinline__ unsigned xb_xcc_id() { return (unsigned)__builtin_amdgcn_s_getreg((3 << 11) | 20) & 0xFu; }
#define XB_SPIN(cond, bar) do { unsigned _sp = 0; while (cond) { __builtin_amdgcn_s_sleep(1); \
    if ((++_sp & 255u) == 0u) { if (xb_ld(&(bar)[XB_TMO])) break; if (_sp > XB_SPIN_CAP) { atomicAdd(&(bar)[XB_TMO], 1u); break; } } } } while (0)
struct XcdBarrier { unsigned* bar; unsigned x; volatile LAS unsigned* st; };
__device__ __forceinline__ XcdBarrier xcd_barrier_post(unsigned* bar, volatile LAS unsigned* st) {
    XcdBarrier b; b.bar = bar; b.x = xb_xcc_id(); b.st = st;
    if (threadIdx.x == 0) (void)xb_add(&bar[XB_XCNT(b.x)], 1u);
    return b;
}
__device__ __forceinline__ void xcd_barrier_complete(unsigned* bar, unsigned x, unsigned& nloc, unsigned& nx) {
    const unsigned G = gridDim.x * gridDim.y * gridDim.z;
    unsigned sum, cnt, mine, sp = 0u;
    for (;;) {
        sum = 0u; cnt = 0u; mine = 0u;
#pragma unroll
        for (unsigned j = 0; j < 16; ++j) { const unsigned c = xb_ld(&bar[XB_XCNT(j)]); sum += c; cnt += (c > 0u) ? 1u : 0u; mine = (j == x) ? c : mine; }
        if (sum == G) break;
        __builtin_amdgcn_s_sleep(1);
        if ((++sp & 255u) == 0u) { if (xb_ld(&bar[XB_TMO])) break; if (sp > XB_SPIN_CAP) { atomicAdd(&bar[XB_TMO], 1u); break; } }
    }
    nloc = mine > 0u ? mine : 1u; nx = cnt > 0u ? cnt : 1u;
}
__device__ __forceinline__ void xcd_barrier(const XcdBarrier& b) {
    asm volatile("s_waitcnt vmcnt(0)" ::: "memory");
    __syncthreads();
    if (threadIdx.x == 0) {
        unsigned* bar = b.bar;
        __builtin_amdgcn_s_waitcnt(0);
        unsigned nloc = b.st[0], nx = b.st[1];
        if (nloc == 0u) { xcd_barrier_complete(bar, b.x, nloc, nx); b.st[0] = nloc; b.st[1] = nx; }
        const unsigned old = xb_add(&bar[XB_XSUB(b.x)], 1u);
        const unsigned gen = old / nloc;
        if (old + 1u == (gen + 1u) * nloc) {
            __builtin_amdgcn_fence(__ATOMIC_RELEASE, "agent");
            asm volatile("s_waitcnt vmcnt(0)" ::: "memory");
            const unsigned og = xb_add(&bar[XB_TOP], 1u);
            const unsigned tg = og / nx;
            if (og + 1u == (tg + 1u) * nx) xb_add(&bar[XB_TOPGEN], 1u);
            else XB_SPIN(xb_ld(&bar[XB_TOPGEN]) == tg, bar);
            __builtin_amdgcn_fence(__ATOMIC_ACQUIRE, "agent");
            xb_add(&bar[XB_XGEN(b.x)], 1u);
            asm volatile("s_waitcnt vmcnt(0)" ::: "memory");
        } else {
            XB_SPIN(xb_ld(&bar[XB_XGEN(b.x)]) == gen, bar);
            __builtin_amdgcn_fence(__ATOMIC_ACQUIRE, "agent");
            asm volatile("s_waitcnt vmcnt(0)" ::: "memory");
        }
    }
    __syncthreads();
}

struct Frame {
    LAS unsigned char* lds;
    int tid, lane, wave, vcu, G;
    unsigned char* ws;
    float* out;
};
struct Args { const float* in[18]; float* out; unsigned char* ws; int ph_lo, ph_hi, li, pad; };
DI float wave_sum(float v) {
#pragma unroll
    for (int o = 1; o < 64; o <<= 1) v += __shfl_xor(v, o);
    return v;
}
DI float wave_max(float v) {
#pragma unroll
    for (int o = 1; o < 64; o <<= 1) v = fmaxf(v, __shfl_xor(v, o));
    return v;
}

template <int MAP>
DI void cvt_item(const float* W, int N, int K, bf16_t* WT, const float* gain, LAS unsigned* scr, int kb, int nb, int lane) {
    const int nq = lane & 15, kr = lane >> 4, k0 = kb * 64, n0 = nb * 64;
    f32x4 v[8][2];
#pragma unroll
    for (int j = 0; j < 8; ++j)
#pragma unroll
        for (int e = 0; e < 2; ++e) v[j][e] = *(const f32x4*)(W + (size_t)(k0 + 8 * j + 2 * kr + e) * N + n0 + 4 * nq);
    if (gain) {
#pragma unroll
        for (int j = 0; j < 8; ++j) { const float g0 = gain[k0 + 8 * j + 2 * kr], g1 = gain[k0 + 8 * j + 2 * kr + 1]; v[j][0] = v[j][0] * g0; v[j][1] = v[j][1] * g1; }
    }
#pragma unroll
    for (int j = 0; j < 8; ++j)
#pragma unroll
        for (int i = 0; i < 4; ++i) scr[(4 * nq + i) * 32 + ((j ^ (nq & 7)) << 2) + kr] = pk2(v[j][0][i], v[j][1][i]);
    LDS_WAIT(); asm volatile("" ::: "memory");
#pragma unroll
    for (int jj = 0; jj < 8; ++jj) {
        const int nl = (lane >> 3) + 8 * jj, c = lane & 7;
        const u32x4 o = *(const LAS u32x4*)(scr + nl * 32 + ((c ^ ((nl >> 2) & 7)) << 2));
        const int n = n0 + nl;
        const int row = (MAP == 0) ? n : ((n >> 2) * 8 + (MAP == 2 ? 4 : 0) + (n & 3));
        *(u32x4*)(WT + (size_t)row * K + k0 + 8 * c) = o;
    }
    LDS_WAIT(); asm volatile("" ::: "memory");
}

DI void p0_prologue(Frame& F, const Args& A) {
    LAS unsigned* scr = (LAS unsigned*)(F.lds + F.wave * 8192);
    const int gw = F.vcu * NWAVES + F.wave, NGW = F.G * NWAVES;
    constexpr int I_IN = 32 * 264, I_A = 32 * 32, I_B = 8 * 32, I_O = 32 * 32;
    for (int it = gw; it < I_IN + I_A + I_B + I_O; it += NGW) {
        int r = it;
        if (r < I_IN) { cvt_item<0>(A.in[2], INW, D, (bf16_t*)(F.ws + WS_WIN), nullptr, scr, r / 264, r % 264, F.lane); continue; } r -= I_IN;
        if (r < I_A) { cvt_item<0>(A.in[6], D, D, (bf16_t*)(F.ws + WS_WA), nullptr, scr, r / 32, r % 32, F.lane); continue; } r -= I_A;
        if (r < I_B) { cvt_item<0>(A.in[7], D, 512, (bf16_t*)(F.ws + WS_WB), nullptr, scr, r / 32, r % 32, F.lane); continue; } r -= I_B;
        cvt_item<0>(A.in[8], D, D, (bf16_t*)(F.ws + WS_WOUT), nullptr, scr, r / 32, r % 32, F.lane);
    }
    const float* x = A.in[0]; const float* g1 = A.in[1]; bf16_t* H = (bf16_t*)(F.ws + WS_H);
    for (int row = gw; row < T; row += NGW) {
        const f32x4* xr = (const f32x4*)(x + (size_t)row * D) + F.lane;
        f32x4 v[8]; float ss = 0.f;
#pragma unroll
        for (int j = 0; j < 8; ++j) { v[j] = xr[64 * j]; ss += (v[j][0] * v[j][0] + v[j][1] * v[j][1]) + (v[j][2] * v[j][2] + v[j][3] * v[j][3]); }
        const float r = rsqrtf(wave_sum(ss) * (1.0f / D) + EPS);
        u32x2* o = (u32x2*)(H + (size_t)row * D) + F.lane;
#pragma unroll
        for (int j = 0; j < 8; ++j) { const f32x4 g = ((const f32x4*)g1)[F.lane + 64 * j]; u32x2 w; w.x = pk2(v[j][0] * r * g[0], v[j][1] * r * g[1]); w.y = pk2(v[j][2] * r * g[2], v[j][3] * r * g[3]); o[64 * j] = w; }
    }
}

struct EpiProj {
    static constexpr bool PERM = true;
    unsigned char* ws; const float* lbl;
    DI void operator()(const f32x4 (&acc)[2][2][4][2], const pg8::Unit& u, int wr, int wc, int fr, int fq) const {
        const int pn = u.pn, row0 = u.pm * 256 + wr * 64 + fr, cw = wc * 32 + 8 * fq;
        if (pn < 32 || pn >= 50) {
            size_t off; int tile, mode;
            if (pn < 8) { off = WS_QA; tile = pn; mode = 0; } else if (pn < 16) { off = WS_LF; tile = pn - 8; mode = 1; } else if (pn < 24) { off = WS_IA; tile = pn - 16; mode = 0; }
            else if (pn < 32) { off = WS_SG; tile = pn - 24; mode = 2; } else if (pn < 58) { off = WS_GA; tile = pn - 50; mode = 2; } else { off = WS_GB; tile = pn - 58; mode = 2; }
            bf16_t* base = (bf16_t*)(ws + off);
#pragma unroll
            for (int bj = 0; bj < 2; ++bj) {
                const int col = tile * 256 + bj * 128 + cw;
                float lb[8];
                if (mode == 1) {
#pragma unroll
                    for (int e = 0; e < 8; ++e) lb[e] = 1.0f / (1.0f + __expf(lbl[2048 + col + e] - lbl[col + e]));
                }
#pragma unroll
                for (int ai = 0; ai < 2; ++ai)
#pragma unroll
                    for (int m = 0; m < 4; ++m) {
                        const int row = row0 + ai * 128 + m * 16;
                        float v[8];
#pragma unroll
                        for (int e = 0; e < 4; ++e) { v[e] = acc[ai][bj][m][0][e]; v[4 + e] = acc[ai][bj][m][1][e]; }
                        if (mode == 1) {
#pragma unroll
                            for (int e = 0; e < 8; ++e) v[e] = __logf(lb[e] + (1.0f - lb[e]) * sigmoidf_(v[e]));
                        } else if (mode == 2) {
#pragma unroll
                            for (int e = 0; e < 8; ++e) v[e] = sigmoidf_(v[e]);
                        }
                        u32x4 w; w.x = pg8::cvt_pk_bf16(v[0], v[1]); w.y = pg8::cvt_pk_bf16(v[2], v[3]); w.z = pg8::cvt_pk_bf16(v[4], v[5]); w.w = pg8::cvt_pk_bf16(v[6], v[7]);
                        *(u32x4*)(base + (size_t)row * D + col) = w;
                    }
            }
        } else {
            const int a = pn - 32, kind = a / 6, ht = a - kind * 6;
#pragma unroll
            for (int bj = 0; bj < 2; ++bj) {
                const int head = ht * 2 + bj, sh = 2 * (head >> 2);
#pragma unroll
                for (int ai = 0; ai < 2; ++ai)
#pragma unroll
                    for (int m = 0; m < 4; ++m) {
                        const int row = row0 + ai * 128 + m * 16, b = row >> 11, s = row & 2047;
                        const int pos = ((s & ((1 << sh) - 1)) << (11 - sh)) + (s >> sh);
                        float v[8];
#pragma unroll
                        for (int e = 0; e < 4; ++e) { v[e] = acc[ai][bj][m][0][e]; v[4 + e] = acc[ai][bj][m][1][e]; }
                        if (kind < 2) {
                            const float sc = (kind == 0) ? 0.08838834764831845f : 1.0f;
                            u32x4 w; w.x = pg8::cvt_pk_bf16(v[0] * sc, v[1] * sc); w.y = pg8::cvt_pk_bf16(v[2] * sc, v[3] * sc); w.z = pg8::cvt_pk_bf16(v[4] * sc, v[5] * sc); w.w = pg8::cvt_pk_bf16(v[6] * sc, v[7] * sc);
                            bf16_t* base = (bf16_t*)(ws + (kind == 0 ? WS_QB : WS_KB));
                            *(u32x4*)(base + ((size_t)(b * 12 + head) * 2048 + pos) * 128 + cw) = w;
                        } else {
                            bf16_t* base = (bf16_t*)(ws + WS_VT) + ((size_t)(b * 12 + head) * 128 + cw) * 2048 + pos;
#pragma unroll
                            for (int e = 0; e < 8; ++e) base[(size_t)e * 2048] = (bf16_t)f2bf(v[e]);
                        }
                    }
            }
        }
    }
};

DI void p2_hgrn_simple(Frame& F, const Args& A) {
    LAS float* qs = (LAS float*)F.lds; LAS float* fs = qs + 16 * 128; LAS float* is = fs + 16 * 128; LAS float* red = is + 16 * 128;
    const bf16_t* QA = (const bf16_t*)(F.ws + WS_QA); const bf16_t* LF = (const bf16_t*)(F.ws + WS_LF); const bf16_t* IA = (const bf16_t*)(F.ws + WS_IA); bf16_t* OH = (bf16_t*)(F.ws + WS_OH);
    const int tid = F.tid, v = tid & 127, kq = __builtin_amdgcn_readfirstlane(tid >> 7), lt = tid >> 5, c4 = tid & 31;
    for (int item = F.vcu; item < 128; item += F.G) {
        const int b = item >> 4, h = item & 15;
        float S[32];
#pragma unroll
        for (int k = 0; k < 32; ++k) S[k] = 0.f;
        for (int t0 = 0; t0 < SEQ; t0 += 16) {
            {
                const size_t g = ((size_t)(b * SEQ + t0 + lt)) * D + h * 128 + 4 * c4;
                const u32x2 q2 = *(const u32x2*)(QA + g), f2 = *(const u32x2*)(LF + g), i2 = *(const u32x2*)(IA + g);
                *(LAS f32x4*)(qs + lt * 128 + 4 * c4) = (f32x4){bflo(q2.x), bfhi(q2.x), bflo(q2.y), bfhi(q2.y)};
                *(LAS f32x4*)(fs + lt * 128 + 4 * c4) = (f32x4){__expf(bflo(f2.x)), __expf(bfhi(f2.x)), __expf(bflo(f2.y)), __expf(bfhi(f2.y))};
                *(LAS f32x4*)(is + lt * 128 + 4 * c4) = (f32x4){bflo(i2.x), bfhi(i2.x), bflo(i2.y), bfhi(i2.y)};
            }
            __syncthreads();
#pragma unroll 2
            for (int t = 0; t < 16; ++t) {
                const float iv = is[t * 128 + v]; float o = 0.f;
#pragma unroll
                for (int k4 = 0; k4 < 8; ++k4) {
                    const f32x4 f = *(const LAS f32x4*)(fs + t * 128 + kq * 32 + 4 * k4), q = *(const LAS f32x4*)(qs + t * 128 + kq * 32 + 4 * k4);
#pragma unroll
                    for (int e = 0; e < 4; ++e) { float s = S[4 * k4 + e]; s = iv + f[e] * (s - iv); S[4 * k4 + e] = s; o += s * q[e]; }
                }
                red[(kq * 16 + t) * 128 + v] = o;
            }
            __syncthreads();
            {
                f32x4 s = *(const LAS f32x4*)(red + (0 * 16 + lt) * 128 + 4 * c4);
#pragma unroll
                for (int q = 1; q < 4; ++q) s = s + *(const LAS f32x4*)(red + (q * 16 + lt) * 128 + 4 * c4);
                u32x2 w; w.x = pk2(s[0], s[1]); w.y = pk2(s[2], s[3]);
                *(u32x2*)(OH + ((size_t)(b * SEQ + t0 + lt)) * D + h * 128 + 4 * c4) = w;
            }
        }
        __syncthreads();
    }
}

DI int t5_bucket(int dist) {
    if (dist < 16) return dist;
    int b = 16;
    b += (dist >= 22); b += (dist >= 30); b += (dist >= 40); b += (dist >= 54); b += (dist >= 73); b += (dist >= 99); b += (dist >= 134); b += (dist >= 182);
    b += (dist >= 246); b += (dist >= 332); b += (dist >= 450); b += (dist >= 609); b += (dist >= 825); b += (dist >= 1117); b += (dist >= 1513);
    return b;
}
DI void p3_attn_simple(Frame& F, const Args& A) {
    const bf16_t* QB = (const bf16_t*)(F.ws + WS_QB); const bf16_t* KB = (const bf16_t*)(F.ws + WS_KB); const bf16_t* VT = (const bf16_t*)(F.ws + WS_VT);
    bf16_t* OG = (bf16_t*)(F.ws + WS_OG); float* LSE = (float*)(F.ws + WS_LSE); const float* relb = A.in[5];
    LAS float* pb = (LAS float*)F.lds + F.wave * 320; LAS float* qf = pb + 192;
    const int gw = F.vcu * NWAVES + F.wave, NGW = F.G * NWAVES, lane = F.lane;
    for (int idx = gw; idx < NB * 12 * SEQ; idx += NGW) {
        const int pos = idx & 2047, bh = idx >> 11, head = bh % 12, b = bh / 12, g = head >> 2, sh = 2 * g;
        const int r = pos >> (11 - sh), l = pos & ((2048 >> sh) - 1), s = (l << sh) + r;
        { const unsigned qw = *(const unsigned*)(QB + (size_t)idx * 128 + 2 * lane); qf[2 * lane] = bflo(qw); qf[2 * lane + 1] = bfhi(qw); }
        LDS_WAIT(); asm volatile("" ::: "memory");
        float mx = -3.0e38f;
#pragma unroll 1
        for (int rr = 0; rr < 3; ++rr) {
            const int j = rr * 64 + lane; const bool valid = (j <= 128) && (j <= l);
            const bf16_t* kp = KB + (size_t)(valid ? idx - j : idx) * 128;
            float d = 0.f;
#pragma unroll
            for (int i = 0; i < 16; ++i) { const u32x4 k = *(const u32x4*)(kp + 8 * i); const f32x4 qa = *(const LAS f32x4*)(qf + 8 * i), qb = *(const LAS f32x4*)(qf + 8 * i + 4);
                d += qa[0] * bflo(k.x) + qa[1] * bfhi(k.x) + qa[2] * bflo(k.y) + qa[3] * bfhi(k.y)
                   + qb[0] * bflo(k.z) + qb[1] * bfhi(k.z) + qb[2] * bflo(k.w) + qb[3] * bfhi(k.w); }
            const float bias = relb[t5_bucket((valid ? j : 0) << sh) * 12 + head];
            const float lgv = valid ? d + bias : -3.0e38f;
            pb[rr * 64 + lane] = lgv;
            mx = fmaxf(mx, lgv);
        }
        mx = wave_max(mx);
        float den = 0.f;
#pragma unroll 1
        for (int rr = 0; rr < 3; ++rr) { const float lgv = pb[rr * 64 + lane]; const float p = (lgv > -1.0e38f) ? __expf(lgv - mx) : 0.f; den += p; pb[rr * 64 + lane] = p; }
        den = wave_sum(den);
        LDS_WAIT(); asm volatile("" ::: "memory");
        const int nk = (l < 128 ? l : 128) + 1;
        const bf16_t* v0 = VT + ((size_t)(b * 12 + head) * 128 + lane) * 2048 + pos;
        const bf16_t* v1 = v0 + (size_t)64 * 2048;
        float o0 = 0.f, o1 = 0.f;
        for (int j = 0; j < nk; ++j) { const float p = pb[j]; o0 += p * bf1(*(v0 - j)); o1 += p * bf1(*(v1 - j)); }
        const float inv = 1.0f / den;
        const size_t orow = (size_t)g * T + (size_t)b * SEQ + s;
        OG[orow * 512 + (head & 3) * 128 + lane] = (bf16_t)f2bf(o0 * inv);
        OG[orow * 512 + (head & 3) * 128 + 64 + lane] = (bf16_t)f2bf(o1 * inv);
        if (lane == 0) LSE[orow * 4 + (head & 3)] = mx + __logf(den);
        LDS_WAIT(); asm volatile("" ::: "memory");
    }
}

DI void p4_fixups(Frame& F, const Args& A) {
    const bf16_t* OH = (const bf16_t*)(F.ws + WS_OH); const bf16_t* SG = (const bf16_t*)(F.ws + WS_SG); const float* hg = A.in[4];
    const bf16_t* OG = (const bf16_t*)(F.ws + WS_OG); const float* LSE = (const float*)(F.ws + WS_LSE);
    bf16_t* YA = (bf16_t*)(F.ws + WS_YA); bf16_t* YB = (bf16_t*)(F.ws + WS_YB);
    const int gw = F.vcu * NWAVES + F.wave, NGW = F.G * NWAVES, lane = F.lane;
    for (int row = gw; row < T; row += NGW) {
#pragma unroll
        for (int j = 0; j < 4; ++j) {
            const int c0 = 512 * j + 8 * lane;
            const u32x4 o = *(const u32x4*)(OH + (size_t)row * D + c0), sg = *(const u32x4*)(SG + (size_t)row * D + c0);
            float v[8] = {bflo(o.x), bfhi(o.x), bflo(o.y), bfhi(o.y), bflo(o.z), bfhi(o.z), bflo(o.w), bfhi(o.w)};
            const float s[8] = {bflo(sg.x), bfhi(sg.x), bflo(sg.y), bfhi(sg.y), bflo(sg.z), bfhi(sg.z), bflo(sg.w), bfhi(sg.w)};
            float ss = 0.f;
#pragma unroll
            for (int e = 0; e < 8; ++e) ss += v[e] * v[e];
            ss += __shfl_xor(ss, 1); ss += __shfl_xor(ss, 2); ss += __shfl_xor(ss, 4); ss += __shfl_xor(ss, 8);
            const float rinv = rsqrtf(ss * (1.0f / 128.0f) + EPS);
            const f32x4 g0 = *(const f32x4*)(hg + c0), g1 = *(const f32x4*)(hg + c0 + 4);
#pragma unroll
            for (int e = 0; e < 4; ++e) { v[e] = v[e] * rinv * g0[e] * s[e]; v[4 + e] = v[4 + e] * rinv * g1[e] * s[4 + e]; }
            u32x4 w; w.x = pk2(v[0], v[1]); w.y = pk2(v[2], v[3]); w.z = pk2(v[4], v[5]); w.w = pk2(v[6], v[7]);
            *(u32x4*)(YA + (size_t)row * D + c0) = w;
        }
        {
            const int c0 = 8 * lane, hs = lane >> 4;
            const float l0 = LSE[((size_t)0 * T + row) * 4 + hs], l1 = LSE[((size_t)1 * T + row) * 4 + hs], l2 = LSE[((size_t)2 * T + row) * 4 + hs];
            const float mx = fmaxf(l0, fmaxf(l1, l2)); float a0 = __expf(l0 - mx), a1 = __expf(l1 - mx), a2 = __expf(l2 - mx);
            const float inv = 1.0f / (a0 + a1 + a2); a0 *= inv; a1 *= inv; a2 *= inv;
            const u32x4 x0 = *(const u32x4*)(OG + ((size_t)0 * T + row) * 512 + c0), x1 = *(const u32x4*)(OG + ((size_t)1 * T + row) * 512 + c0), x2 = *(const u32x4*)(OG + ((size_t)2 * T + row) * 512 + c0);
            u32x4 w;
            w.x = pk2(a0 * bflo(x0.x) + a1 * bflo(x1.x) + a2 * bflo(x2.x), a0 * bfhi(x0.x) + a1 * bfhi(x1.x) + a2 * bfhi(x2.x));
            w.y = pk2(a0 * bflo(x0.y) + a1 * bflo(x1.y) + a2 * bflo(x2.y), a0 * bfhi(x0.y) + a1 * bfhi(x1.y) + a2 * bfhi(x2.y));
            w.z = pk2(a0 * bflo(x0.z) + a1 * bflo(x1.z) + a2 * bflo(x2.z), a0 * bfhi(x0.z) + a1 * bfhi(x1.z) + a2 * bfhi(x2.z));
            w.w = pk2(a0 * bflo(x0.w) + a1 * bflo(x1.w) + a2 * bflo(x2.w), a0 * bfhi(x0.w) + a1 * bfhi(x1.w) + a2 * bfhi(x2.w));
            *(u32x4*)(YB + (size_t)row * 512 + c0) = w;
        }
    }
}

template <int MODE> struct EpiGate {
    static constexpr bool PERM = true;
    const bf16_t* gate; bf16_t* tmp; bf16_t* outp;
    DI void operator()(const f32x4 (&acc)[2][2][4][2], const pg8::Unit& u, int wr, int wc, int fr, int fq) const {
        const int row0 = u.pm * 256 + wr * 64 + fr, col0 = u.pn * 256 + wc * 32 + 8 * fq;
#pragma unroll
        for (int ai = 0; ai < 2; ++ai)
#pragma unroll
            for (int m = 0; m < 4; ++m)
#pragma unroll
                for (int bj = 0; bj < 2; ++bj) {
                    const size_t o = (size_t)(row0 + ai * 128 + m * 16) * D + col0 + bj * 128;
                    const u32x4 gt = *(const u32x4*)(gate + o);
                    float v[8];
#pragma unroll
                    for (int e = 0; e < 4; ++e) { v[e] = acc[ai][bj][m][0][e]; v[4 + e] = acc[ai][bj][m][1][e]; }
                    v[0] *= bflo(gt.x); v[1] *= bfhi(gt.x); v[2] *= bflo(gt.y); v[3] *= bfhi(gt.y); v[4] *= bflo(gt.z); v[5] *= bfhi(gt.z); v[6] *= bflo(gt.w); v[7] *= bfhi(gt.w);
                    if (MODE == 1) { const u32x4 tp = *(const u32x4*)(tmp + o);
                        v[0] += bflo(tp.x); v[1] += bfhi(tp.x); v[2] += bflo(tp.y); v[3] += bfhi(tp.y); v[4] += bflo(tp.z); v[5] += bfhi(tp.z); v[6] += bflo(tp.w); v[7] += bfhi(tp.w); }
                    u32x4 w; w.x = pg8::cvt_pk_bf16(v[0], v[1]); w.y = pg8::cvt_pk_bf16(v[2], v[3]); w.z = pg8::cvt_pk_bf16(v[4], v[5]); w.w = pg8::cvt_pk_bf16(v[6], v[7]);
                    *(u32x4*)((MODE == 1 ? outp : tmp) + o) = w;
                }
    }
};
struct EpiOut {
    static constexpr bool PERM = true;
    const float* x; float* x1; bf16_t* x1b;
    DI void operator()(const f32x4 (&acc)[2][2][4][2], const pg8::Unit& u, int wr, int wc, int fr, int fq) const {
        const int row0 = u.pm * 256 + wr * 64 + fr, col0 = u.pn * 256 + wc * 32 + 8 * fq;
#pragma unroll
        for (int ai = 0; ai < 2; ++ai)
#pragma unroll
            for (int m = 0; m < 4; ++m)
#pragma unroll
                for (int bj = 0; bj < 2; ++bj) {
                    const size_t o = (size_t)(row0 + ai * 128 + m * 16) * D + col0 + bj * 128;
                    const f32x4 a0 = *(const f32x4*)(x + o) + acc[ai][bj][m][0], a1 = *(const f32x4*)(x + o + 4) + acc[ai][bj][m][1];
                    *(f32x4*)(x1 + o) = a0; *(f32x4*)(x1 + o + 4) = a1;
                    u32x4 w; w.x = pg8::cvt_pk_bf16(a0[0], a0[1]); w.y = pg8::cvt_pk_bf16(a0[2], a0[3]); w.z = pg8::cvt_pk_bf16(a1[0], a1[1]); w.w = pg8::cvt_pk_bf16(a1[2], a1[3]);
                    *(u32x4*)(x1b + o) = w;
                }
    }
};

DI void p7_router(Frame& F, const Args& A) {
    const float* X1 = (const float*)(F.ws + WS_X1); const float* g2 = A.in[9]; const float* wrg = A.in[10]; const float* brg = A.in[11]; const float* wre = A.in[12]; const float* bre = A.in[13];
    int* EID = (int*)(F.ws + WS_EID); float* GWT = (float*)(F.ws + WS_GWT); float* R2 = (float*)(F.ws + WS_R2);
    unsigned* cnt = (unsigned*)(F.ws + WS_CTL) + CW_CNT;
    int* rowtok = (int*)(F.ws + WS_ROWTOK); int* rowdst = (int*)(F.ws + WS_ROWDST);
    const int gw = F.vcu * NWAVES + F.wave, NGW = F.G * NWAVES, lane = F.lane;
    for (int p = F.vcu * NTHREADS + F.tid; p < PMAX; p += F.G * NTHREADS) { rowtok[p] = 0; rowdst[p] = -1; }
    for (int row = gw; row < T; row += NGW) {
        const f32x4* xr = (const f32x4*)(X1 + (size_t)row * D) + lane;
        f32x4 v[8]; float ss = 0.f;
#pragma unroll
        for (int j = 0; j < 8; ++j) { v[j] = xr[64 * j]; ss += (v[j][0] * v[j][0] + v[j][1] * v[j][1]) + (v[j][2] * v[j][2] + v[j][3] * v[j][3]); }
        const float r = rsqrtf(wave_sum(ss) * (1.0f / D) + EPS);
#pragma unroll
        for (int j = 0; j < 8; ++j) { const f32x4 g = ((const f32x4*)g2)[lane + 64 * j]; v[j] = v[j] * r * g; }
        float a[8];
#pragma unroll
        for (int e = 0; e < 8; ++e) a[e] = 0.f;
#pragma unroll
        for (int j = 0; j < 8; ++j)
#pragma unroll
            for (int i = 0; i < 4; ++i) { const int c = 4 * lane + 256 * j + i; const f32x4 w0 = *(const f32x4*)(wrg + (size_t)c * 8), w1 = *(const f32x4*)(wrg + (size_t)c * 8 + 4); const float h = v[j][i];
#pragma unroll
                for (int e = 0; e < 4; ++e) { a[e] += h * w0[e]; a[4 + e] += h * w1[e]; }
                if (i == 3) __builtin_amdgcn_sched_barrier(0); }
        int gsel = 0; float gmax = -3.0e38f;
#pragma unroll
        for (int e = 0; e < 8; ++e) { a[e] = wave_sum(a[e]) + brg[e]; if (a[e] > gmax) { gmax = a[e]; gsel = e; } }
        float gden = 0.f;
#pragma unroll
        for (int e = 0; e < 8; ++e) gden += __expf(a[e] - gmax);
        const float pg = 1.0f / gden;
        gsel = __builtin_amdgcn_readfirstlane(gsel);
#pragma unroll
        for (int e = 0; e < 8; ++e) a[e] = 0.f;
#pragma unroll
        for (int j = 0; j < 8; ++j)
#pragma unroll
            for (int i = 0; i < 4; ++i) { const int c = 4 * lane + 256 * j + i; const f32x4 w0 = *(const f32x4*)(wre + (size_t)c * 64 + gsel * 8), w1 = *(const f32x4*)(wre + (size_t)c * 64 + gsel * 8 + 4); const float h = v[j][i];
#pragma unroll
                for (int e = 0; e < 4; ++e) { a[e] += h * w0[e]; a[4 + e] += h * w1[e]; }
                if (i == 3) __builtin_amdgcn_sched_barrier(0); }
        int i1 = 0; float v1 = -3.0e38f;
#pragma unroll
        for (int e = 0; e < 8; ++e) { a[e] = wave_sum(a[e]) + bre[gsel * 8 + e]; if (a[e] > v1) { v1 = a[e]; i1 = e; } }
        int i2 = 0; float v2 = -3.0e38f;
#pragma unroll
        for (int e = 0; e < 8; ++e) { if (e != i1 && a[e] > v2) { v2 = a[e]; i2 = e; } }
        const float e2 = __expf(v2 - v1), p1 = 1.0f / (1.0f + e2), p2 = e2 * p1;
        if (lane == 0) {
            const int ea = gsel * 8 + i1, eb = gsel * 8 + i2;
            EID[row * 2] = ea; EID[row * 2 + 1] = eb; GWT[row * 2] = pg * p1; GWT[row * 2 + 1] = pg * p2; R2[row] = r;
            atomicAdd(&cnt[ea], 1u); atomicAdd(&cnt[eb], 1u);
        }
    }
    LAS unsigned* scr = (LAS unsigned*)(F.lds + F.wave * 8192);
    constexpr int I_G = NE * 32 * 8, I_D = NE * 8 * 32;
    for (int it = gw; it < 2 * I_G + I_D; it += NGW) {
        int r_ = it;
        if (r_ < 2 * I_G) { const int up = r_ >= I_G; if (up) r_ -= I_G; const int e = r_ >> 8, rem = r_ & 255;
            const float* W = (up ? A.in[15] : A.in[14]) + (size_t)e * D * FF; bf16_t* WT = (bf16_t*)(F.ws + WS_WGU) + (size_t)e * 1024 * D;
            if (up) cvt_item<2>(W, FF, D, WT, g2, scr, rem >> 3, rem & 7, lane); else cvt_item<1>(W, FF, D, WT, g2, scr, rem >> 3, rem & 7, lane);
            continue; }
        r_ -= 2 * I_G; { const int e = r_ >> 8, rem = r_ & 255;
            cvt_item<0>(A.in[16] + (size_t)e * FF * D, D, FF, (bf16_t*)(F.ws + WS_WD) + (size_t)e * D * FF, nullptr, scr, rem >> 5, rem & 31, lane); }
    }
}

DI int moe_tables(Frame& F, LAS int* rbe, LAS int* bstart) {
    const unsigned* cnt = (const unsigned*)(F.ws + WS_CTL) + CW_CNT;
    __syncthreads();
    if (F.tid == 0) {
        int acc = 0;
        for (int e = 0; e < NE; ++e) { const int c = (int)__hip_atomic_load(cnt + e, __ATOMIC_RELAXED, __HIP_MEMORY_SCOPE_AGENT); const int nb = (c + 255) >> 8; bstart[e] = acc; for (int k = 0; k < nb; ++k) rbe[acc + k] = e; acc += nb; }
        bstart[NE] = acc;
    }
    __syncthreads();
    return bstart[NE];
}

DI void p8_scatter(Frame& F, const Args& A) {
    LAS int* rbe = (LAS int*)(F.lds + LDSCTL_OFF); LAS int* bstart = (LAS int*)(F.lds);
    (void)moe_tables(F, rbe, bstart);
    const int* EID = (const int*)(F.ws + WS_EID); const float* GWT = (const float*)(F.ws + WS_GWT); const float* R2 = (const float*)(F.ws + WS_R2);
    unsigned* fill = (unsigned*)(F.ws + WS_CTL) + CW_FILL;
    int* rowtok = (int*)(F.ws + WS_ROWTOK); int* rowdst = (int*)(F.ws + WS_ROWDST); float* roww = (float*)(F.ws + WS_ROWW); float* rowr2 = (float*)(F.ws + WS_ROWR2);
    for (int a = F.vcu * NTHREADS + F.tid; a < 2 * T; a += F.G * NTHREADS) {
        const int e = EID[a]; const unsigned k = atomicAdd(&fill[e], 1u); const int p = bstart[e] * 256 + (int)k;
        rowtok[p] = a >> 1; rowdst[p] = a; roww[p] = GWT[a]; rowr2[p] = R2[a >> 1];
    }
    __syncthreads();
}

struct EpiGU {
    static constexpr bool PERM = true;
    const float* rowr2; bf16_t* U;
    DI void operator()(const f32x4 (&acc)[2][2][4][2], const pg8::Unit& u, int wr, int wc, int fr, int fq) const {
        const int row0 = u.pm * 256 + wr * 64 + fr, pnr = u.pn & 3;
#pragma unroll
        for (int ai = 0; ai < 2; ++ai)
#pragma unroll
            for (int m = 0; m < 4; ++m) {
                const int p = row0 + ai * 128 + m * 16; const float r = rowr2[p];
#pragma unroll
                for (int bj = 0; bj < 2; ++bj) {
                    const int f0 = 128 * pnr + 64 * bj + 16 * wc + 4 * fq;
                    float o[4];
#pragma unroll
                    for (int e = 0; e < 4; ++e) { const float g = acc[ai][bj][m][0][e] * r, up = acc[ai][bj][m][1][e] * r; o[e] = g * sigmoidf_(g) * up; }
                    u32x2 w; w.x = pg8::cvt_pk_bf16(o[0], o[1]); w.y = pg8::cvt_pk_bf16(o[2], o[3]);
                    *(u32x2*)(U + (size_t)p * FF + f0) = w;
                }
            }
    }
};
struct EpiDown {
    static constexpr bool PERM = true;
    const int* rowdst; const float* roww; bf16_t* YK;
    DI void operator()(const f32x4 (&acc)[2][2][4][2], const pg8::Unit& u, int wr, int wc, int fr, int fq) const {
        const int row0 = u.pm * 256 + wr * 64 + fr, col0 = (u.pn & 7) * 256 + wc * 32 + 8 * fq;
#pragma unroll
        for (int ai = 0; ai < 2; ++ai)
#pragma unroll
            for (int m = 0; m < 4; ++m) {
                const int p = row0 + ai * 128 + m * 16; const int dst = rowdst[p]; const float w = roww[p];
                if (dst >= 0) {
#pragma unroll
                    for (int bj = 0; bj < 2; ++bj) {
                        const f32x4 a0 = acc[ai][bj][m][0] * w, a1 = acc[ai][bj][m][1] * w;
                        u32x4 o; o.x = pg8::cvt_pk_bf16(a0[0], a0[1]); o.y = pg8::cvt_pk_bf16(a0[2], a0[3]); o.z = pg8::cvt_pk_bf16(a1[0], a1[1]); o.w = pg8::cvt_pk_bf16(a1[2], a1[3]);
                        *(u32x4*)(YK + (size_t)dst * D + col0 + bj * 128) = o;
                    }
                }
            }
    }
};

DI void p11_final(Frame& F, const Args& A) {
    const float* X1 = (const float*)(F.ws + WS_X1); const bf16_t* YK = (const bf16_t*)(F.ws + WS_YK); const float* gf = A.in[17];
    const int gw = F.vcu * NWAVES + F.wave, NGW = F.G * NWAVES, lane = F.lane;
    for (int row = gw; row < T; row += NGW) {
        float v[32]; float ss = 0.f;
#pragma unroll
        for (int j = 0; j < 4; ++j) {
            const int c0 = 512 * j + 8 * lane;
            const f32x4 a0 = *(const f32x4*)(X1 + (size_t)row * D + c0), a1 = *(const f32x4*)(X1 + (size_t)row * D + c0 + 4);
            const u32x4 y0 = *(const u32x4*)(YK + (size_t)(2 * row) * D + c0), y1 = *(const u32x4*)(YK + (size_t)(2 * row + 1) * D + c0);
            v[8 * j + 0] = a0[0] + (bflo(y0.x) + bflo(y1.x)); v[8 * j + 1] = a0[1] + (bfhi(y0.x) + bfhi(y1.x)); v[8 * j + 2] = a0[2] + (bflo(y0.y) + bflo(y1.y)); v[8 * j + 3] = a0[3] + (bfhi(y0.y) + bfhi(y1.y));
            v[8 * j + 4] = a1[0] + (bflo(y0.z) + bflo(y1.z)); v[8 * j + 5] = a1[1] + (bfhi(y0.z) + bfhi(y1.z)); v[8 * j + 6] = a1[2] + (bflo(y0.w) + bflo(y1.w)); v[8 * j + 7] = a1[3] + (bfhi(y0.w) + bfhi(y1.w));
#pragma unroll
            for (int e = 0; e < 8; ++e) ss += v[8 * j + e] * v[8 * j + e];
        }
        const float r = rsqrtf(wave_sum(ss) * (1.0f / D) + EPS);
#pragma unroll
        for (int j = 0; j < 4; ++j) {
            const int c0 = 512 * j + 8 * lane;
            const f32x4 g0 = *(const f32x4*)(gf + c0), g1 = *(const f32x4*)(gf + c0 + 4);
            *(f32x4*)(F.out + (size_t)row * D + c0) = (f32x4){v[8 * j] * r * g0[0], v[8 * j + 1] * r * g0[1], v[8 * j + 2] * r * g0[2], v[8 * j + 3] * r * g0[3]};
            *(f32x4*)(F.out + (size_t)row * D + c0 + 4) = (f32x4){v[8 * j + 4] * r * g1[0], v[8 * j + 5] * r * g1[1], v[8 * j + 6] * r * g1[2], v[8 * j + 7] * r * g1[3]};
        }
    }
}

constexpr int N_PHASES = 12;
__global__ void __launch_bounds__(NTHREADS, 2) fwd(Args args) {
    extern __shared__ __attribute__((aligned(16))) unsigned char lds_raw[];
    Frame F;
    F.lds = (LAS unsigned char*)lds_raw;
    F.tid = threadIdx.x; F.lane = F.tid & 63; F.wave = __builtin_amdgcn_readfirstlane(F.tid >> 6);
    F.G = gridDim.x; { const int bx = blockIdx.x; F.vcu = (F.G % 8 == 0) ? (bx % 8) * (F.G / 8) + bx / 8 : bx; }
    F.ws = args.ws; F.out = args.out;
    volatile LAS unsigned* MISC = (volatile LAS unsigned*)(F.lds + MISC_OFF);
    for (int u = F.tid; u < (LDS_BYTES - LDSCTL_OFF) / 4; u += NTHREADS) ((LAS unsigned*)(F.lds + LDSCTL_OFF))[u] = 0u;
    __syncthreads();
    unsigned* ctl = (unsigned*)(F.ws + WS_CTL);
    XcdBarrier bar; bar.bar = ctl + CW_BAR; bar.x = 0; bar.st = nullptr;
    if (MK_N_LAUNCHES == 1) bar = xcd_barrier_post(ctl + CW_BAR, MISC + 8);
#define GRID_BAR() do { if (MK_N_LAUNCHES == 1) xcd_barrier(bar); } while (0)
    const int lo = args.ph_lo, hi = args.ph_hi;
#ifndef PHASE_MASK
#define PHASE_MASK 0xFFF
#endif
#define IN(k) (((PHASE_MASK >> (k)) & 1) && lo <= (k) && (k) < hi)
#define BOTH(k) (IN(k) && IN((k) + 1))

    if (IN(0)) { p0_prologue(F, args); if (BOTH(0)) GRID_BAR(); }
    if (IN(1)) {
        pg8::Gemm g{(const bf16_t*)(F.ws + WS_H), (const bf16_t*)(F.ws + WS_WIN), D, nullptr}; pg8::StaticOrder S; S.init(T, INW, F.G, (int)blockIdx.x);
        EpiProj E{F.ws, args.in[3]};
        pg8::gemm_phase<EpiProj, pg8::StaticOrder, true, true, false>(F.lds, g, S, E);
        if (BOTH(1)) GRID_BAR();
    }
    if (IN(2)) { p2_hgrn_simple(F, args); }
    if (IN(3)) { p3_attn_simple(F, args); if (BOTH(3)) GRID_BAR(); }
    if (IN(4)) { p4_fixups(F, args); if (BOTH(4)) GRID_BAR(); }
    if (IN(5)) {
        {   pg8::Gemm g{(const bf16_t*)(F.ws + WS_YB), (const bf16_t*)(F.ws + WS_WB), 512, nullptr}; pg8::StaticOrder S; S.init(T, D, F.G, (int)blockIdx.x);
            EpiGate<0> E{(const bf16_t*)(F.ws + WS_GB), (bf16_t*)(F.ws + WS_TMP), nullptr};
            pg8::gemm_phase<EpiGate<0>, pg8::StaticOrder, true, true, false>(F.lds, g, S, E); }
        VM_WAIT(); __syncthreads();
        {   pg8::Gemm g{(const bf16_t*)(F.ws + WS_YA), (const bf16_t*)(F.ws + WS_WA), D, nullptr}; pg8::StaticOrder S; S.init(T, D, F.G, (int)blockIdx.x);
            EpiGate<1> E{(const bf16_t*)(F.ws + WS_GA), (bf16_t*)(F.ws + WS_TMP), (bf16_t*)(F.ws + WS_MERGED)};
            pg8::gemm_phase<EpiGate<1>, pg8::StaticOrder, true, true, false>(F.lds, g, S, E); }
        if (BOTH(5)) GRID_BAR();
    }
    if (IN(6)) {
        pg8::Gemm g{(const bf16_t*)(F.ws + WS_MERGED), (const bf16_t*)(F.ws + WS_WOUT), D, nullptr}; pg8::StaticOrder S; S.init(T, D, F.G, (int)blockIdx.x);
        EpiOut E{args.in[0], (float*)(F.ws + WS_X1), (bf16_t*)(F.ws + WS_X1B)};
        pg8::gemm_phase<EpiOut, pg8::StaticOrder, true, true, false>(F.lds, g, S, E);
        if (BOTH(6)) GRID_BAR();
    }
    if (IN(7)) { p7_router(F, args); if (BOTH(7)) GRID_BAR(); }
    if (IN(8)) { p8_scatter(F, args); if (BOTH(8)) GRID_BAR(); }
    if (IN(9)) {
        LAS int* rbe = (LAS int*)(F.lds + LDSCTL_OFF); LAS int* bstart = (LAS int*)(F.lds + LDSCTL_OFF + 768 + 256 + 64);
        const int nrb = moe_tables(F, rbe, bstart);
        pg8::Gemm g{(const bf16_t*)(F.ws + WS_X1B), (const bf16_t*)(F.ws + WS_WGU), D, (const int*)(F.ws + WS_ROWTOK)};
        pg8::MoeOrder S{rbe, nrb, 4, F.G, F.vcu};
        EpiGU E{(const float*)(F.ws + WS_ROWR2), (bf16_t*)(F.ws + WS_U)};
        pg8::gemm_phase<EpiGU, pg8::MoeOrder, true, true, true>(F.lds, g, S, E);
        if (BOTH(9)) GRID_BAR();
    }
    if (IN(10)) {
        LAS int* rbe = (LAS int*)(F.lds + LDSCTL_OFF); LAS int* bstart = (LAS int*)(F.lds + LDSCTL_OFF + 768 + 256 + 64);
        const int nrb = moe_tables(F, rbe, bstart);
        pg8::Gemm g{(const bf16_t*)(F.ws + WS_U), (const bf16_t*)(F.ws + WS_WD), FF, nullptr};
        pg8::MoeOrder S{rbe, nrb, 8, F.G, F.vcu};
        EpiDown E{(const int*)(F.ws + WS_ROWDST), (const float*)(F.ws + WS_ROWW), (bf16_t*)(F.ws + WS_YK)};
        pg8::gemm_phase<EpiDown, pg8::MoeOrder, true, true, false>(F.lds, g, S, E);
        if (BOTH(10)) GRID_BAR();
    }
    if (IN(11)) { p11_final(F, args); }
#undef IN
#undef BOTH
}

extern "C" void kernel_launch(void* const* d_in, const int* in_sizes, int n_in, void* d_out, int out_size, void* d_ws, size_t ws_size, hipStream_t stream) {
    static int grid = 0;
    if (grid == 0) {
        if (n_in != 18 || in_sizes[0] != T * D || out_size != T * D || ws_size < WS_END) { fprintf(stderr, "kernel_launch: unexpected shapes: n_in %d in0 %d out %d ws %zu (need %zu)\n", n_in, n_in > 0 ? in_sizes[0] : -1, out_size, ws_size, (size_t)WS_END); grid = -1; return; }
        int dev = 0, cus = 0, per_cu = 0;
        if (hipGetDevice(&dev) != hipSuccess || hipDeviceGetAttribute(&cus, hipDeviceAttributeMultiprocessorCount, dev) != hipSuccess) { grid = -1; return; }
        if (hipFuncSetAttribute((const void*)fwd, hipFuncAttributeMaxDynamicSharedMemorySize, LDS_BYTES) != hipSuccess) { fprintf(stderr, "kernel_launch: hipFuncSetAttribute failed\n"); grid = -1; return; }
        if (hipOccupancyMaxActiveBlocksPerMultiprocessor(&per_cu, (const void*)fwd, NTHREADS, LDS_BYTES) != hipSuccess || per_cu < 1) fprintf(stderr, "kernel_launch: occupancy query reports %d\n", per_cu);
        (void)hipGetLastError();
        grid = cus;
        fprintf(stderr, "kernel_launch: grid %d, occupancy query %d, ws %zu\n", grid, per_cu, ws_size);
    }
    if (grid < 0) return;
    if (hipMemsetAsync((char*)d_ws + WS_CTL, 0, CTL_ZERO_BYTES, stream) != hipSuccess) return;
    Args a{};
    for (int i = 0; i < 18; ++i) a.in[i] = (const float*)d_in[i];
    a.out = (float*)d_out; a.ws = (unsigned char*)d_ws;
    const int nl = MK_N_LAUNCHES;
    for (int li = 0; li < nl; ++li) {
        a.ph_lo = (nl == 1) ? 0 : li; a.ph_hi = (nl == 1) ? N_PHASES : li + 1; a.li = li; a.pad = 0;
        hipLaunchKernelGGL(fwd, dim3(grid), dim3(NTHREADS), LDS_BYTES, stream, a);
        const hipError_t le = hipPeekAtLastError();
        if (le != hipSuccess) { fprintf(stderr, "kernel_launch: launch %d failed: %s\n", li, hipGetErrorName(le)); break; }
    }
}
```

```cpp
#include <hip/hip_runtime.h>
#include <cstdio>
#include <cstdint>

#ifndef MK_N_LAUNCHES
#define MK_N_LAUNCHES 1
#endif

#define DI __device__ __forceinline__
#define GAS __attribute__((address_space(1)))
#define LAS __attribute__((address_space(3)))
typedef unsigned short bf16_t;
typedef short bf16x8 __attribute__((ext_vector_type(8)));
typedef float f32x4 __attribute__((ext_vector_type(4)));
typedef unsigned u32x4 __attribute__((ext_vector_type(4)));
typedef unsigned u32x2 __attribute__((ext_vector_type(2)));

constexpr int NB = 8, SEQ = 2048, T = NB * SEQ, D = 2048;
constexpr int INW = 16896;
constexpr int NE = 64, FF = 512;
constexpr int PMAX = 49152;
constexpr float EPS = 1e-6f;
constexpr int NWAVES = 8, NTHREADS = 512;

constexpr size_t MiB = 1u << 20;
constexpr size_t WS_CTL = 0, CTL_ZERO_BYTES = 1 * MiB;
constexpr size_t WS_EID = 1 * MiB, WS_GWT = WS_EID + 256 * 1024, WS_R2 = WS_GWT + 256 * 1024;
constexpr size_t WS_ROWTOK = 2 * MiB, WS_ROWDST = WS_ROWTOK + 256 * 1024, WS_ROWW = WS_ROWDST + 256 * 1024, WS_ROWR2 = WS_ROWW + 256 * 1024;
constexpr size_t WS_LSE = 3 * MiB;
constexpr size_t WS_WA = 8 * MiB, WS_WB = 16 * MiB, WS_WOUT = 18 * MiB;
constexpr size_t WS_WIN = 32 * MiB, WS_H = 98 * MiB;
constexpr size_t WS_QA = 162 * MiB, WS_LF = 226 * MiB, WS_IA = 290 * MiB, WS_SG = 354 * MiB;
constexpr size_t WS_QB = 418 * MiB, WS_KB = 466 * MiB, WS_VT = 514 * MiB, WS_GA = 562 * MiB, WS_GB = 626 * MiB;
constexpr size_t WS_OH = 690 * MiB, WS_OG = 754 * MiB;
constexpr size_t WS_YA = 803 * MiB, WS_YB = 867 * MiB, WS_TMP = 883 * MiB, WS_MERGED = 947 * MiB, WS_END = 1011 * MiB;
constexpr size_t WS_X1 = 162 * MiB, WS_X1B = 290 * MiB, WS_WGU = 354 * MiB, WS_WD = 610 * MiB, WS_U = 738 * MiB, WS_YK = 32 * MiB;
static_assert(WS_U + (size_t)PMAX * FF * 2 <= WS_YA, "ws map");
constexpr int CW_BAR = 4096;
constexpr int CW_CNT = 16384;
constexpr int CW_FILL = 16384 + 64;

constexpr int RING_BYTES = 131072;
constexpr int LDSCTL_OFF = RING_BYTES;
constexpr int MISC_OFF = LDSCTL_OFF + 1024;
constexpr int LDS_BYTES = 147456;

DI unsigned f2bf(float f) { unsigned u = __builtin_bit_cast(unsigned, f); return (u + 0x7fffu + ((u >> 16) & 1u)) >> 16; }
DI unsigned pk2(float lo, float hi) { return f2bf(lo) | (f2bf(hi) << 16); }
DI float bflo(unsigned w) { return __builtin_bit_cast(float, w << 16); }
DI float bfhi(unsigned w) { return __builtin_bit_cast(float, w & 0xffff0000u); }
DI float bf1(bf16_t b) { return __builtin_bit_cast(float, (unsigned)b << 16); }
DI float sigmoidf_(float x) { return 1.0f / (1.0f + __expf(-x)); }
#define LDS_WAIT() asm volatile("s_waitcnt lgkmcnt(0)" ::: "memory")
#define VM_WAIT() asm volatile("s_waitcnt vmcnt(0)" ::: "memory")

namespace pg8 {
constexpr int BM = 256, BK = 64, HALF = 128, HTB = HALF * BK * 2, STAGE_BYTES = 8 * HTB, NXCD = 8, WGM = 8;
__host__ __device__ __forceinline__ int lds_byte(int r, int c) { const int st = (r >> 4) * 2 + (c >> 5), rr = r & 15, cc = c & 31, ob = rr * 64 + cc * 2; return st * 1024 + (ob ^ (((ob >> 9) & 1) << 5)); }
__host__ __device__ __forceinline__ void stage_rc(int b, int& R, int& C) { const int st = b / 1024, sb = b % 1024, swz = sb ^ (((sb >> 9) & 1) << 5); R = (st >> 1) * 16 + swz / 64; C = (st & 1) * 32 + (swz % 64) / 2; }
__host__ __device__ __forceinline__ int perm32(int rho) { const int n = rho >> 4, i = rho & 15; return 8 * (i >> 2) + 4 * n + (i & 3); }

struct Unit { int pm, pn; };
struct Gemm { const bf16_t* A; const bf16_t* Bt; int K; const int* rowtok; };

struct StaticOrder {
    int nM, nN, nwg, G, c;
    __host__ __device__ void init(int M, int N, int G_, int c_) { nM = M / BM; nN = N / BM; nwg = nM * nN; G = G_; c = c_; }
    __host__ __device__ bool next(int i, Unit& u) const {
        const long L = (long)i * G + c; if (L >= nwg) return false;
        int wgid = (int)L; { const int q = nwg / NXCD, r = nwg % NXCD, xcd = wgid % NXCD, off = wgid / NXCD; wgid = (xcd < r ? xcd * (q + 1) : r * (q + 1) + (xcd - r) * q) + off; }
        const int nig = WGM * nN, gid = wgid / nig, fm = gid * WGM, gsz = (nM - fm) < WGM ? (nM - fm) : WGM;
        u.pm = fm + ((wgid % nig) % gsz); u.pn = (wgid % nig) / gsz; return true;
    }
};
struct MoeOrder {
    const LAS int* rbe; int nrb, NT, G, vcu;
    DI bool next(int i, Unit& u) const {
        const int L = i * G + vcu; if (L >= nrb * NT) return false;
        const int rb = L / NT, pnr = L - rb * NT; u.pm = rb; u.pn = rbe[rb] * NT + pnr; return true;
    }
};

DI unsigned cvt_pk_bf16(float lo, float hi) { unsigned r; asm volatile("v_cvt_pk_bf16_f32 %0, %1, %2" : "=v"(r) : "v"(lo), "v"(hi)); return r; }

template <class Epi, class Sched, bool ALIGN_EPI, bool SP2, bool GATHER>
DI void gemm_phase(LAS unsigned char* lds, const Gemm g, const Sched& S, const Epi& E) {
    const int tid = threadIdx.x, wid = __builtin_amdgcn_readfirstlane(tid >> 6), lane = tid & 63, wr = wid >> 2, wc = wid & 3, fr = lane & 15, fq = lane >> 4;
    const int K = g.K, nt = K / BK;
    unsigned voffA[2], voffB[2]; int RA[2], CA[2];
#pragma unroll
    for (int i = 0; i < 2; ++i) { int R, C; stage_rc(tid * 16 + i * 8192, R, C); const int Rb = Epi::PERM ? ((R & ~31) + perm32(R & 31)) : R;
        voffA[i] = (unsigned)(R * K + C) * 2u; voffB[i] = (unsigned)(Rb * K + C) * 2u; RA[i] = R; CA[i] = C; }
    const size_t kstep = (size_t)(BK * 2);
    const size_t hstep = (size_t)HALF * K * 2;
    const size_t tstep = 2 * hstep;
    const size_t hstepA = GATHER ? 0 : hstep;
    const unsigned ldsw = (unsigned)wid * 1024u;
    const int aoff = lds_byte(wr * 64 + fr, fq * 8), boff = lds_byte(wc * 32 + fr, fq * 8);
#define PG8_SA(b, h) (((b) * 2 + (h)) * HTB)
#define PG8_SB(b, h) ((4 + (b) * 2 + (h)) * HTB)
#define PG8_STAGE2(bufoff, gbase, v0, v1) do { \
        __builtin_amdgcn_global_load_lds((const unsigned*)((const char*)(gbase) + (v0)), (LAS unsigned*)(lds + (bufoff) + ldsw), 16, 0, 0); \
        __builtin_amdgcn_global_load_lds((const unsigned*)((const char*)(gbase) + (v1)), (LAS unsigned*)(lds + (bufoff) + ldsw + 8192), 16, 0, 0); } while (0)
#define PG8_STAGE(bufoff, gbase, voff) PG8_STAGE2(bufoff, gbase, (voff)[0], (voff)[1])
#define PG8_LDA(dst, b, h) do { _Pragma("unroll") for (int m = 0; m < 4; ++m) _Pragma("unroll") for (int k = 0; k < 2; ++k) dst[m][k] = *(const LAS bf16x8*)(lds + PG8_SA(b, h) + aoff + m * 2048 + k * 1024); } while (0)
#define PG8_LDB(dst, b, h) do { _Pragma("unroll") for (int n = 0; n < 2; ++n) _Pragma("unroll") for (int k = 0; k < 2; ++k) dst[n][k] = *(const LAS bf16x8*)(lds + PG8_SB(b, h) + boff + n * 2048 + k * 1024); } while (0)
#define PG8_MMA(ai, bj, At, Bt) do { __builtin_amdgcn_s_setprio(1); _Pragma("unroll") for (int m = 0; m < 4; ++m) _Pragma("unroll") for (int n = 0; n < 2; ++n) _Pragma("unroll") for (int k = 0; k < 2; ++k) \
        acc[ai][bj][m][n] = __builtin_amdgcn_mfma_f32_16x16x32_bf16(Bt[n][k], At[m][k], acc[ai][bj][m][n], 0, 0, 0); __builtin_amdgcn_s_setprio(0); } while (0)
#define PG8_WAIT_V(n) asm volatile("s_waitcnt vmcnt(" #n ")" ::: "memory")
#define PG8_WAIT_L(n) asm volatile("s_waitcnt lgkmcnt(" #n ")" ::: "memory")
#define PG8_BAR __builtin_amdgcn_s_barrier()
#define PG8_SCHED __builtin_amdgcn_sched_barrier(0)
#define PG8_GATHER(u, dst) do { _Pragma("unroll") for (int _h = 0; _h < 2; ++_h) _Pragma("unroll") for (int _i = 0; _i < 2; ++_i) { \
        const int _tok = g.rowtok[(u).pm * BM + _h * HALF + RA[_i]]; dst[_h][_i] = (unsigned)(_tok * K + CA[_i]) * 2u; } } while (0)
    Unit cur, nxt; int ui = 0;
    if (!S.next(0, cur)) return;
    f32x4 acc[2][2][4][2];
#pragma unroll
    for (int a = 0; a < 2; ++a)
#pragma unroll
        for (int b = 0; b < 2; ++b)
#pragma unroll
            for (int m = 0; m < 4; ++m)
#pragma unroll
                for (int n = 0; n < 2; ++n) acc[a][b][m][n] = (f32x4){0.f, 0.f, 0.f, 0.f};
    bf16x8 At[4][2], B0[2][2], B1[2][2];
    unsigned gC[2][2], gN[2][2];
    if constexpr (GATHER) { PG8_GATHER(cur, gC); } else { gC[0][0] = voffA[0]; gC[0][1] = voffA[1]; gC[1][0] = voffA[0]; gC[1][1] = voffA[1]; }
#pragma unroll
    for (int h = 0; h < 2; ++h) { gN[h][0] = gC[h][0]; gN[h][1] = gC[h][1]; }
    const char* cA = (const char*)g.A + (GATHER ? 0 : (size_t)cur.pm * tstep); const char* cB = (const char*)g.Bt + (size_t)cur.pn * tstep;
    static_assert(SP2, "only the SP2 loop is kept in this file");
    PG8_STAGE(PG8_SB(0, 0), cB, voffB); PG8_STAGE(PG8_SB(0, 1), cB + hstep, voffB); PG8_STAGE2(PG8_SA(0, 0), cA, gC[0][0], gC[0][1]); PG8_STAGE2(PG8_SA(0, 1), cA + hstepA, gC[1][0], gC[1][1]);
    if (wr == 1) PG8_BAR;
    PG8_WAIT_V(2); PG8_BAR;
    PG8_STAGE(PG8_SB(1, 0), cB + kstep, voffB); PG8_STAGE2(PG8_SA(1, 0), cA + kstep, gC[0][0], gC[0][1]); PG8_STAGE(PG8_SB(1, 1), cB + hstep + kstep, voffB);
    PG8_WAIT_V(6); PG8_BAR;
    for (;;) {
        const bool has_next = S.next(ui + 1, nxt);
        const char* nA = (has_next && !GATHER) ? (const char*)g.A + (size_t)nxt.pm * tstep : cA; const char* nB = has_next ? (const char*)g.Bt + (size_t)nxt.pn * tstep : cB;
        if constexpr (GATHER) { if (has_next) { PG8_GATHER(nxt, gN); } else {
#pragma unroll
            for (int h = 0; h < 2; ++h) { gN[h][0] = gC[h][0]; gN[h][1] = gC[h][1]; } } }
        for (int t = 0; t < nt; t += 2) {
            const bool last = (t == nt - 2);
            const char* a1 = cA + (size_t)(t + 1) * kstep;
            const char* a2 = last ? nA : cA + (size_t)(t + 2) * kstep; const char* b2 = last ? nB : cB + (size_t)(t + 2) * kstep;
            const char* a3 = a2 + kstep; const char* b3 = b2 + kstep;
            unsigned x00 = gC[0][0], x01 = gC[0][1], x10 = gC[1][0], x11 = gC[1][1];
            if constexpr (GATHER) { if (last) { x00 = gN[0][0]; x01 = gN[0][1]; x10 = gN[1][0]; x11 = gN[1][1]; } }
            PG8_LDB(B0, 0, 0); PG8_LDB(B1, 0, 1); PG8_SCHED; PG8_LDA(At, 0, 0); PG8_STAGE2(PG8_SA(1, 1), a1 + hstepA, gC[1][0], gC[1][1]);
            PG8_WAIT_V(8); PG8_WAIT_L(0); PG8_BAR; PG8_MMA(0, 0, At, B0); PG8_MMA(0, 1, At, B1); PG8_BAR; PG8_SCHED;
            PG8_LDA(At, 0, 1); PG8_STAGE(PG8_SB(0, 0), b2, voffB); PG8_STAGE(PG8_SB(0, 1), b2 + hstep, voffB); PG8_STAGE2(PG8_SA(0, 0), a2, x00, x01);
            PG8_WAIT_V(8); PG8_WAIT_L(0); PG8_BAR; PG8_MMA(1, 0, At, B0); PG8_MMA(1, 1, At, B1); PG8_BAR; PG8_SCHED;
            PG8_LDB(B0, 1, 0); PG8_LDB(B1, 1, 1); PG8_SCHED; PG8_LDA(At, 1, 0); PG8_STAGE2(PG8_SA(0, 1), a2 + hstepA, x10, x11);
            PG8_WAIT_V(8); PG8_WAIT_L(0); PG8_BAR; PG8_MMA(0, 0, At, B0); PG8_MMA(0, 1, At, B1); PG8_BAR; PG8_SCHED;
            PG8_LDA(At, 1, 1); PG8_STAGE(PG8_SB(1, 0), b3, voffB); PG8_STAGE(PG8_SB(1, 1), b3 + hstep, voffB); PG8_STAGE2(PG8_SA(1, 0), a3, x00, x01);
            PG8_WAIT_V(8); PG8_WAIT_L(0); PG8_BAR; PG8_MMA(1, 0, At, B0); PG8_MMA(1, 1, At, B1); PG8_BAR; PG8_SCHED;
        }
        if constexpr (ALIGN_EPI) { if (wr == 0) PG8_BAR; }
        E(acc, cur, wr, wc, fr, fq);
        if (!has_next) break;
#pragma unroll
        for (int a = 0; a < 2; ++a)
#pragma unroll
            for (int b = 0; b < 2; ++b)
#pragma unroll
                for (int m = 0; m < 4; ++m)
#pragma unroll
                    for (int n = 0; n < 2; ++n) acc[a][b][m][n] = (f32x4){0.f, 0.f, 0.f, 0.f};
        cur = nxt; cA = nA; cB = nB; ++ui;
#pragma unroll
        for (int h = 0; h < 2; ++h) { gC[h][0] = gN[h][0]; gC[h][1] = gN[h][1]; }
        if constexpr (ALIGN_EPI) { if (wr == 1) PG8_BAR; }
    }
    PG8_WAIT_V(0);
    if constexpr (!ALIGN_EPI) { if (wr == 0) PG8_BAR; }
    PG8_BAR;
#undef PG8_SA
#undef PG8_SB
#undef PG8_STAGE
#undef PG8_STAGE2
#undef PG8_LDA
#undef PG8_LDB
#undef PG8_MMA
#undef PG8_WAIT_V
#undef PG8_WAIT_L
#undef PG8_BAR
#undef PG8_SCHED
#undef PG8_GATHER
}
}

#define XB_TMO      128
#define XB_XCNT(j)  (256  + 64 * (j))
#define XB_XSUB(j)  (1280 + 64 * (j))
#define XB_XGEN(j)  (2304 + 64 * (j))
#define XB_TOP      3328
#define XB_TOPGEN   3392
#define XCD_BAR_WORDS 3456
#define XB_SPIN_CAP (1u << 18)
__device__ __forceinline__ unsigned xb_ld(unsigned* p)              { return __hip_atomic_load(p, __ATOMIC_RELAXED, __HIP_MEMORY_SCOPE_AGENT); }
__device__ __forceinline__ unsigned xb_add(unsigned* p, unsigned v) { return __hip_atomic_fetch_add(p, v, __ATOMIC_RELAXED, __HIP_MEMORY_SCOPE_AGENT); }
__device__ __forceinline__ unsigned xb_xcc_id() { return (unsigned)__builtin_amdgcn_s_getreg((3 << 11) | 20) & 0xFu; }
#define XB_SPIN(cond, bar) do { unsigned _sp = 0; while (cond) { __builtin_amdgcn_s_sleep(1); \
    if ((++_sp & 255u) == 0u) { if (xb_ld(&(bar)[XB_TMO])) break; if (_sp > XB_SPIN_CAP) { atomicAdd(&(bar)[XB_TMO], 1u); break; } } } } while (0)
struct XcdBarrier { unsigned* bar; unsigned x; volatile LAS unsigned* st; };
__device__ __forceinline__ XcdBarrier xcd_barrier_post(unsigned* bar, volatile LAS unsigned* st) {
    XcdBarrier b; b.bar = bar; b.x = xb_xcc_id(); b.st = st;
    if (threadIdx.x == 0) (void)xb_add(&bar[XB_XCNT(b.x)], 1u);
    return b;
}
__device__ __forceinline__ void xcd_barrier_complete(unsigned* bar, unsigned x, unsigned& nloc, unsigned& nx) {
    const unsigned G = gridDim.x * gridDim.y * gridDim.z;
    unsigned sum, cnt, mine, sp = 0u;
    for (;;) {
        sum = 0u; cnt = 0u; mine = 0u;
#pragma unroll
        for (unsigned j = 0; j < 16; ++j) { const unsigned c = xb_ld(&bar[XB_XCNT(j)]); sum += c; cnt += (c > 0u) ? 1u : 0u; mine = (j == x) ? c : mine; }
        if (sum == G) break;
        __builtin_amdgcn_s_sleep(1);
        if ((++sp & 255u) == 0u) { if (xb_ld(&bar[XB_TMO])) break; if (sp > XB_SPIN_CAP) { atomicAdd(&bar[XB_TMO], 1u); break; } }
    }
    nloc = mine > 0u ? mine : 1u; nx = cnt > 0u ? cnt : 1u;
}
__device__ __forceinline__ void xcd_barrier(const XcdBarrier& b) {
    asm volatile("s_waitcnt vmcnt(0)" ::: "memory");
    __syncthreads();
    if (threadIdx.x == 0) {
        unsigned* bar = b.bar;
        __builtin_amdgcn_s_waitcnt(0);
        unsigned nloc = b.st[0], nx = b.st[1];
        if (nloc == 0u) { xcd_barrier_complete(bar, b.x, nloc, nx); b.st[0] = nloc; b.st[1] = nx; }
        const unsigned old = xb_add(&bar[XB_XSUB(b.x)], 1u);
        const unsigned gen = old / nloc;
        if (old + 1u == (gen + 1u) * nloc) {
            __builtin_amdgcn_fence(__ATOMIC_RELEASE, "agent");
            asm volatile("s_waitcnt vmcnt(0)" ::: "memory");
            const unsigned og = xb_add(&bar[XB_TOP], 1u);
            const unsigned tg = og / nx;
            if (og + 1u == (tg + 1u) * nx) xb_add(&bar[XB_TOPGEN], 1u);
            else XB_SPIN(xb_ld(&bar[XB_TOPGEN]) == tg, bar);
            __builtin_amdgcn_fence(__ATOMIC_ACQUIRE, "agent");
            xb_add(&bar[XB_XGEN(b.x)], 1u);
            asm volatile("s_waitcnt vmcnt(0)" ::: "memory");
        } else {
            XB_SPIN(xb_ld(&bar[XB_XGEN(b.x)]) == gen, bar);
            __builtin_amdgcn_fence(__ATOMIC_ACQUIRE, "agent");
            asm volatile("s_waitcnt vmcnt(0)" ::: "memory");
        }
    }
    __syncthreads();
}

struct Frame {
    LAS unsigned char* lds;
    int tid, lane, wave, vcu, G;
    unsigned char* ws;
    float* out;
};
struct Args { const float* in[18]; float* out; unsigned char* ws; int ph_lo, ph_hi, li, pad; };
DI float wave_sum(float v) {
#pragma unroll
    for (int o = 1; o < 64; o <<= 1) v += __shfl_xor(v, o);
    return v;
}
DI float wave_max(float v) {
#pragma unroll
    for (int o = 1; o < 64; o <<= 1) v = fmaxf(v, __shfl_xor(v, o));
    return v;
}

template <int MAP>
DI void cvt_item(const float* W, int N, int K, bf16_t* WT, const float* gain, LAS unsigned* scr, int kb, int nb, int lane) {
    const int nq = lane & 15, kr = lane >> 4, k0 = kb * 64, n0 = nb * 64;
    f32x4 v[8][2];
#pragma unroll
    for (int j = 0; j < 8; ++j)
#pragma unroll
        for (int e = 0; e < 2; ++e) v[j][e] = *(const f32x4*)(W + (size_t)(k0 + 8 * j + 2 * kr + e) * N + n0 + 4 * nq);
    if (gain) {
#pragma unroll
        for (int j = 0; j < 8; ++j) { const float g0 = gain[k0 + 8 * j + 2 * kr], g1 = gain[k0 + 8 * j + 2 * kr + 1]; v[j][0] = v[j][0] * g0; v[j][1] = v[j][1] * g1; }
    }
#pragma unroll
    for (int j = 0; j < 8; ++j)
#pragma unroll
        for (int i = 0; i < 4; ++i) scr[(4 * nq + i) * 32 + ((j ^ (nq & 7)) << 2) + kr] = pk2(v[j][0][i], v[j][1][i]);
    LDS_WAIT(); asm volatile("" ::: "memory");
#pragma unroll
    for (int jj = 0; jj < 8; ++jj) {
        const int nl = (lane >> 3) + 8 * jj, c = lane & 7;
        const u32x4 o = *(const LAS u32x4*)(scr + nl * 32 + ((c ^ ((nl >> 2) & 7)) << 2));
        const int n = n0 + nl;
        const int row = (MAP == 0) ? n : ((n >> 2) * 8 + (MAP == 2 ? 4 : 0) + (n & 3));
        *(u32x4*)(WT + (size_t)row * K + k0 + 8 * c) = o;
    }
    LDS_WAIT(); asm volatile("" ::: "memory");
}

DI void p0_prologue(Frame& F, const Args& A) {
    LAS unsigned* scr = (LAS unsigned*)(F.lds + F.wave * 8192);
    const int gw = F.vcu * NWAVES + F.wave, NGW = F.G * NWAVES;
    constexpr int I_IN = 32 * 264, I_A = 32 * 32, I_B = 8 * 32, I_O = 32 * 32;
    for (int it = gw; it < I_IN + I_A + I_B + I_O; it += NGW) {
        int r = it;
        if (r < I_IN) { cvt_item<0>(A.in[2], INW, D, (bf16_t*)(F.ws + WS_WIN), nullptr, scr, r / 264, r % 264, F.lane); continue; } r -= I_IN;
        if (r < I_A) { cvt_item<0>(A.in[6], D, D, (bf16_t*)(F.ws + WS_WA), nullptr, scr, r / 32, r % 32, F.lane); continue; } r -= I_A;
        if (r < I_B) { cvt_item<0>(A.in[7], D, 512, (bf16_t*)(F.ws + WS_WB), nullptr, scr, r / 32, r % 32, F.lane); continue; } r -= I_B;
        cvt_item<0>(A.in[8], D, D, (bf16_t*)(F.ws + WS_WOUT), nullptr, scr, r / 32, r % 32, F.lane);
    }
    const float* x = A.in[0]; const float* g1 = A.in[1]; bf16_t* H = (bf16_t*)(F.ws + WS_H);
    for (int row = gw; row < T; row += NGW) {
        const f32x4* xr = (const f32x4*)(x + (size_t)row * D) + F.lane;
        f32x4 v[8]; float ss = 0.f;
#pragma unroll
        for (int j = 0; j < 8; ++j) { v[j] = xr[64 * j]; ss += (v[j][0] * v[j][0] + v[j][1] * v[j][1]) + (v[j][2] * v[j][2] + v[j][3] * v[j][3]); }
        const float r = rsqrtf(wave_sum(ss) * (1.0f / D) + EPS);
        u32x2* o = (u32x2*)(H + (size_t)row * D) + F.lane;
#pragma unroll
        for (int j = 0; j < 8; ++j) { const f32x4 g = ((const f32x4*)g1)[F.lane + 64 * j]; u32x2 w; w.x = pk2(v[j][0] * r * g[0], v[j][1] * r * g[1]); w.y = pk2(v[j][2] * r * g[2], v[j][3] * r * g[3]); o[64 * j] = w; }
    }
}

struct EpiProj {
    static constexpr bool PERM = true;
    unsigned char* ws; const float* lbl;
    DI void operator()(const f32x4 (&acc)[2][2][4][2], const pg8::Unit& u, int wr, int wc, int fr, int fq) const {
        const int pn = u.pn, row0 = u.pm * 256 + wr * 64 + fr, cw = wc * 32 + 8 * fq;
        if (pn < 32 || pn >= 50) {
            size_t off; int tile, mode;
            if (pn < 8) { off = WS_QA; tile = pn; mode = 0; } else if (pn < 16) { off = WS_LF; tile = pn - 8; mode = 1; } else if (pn < 24) { off = WS_IA; tile = pn - 16; mode = 0; }
            else if (pn < 32) { off = WS_SG; tile = pn - 24; mode = 2; } else if (pn < 58) { off = WS_GA; tile = pn - 50; mode = 2; } else { off = WS_GB; tile = pn - 58; mode = 2; }
            bf16_t* base = (bf16_t*)(ws + off);
#pragma unroll
            for (int bj = 0; bj < 2; ++bj) {
                const int col = tile * 256 + bj * 128 + cw;
                float lb[8];
                if (mode == 1) {
#pragma unroll
                    for (int e = 0; e < 8; ++e) lb[e] = 1.0f / (1.0f + __expf(lbl[2048 + col + e] - lbl[col + e]));
                }
#pragma unroll
                for (int ai = 0; ai < 2; ++ai)
#pragma unroll
                    for (int m = 0; m < 4; ++m) {
                        const int row = row0 + ai * 128 + m * 16;
                        float v[8];
#pragma unroll
                        for (int e = 0; e < 4; ++e) { v[e] = acc[ai][bj][m][0][e]; v[4 + e] = acc[ai][bj][m][1][e]; }
                        if (mode == 1) {
#pragma unroll
                            for (int e = 0; e < 8; ++e) v[e] = __logf(lb[e] + (1.0f - lb[e]) * sigmoidf_(v[e]));
                        } else if (mode == 2) {
#pragma unroll
                            for (int e = 0; e < 8; ++e) v[e] = sigmoidf_(v[e]);
                        }
                        u32x4 w; w.x = pg8::cvt_pk_bf16(v[0], v[1]); w.y = pg8::cvt_pk_bf16(v[2], v[3]); w.z = pg8::cvt_pk_bf16(v[4], v[5]); w.w = pg8::cvt_pk_bf16(v[6], v[7]);
                        *(u32x4*)(base + (size_t)row * D + col) = w;
                    }
            }
        } else {
            const int a = pn - 32, kind = a / 6, ht = a - kind * 6;
#pragma unroll
            for (int bj = 0; bj < 2; ++bj) {
                const int head = ht * 2 + bj, sh = 2 * (head >> 2);
#pragma unroll
                for (int ai = 0; ai < 2; ++ai)
#pragma unroll
                    for (int m = 0; m < 4; ++m) {
                        const int row = row0 + ai * 128 + m * 16, b = row >> 11, s = row & 2047;
                        const int pos = ((s & ((1 << sh) - 1)) << (11 - sh)) + (s >> sh);
                        float v[8];
#pragma unroll
                        for (int e = 0; e < 4; ++e) { v[e] = acc[ai][bj][m][0][e]; v[4 + e] = acc[ai][bj][m][1][e]; }
                        if (kind < 2) {
                            const float sc = (kind == 0) ? 0.08838834764831845f : 1.0f;
                            u32x4 w; w.x = pg8::cvt_pk_bf16(v[0] * sc, v[1] * sc); w.y = pg8::cvt_pk_bf16(v[2] * sc, v[3] * sc); w.z = pg8::cvt_pk_bf16(v[4] * sc, v[5] * sc); w.w = pg8::cvt_pk_bf16(v[6] * sc, v[7] * sc);
                            bf16_t* base = (bf16_t*)(ws + (kind == 0 ? WS_QB : WS_KB));
                            *(u32x4*)(base + ((size_t)(b * 12 + head) * 2048 + pos) * 128 + cw) = w;
                        } else {
                            bf16_t* base = (bf16_t*)(ws + WS_VT) + ((size_t)(b * 12 + head) * 128 + cw) * 2048 + pos;
#pragma unroll
                            for (int e = 0; e < 8; ++e) base[(size_t)e * 2048] = (bf16_t)f2bf(v[e]);
                        }
                    }
            }
        }
    }
};

DI void p2_hgrn_simple(Frame& F, const Args& A) {
    LAS float* qs = (LAS float*)F.lds; LAS float* fs = qs + 16 * 128; LAS float* is = fs + 16 * 128; LAS float* red = is + 16 * 128;
    const bf16_t* QA = (const bf16_t*)(F.ws + WS_QA); const bf16_t* LF = (const bf16_t*)(F.ws + WS_LF); const bf16_t* IA = (const bf16_t*)(F.ws + WS_IA); bf16_t* OH = (bf16_t*)(F.ws + WS_OH);
    const int tid = F.tid, v = tid & 127, kq = __builtin_amdgcn_readfirstlane(tid >> 7), lt = tid >> 5, c4 = tid & 31;
    for (int item = F.vcu; item < 128; item += F.G) {
        const int b = item >> 4, h = item & 15;
        float S[32];
#pragma unroll
        for (int k = 0; k < 32; ++k) S[k] = 0.f;
        for (int t0 = 0; t0 < SEQ; t0 += 16) {
            {
                const size_t g = ((size_t)(b * SEQ + t0 + lt)) * D + h * 128 + 4 * c4;
                const u32x2 q2 = *(const u32x2*)(QA + g), f2 = *(const u32x2*)(LF + g), i2 = *(const u32x2*)(IA + g);
                *(LAS f32x4*)(qs + lt * 128 + 4 * c4) = (f32x4){bflo(q2.x), bfhi(q2.x), bflo(q2.y), bfhi(q2.y)};
                *(LAS f32x4*)(fs + lt * 128 + 4 * c4) = (f32x4){__expf(bflo(f2.x)), __expf(bfhi(f2.x)), __expf(bflo(f2.y)), __expf(bfhi(f2.y))};
                *(LAS f32x4*)(is + lt * 128 + 4 * c4) = (f32x4){bflo(i2.x), bfhi(i2.x), bflo(i2.y), bfhi(i2.y)};
            }
            __syncthreads();
#pragma unroll 2
            for (int t = 0; t < 16; ++t) {
                const float iv = is[t * 128 + v]; float o = 0.f;
#pragma unroll
                for (int k4 = 0; k4 < 8; ++k4) {
                    const f32x4 f = *(const LAS f32x4*)(fs + t * 128 + kq * 32 + 4 * k4), q = *(const LAS f32x4*)(qs + t * 128 + kq * 32 + 4 * k4);
#pragma unroll
                    for (int e = 0; e < 4; ++e) { float s = S[4 * k4 + e]; s = iv + f[e] * (s - iv); S[4 * k4 + e] = s; o += s * q[e]; }
                }
                red[(kq * 16 + t) * 128 + v] = o;
            }
            __syncthreads();
            {
                f32x4 s = *(const LAS f32x4*)(red + (0 * 16 + lt) * 128 + 4 * c4);
#pragma unroll
                for (int q = 1; q < 4; ++q) s = s + *(const LAS f32x4*)(red + (q * 16 + lt) * 128 + 4 * c4);
                u32x2 w; w.x = pk2(s[0], s[1]); w.y = pk2(s[2], s[3]);
                *(u32x2*)(OH + ((size_t)(b * SEQ + t0 + lt)) * D + h * 128 + 4 * c4) = w;
            }
        }
        __syncthreads();
    }
}

DI int t5_bucket(int dist) {
    if (dist < 16) return dist;
    int b = 16;
    b += (dist >= 22); b += (dist >= 30); b += (dist >= 40); b += (dist >= 54); b += (dist >= 73); b += (dist >= 99); b += (dist >= 134); b += (dist >= 182);
    b += (dist >= 246); b += (dist >= 332); b += (dist >= 450); b += (dist >= 609); b += (dist >= 825); b += (dist >= 1117); b += (dist >= 1513);
    return b;
}
DI void p3_attn_simple(Frame& F, const Args& A) {
    const bf16_t* QB = (const bf16_t*)(F.ws + WS_QB); const bf16_t* KB = (const bf16_t*)(F.ws + WS_KB); const bf16_t* VT = (const bf16_t*)(F.ws + WS_VT);
    bf16_t* OG = (bf16_t*)(F.ws + WS_OG); float* LSE = (float*)(F.ws + WS_LSE); const float* relb = A.in[5];
    LAS float* pb = (LAS float*)F.lds + F.wave * 320; LAS float* qf = pb + 192;
    const int gw = F.vcu * NWAVES + F.wave, NGW = F.G * NWAVES, lane = F.lane;
    for (int idx = gw; idx < NB * 12 * SEQ; idx += NGW) {
        const int pos = idx & 2047, bh = idx >> 11, head = bh % 12, b = bh / 12, g = head >> 2, sh = 2 * g;
        const int r = pos >> (11 - sh), l = pos & ((2048 >> sh) - 1), s = (l << sh) + r;
        { const unsigned qw = *(const unsigned*)(QB + (size_t)idx * 128 + 2 * lane); qf[2 * lane] = bflo(qw); qf[2 * lane + 1] = bfhi(qw); }
        LDS_WAIT(); asm volatile("" ::: "memory");
        float mx = -3.0e38f;
#pragma unroll 1
        for (int rr = 0; rr < 3; ++rr) {
            const int j = rr * 64 + lane; const bool valid = (j <= 128) && (j <= l);
            const bf16_t* kp = KB + (size_t)(valid ? idx - j : idx) * 128;
            float d = 0.f;
#pragma unroll
            for (int i = 0; i < 16; ++i) { const u32x4 k = *(const u32x4*)(kp + 8 * i); const f32x4 qa = *(const LAS f32x4*)(qf + 8 * i), qb = *(const LAS f32x4*)(qf + 8 * i + 4);
                d += qa[0] * bflo(k.x) + qa[1] * bfhi(k.x) + qa[2] * bflo(k.y) + qa[3] * bfhi(k.y)
                   + qb[0] * bflo(k.z) + qb[1] * bfhi(k.z) + qb[2] * bflo(k.w) + qb[3] * bfhi(k.w); }
            const float bias = relb[t5_bucket((valid ? j : 0) << sh) * 12 + head];
            const float lgv = valid ? d + bias : -3.0e38f;
            pb[rr * 64 + lane] = lgv;
            mx = fmaxf(mx, lgv);
        }
        mx = wave_max(mx);
        float den = 0.f;
#pragma unroll 1
        for (int rr = 0; rr < 3; ++rr) { const float lgv = pb[rr * 64 + lane]; const float p = (lgv > -1.0e38f) ? __expf(lgv - mx) : 0.f; den += p; pb[rr * 64 + lane] = p; }
        den = wave_sum(den);
        LDS_WAIT(); asm volatile("" ::: "memory");
        const int nk = (l < 128 ? l : 128) + 1;
        const bf16_t* v0 = VT + ((size_t)(b * 12 + head) * 128 + lane) * 2048 + pos;
        const bf16_t* v1 = v0 + (size_t)64 * 2048;
        float o0 = 0.f, o1 = 0.f;
        for (int j = 0; j < nk; ++j) { const float p = pb[j]; o0 += p * bf1(*(v0 - j)); o1 += p * bf1(*(v1 - j)); }
        const float inv = 1.0f / den;
        const size_t orow = (size_t)g * T + (size_t)b * SEQ + s;
        OG[orow * 512 + (head & 3) * 128 + lane] = (bf16_t)f2bf(o0 * inv);
        OG[orow * 512 + (head & 3) * 128 + 64 + lane] = (bf16_t)f2bf(o1 * inv);
        if (lane == 0) LSE[orow * 4 + (head & 3)] = mx + __logf(den);
        LDS_WAIT(); asm volatile("" ::: "memory");
    }
}

typedef float f32x16 __attribute__((ext_vector_type(16)));
typedef __bf16 bf16x2_t __attribute__((ext_vector_type(2)));
typedef float f32x2_t __attribute__((ext_vector_type(2)));
DI unsigned cvtpk_s(float lo, float hi) { f32x2_t v = {lo, hi}; bf16x2_t b = __builtin_convertvector(v, bf16x2_t); return __builtin_bit_cast(unsigned, b); }
DI int crow(int reg, int h) { return (reg & 3) + 8 * (reg >> 2) + 4 * h; }
DI bf16x8 pack_step(const f32x16& x, int s) {
    u32x4 p; p.x = cvtpk_s(x[8 * s], x[8 * s + 1]); p.y = cvtpk_s(x[8 * s + 2], x[8 * s + 3]); p.z = cvtpk_s(x[8 * s + 4], x[8 * s + 5]); p.w = cvtpk_s(x[8 * s + 6], x[8 * s + 7]);
    return __builtin_bit_cast(bf16x8, p);
}
#define MFMA32(a, b, c) __builtin_amdgcn_mfma_f32_32x32x16_bf16((a), (b), (c), 0, 0, 0)
DI void p3_attn_mfma(Frame& F, const Args& A) {
    const bf16_t* QB = (const bf16_t*)(F.ws + WS_QB); const bf16_t* KB = (const bf16_t*)(F.ws + WS_KB); const bf16_t* VT = (const bf16_t*)(F.ws + WS_VT);
    bf16_t* OG = (bf16_t*)(F.ws + WS_OG); float* LSE = (float*)(F.ws + WS_LSE); const float* relb = A.in[5];
    LAS float* tb = (LAS float*)F.lds + F.wave * 256;
    const int gw = F.vcu * NWAVES + F.wave, NGW = F.G * NWAVES, lane = F.lane, r32 = lane & 31, h = lane >> 5;
    for (int u = gw; u < NB * 12 * 64; u += NGW) {
        const int bh = u >> 6, qt = u & 63, head = bh % 12, b = bh / 12, g = head >> 2, sh = 2 * g;
        const int pos0 = qt * 32, r = pos0 >> (11 - sh), l0 = pos0 & ((2048 >> sh) - 1), cbase = pos0 - l0;
#pragma unroll
        for (int k = 0; k < 3; ++k) { const int j = lane + 64 * k; tb[32 + j] = (j <= 128) ? relb[t5_bucket(j << sh) * 12 + head] : 0.f; }
        if (lane < 32) tb[lane] = 0.f;
        LDS_WAIT(); asm volatile("" ::: "memory");
        bf16x8 qf[8];
        { const bf16_t* qp = QB + ((size_t)bh * 2048 + pos0 + r32) * 128 + 8 * h; asm volatile("" : "+v"(qp));
#pragma unroll
          for (int st = 0; st < 8; ++st) qf[st] = *(const bf16x8*)(qp + 16 * st); }
        const bf16_t* kbase = KB + ((size_t)bh * 2048 + cbase + (l0 - 128) + r32) * 128 + 8 * h; asm volatile("" : "+v"(kbase));
        f32x16 S[5];
        float mx = -3.0e38f;
        int rq = r32; asm volatile("" : "+v"(rq));
#pragma unroll
        for (int t = 0; t < 5; ++t) {
            const int k0 = l0 - 128 + 32 * t;
            if (k0 >= 0) {
                const bf16_t* kp = kbase + t * (32 * 128);
                f32x16 acc;
#pragma unroll
                for (int i = 0; i < 16; ++i) acc[i] = 0.f;
#pragma unroll
                for (int st = 0; st < 8; ++st) acc = MFMA32(*(const bf16x8*)(kp + 16 * st), qf[st], acc);
#pragma unroll
                for (int i = 0; i < 16; ++i) {
                    const int key = crow(i, h); const int delta = 128 - 32 * t + rq - key;
                    const float v = acc[i] + tb[32 + delta];
                    const bool valid = (t == 0) ? (key >= rq) : ((t == 4) ? (key <= rq) : true);
                    S[t][i] = valid ? v : -3.0e38f; mx = fmaxf(mx, S[t][i]);
                }
            }
            __builtin_amdgcn_sched_barrier(0);
        }
        mx = fmaxf(mx, __shfl_xor(mx, 32));
        float den = 0.f;
#pragma unroll
        for (int t = 0; t < 5; ++t) {
            const int k0 = l0 - 128 + 32 * t;
            if (k0 >= 0) {
#pragma unroll
                for (int i = 0; i < 16; ++i) { const float p = (S[t][i] > -1.0e38f) ? __expf(S[t][i] - mx) : 0.f; S[t][i] = p; den += p; }
            }
        }
        den += __shfl_xor(den, 32);
        const float inv = 1.0f / den;
        u32x4 Pp[5][2];
#pragma unroll
        for (int t = 0; t < 5; ++t) {
            const int k0 = l0 - 128 + 32 * t;
            if (k0 >= 0) {
#pragma unroll
                for (int s2 = 0; s2 < 2; ++s2) {
                    Pp[t][s2].x = cvtpk_s(S[t][8 * s2] * inv, S[t][8 * s2 + 1] * inv); Pp[t][s2].y = cvtpk_s(S[t][8 * s2 + 2] * inv, S[t][8 * s2 + 3] * inv);
                    Pp[t][s2].z = cvtpk_s(S[t][8 * s2 + 4] * inv, S[t][8 * s2 + 5] * inv); Pp[t][s2].w = cvtpk_s(S[t][8 * s2 + 6] * inv, S[t][8 * s2 + 7] * inv);
                }
            }
        }
        __builtin_amdgcn_sched_barrier(0);
        f32x16 O[4];
        const bf16_t* vbp[4];
#pragma unroll
        for (int db = 0; db < 4; ++db) { vbp[db] = VT + ((size_t)bh * 128 + db * 32 + r32) * 2048 + (cbase + l0 - 128 + 4 * h); asm volatile("" : "+v"(vbp[db]));
#pragma unroll
            for (int i = 0; i < 16; ++i) O[db][i] = 0.f; }
#pragma unroll
        for (int t = 0; t < 5; ++t) {
            const int k0 = l0 - 128 + 32 * t;
            if (k0 >= 0) {
#pragma unroll
                for (int s2 = 0; s2 < 2; ++s2) {
                    const bf16x8 pa = __builtin_bit_cast(bf16x8, Pp[t][s2]);
#pragma unroll
                    for (int db = 0; db < 4; ++db) {
                        const bf16_t* vp = vbp[db] + (32 * t + 16 * s2);
                        const u32x2 lo = *(const u32x2*)vp, hi = *(const u32x2*)(vp + 8);
                        u32x4 vv; vv.x = lo.x; vv.y = lo.y; vv.z = hi.x; vv.w = hi.y;
                        O[db] = MFMA32(pa, __builtin_bit_cast(bf16x8, vv), O[db]);
                    }
                }
            }
            __builtin_amdgcn_sched_barrier(0);
        }
        const size_t obase = (size_t)g * T + (size_t)b * SEQ;
#pragma unroll
        for (int i = 0; i < 16; ++i) {
            const int l = l0 + crow(i, h); const int tok = (l << sh) + r;
            bf16_t* op = OG + (obase + tok) * 512 + (head & 3) * 128 + r32;
#pragma unroll
            for (int db = 0; db < 4; ++db) op[db * 32] = (bf16_t)f2bf(O[db][i]);
        }
        if (h == 0) { const int tok = ((l0 + r32) << sh) + r; LSE[(obase + tok) * 4 + (head & 3)] = mx + __logf(den); }
        LDS_WAIT(); asm volatile("" ::: "memory");
    }
}

DI void p4_fixups(Frame& F, const Args& A) {
    const bf16_t* OH = (const bf16_t*)(F.ws + WS_OH); const bf16_t* SG = (const bf16_t*)(F.ws + WS_SG); const float* hg = A.in[4];
    const bf16_t* OG = (const bf16_t*)(F.ws + WS_OG); const float* LSE = (const float*)(F.ws + WS_LSE);
    bf16_t* YA = (bf16_t*)(F.ws + WS_YA); bf16_t* YB = (bf16_t*)(F.ws + WS_YB);
    const int gw = F.vcu * NWAVES + F.wave, NGW = F.G * NWAVES, lane = F.lane;
    for (int row = gw; row < T; row += NGW) {
#pragma unroll
        for (int j = 0; j < 4; ++j) {
            const int c0 = 512 * j + 8 * lane;
            const u32x4 o = *(const u32x4*)(OH + (size_t)row * D + c0), sg = *(const u32x4*)(SG + (size_t)row * D + c0);
            float v[8] = {bflo(o.x), bfhi(o.x), bflo(o.y), bfhi(o.y), bflo(o.z), bfhi(o.z), bflo(o.w), bfhi(o.w)};
            const float s[8] = {bflo(sg.x), bfhi(sg.x), bflo(sg.y), bfhi(sg.y), bflo(sg.z), bfhi(sg.z), bflo(sg.w), bfhi(sg.w)};
            float ss = 0.f;
#pragma unroll
            for (int e = 0; e < 8; ++e) ss += v[e] * v[e];
            ss += __shfl_xor(ss, 1); ss += __shfl_xor(ss, 2); ss += __shfl_xor(ss, 4); ss += __shfl_xor(ss, 8);
            const float rinv = rsqrtf(ss * (1.0f / 128.0f) + EPS);
            const f32x4 g0 = *(const f32x4*)(hg + c0), g1 = *(const f32x4*)(hg + c0 + 4);
#pragma unroll
            for (int e = 0; e < 4; ++e) { v[e] = v[e] * rinv * g0[e] * s[e]; v[4 + e] = v[4 + e] * rinv * g1[e] * s[4 + e]; }
            u32x4 w; w.x = pk2(v[0], v[1]); w.y = pk2(v[2], v[3]); w.z = pk2(v[4], v[5]); w.w = pk2(v[6], v[7]);
            *(u32x4*)(YA + (size_t)row * D + c0) = w;
        }
        {
            const int c0 = 8 * lane, hs = lane >> 4;
            const float l0 = LSE[((size_t)0 * T + row) * 4 + hs], l1 = LSE[((size_t)1 * T + row) * 4 + hs], l2 = LSE[((size_t)2 * T + row) * 4 + hs];
            const float mx = fmaxf(l0, fmaxf(l1, l2)); float a0 = __expf(l0 - mx), a1 = __expf(l1 - mx), a2 = __expf(l2 - mx);
            const float inv = 1.0f / (a0 + a1 + a2); a0 *= inv; a1 *= inv; a2 *= inv;
            const u32x4 x0 = *(const u32x4*)(OG + ((size_t)0 * T + row) * 512 + c0), x1 = *(const u32x4*)(OG + ((size_t)1 * T + row) * 512 + c0), x2 = *(const u32x4*)(OG + ((size_t)2 * T + row) * 512 + c0);
            u32x4 w;
            w.x = pk2(a0 * bflo(x0.x) + a1 * bflo(x1.x) + a2 * bflo(x2.x), a0 * bfhi(x0.x) + a1 * bfhi(x1.x) + a2 * bfhi(x2.x));
            w.y = pk2(a0 * bflo(x0.y) + a1 * bflo(x1.y) + a2 * bflo(x2.y), a0 * bfhi(x0.y) + a1 * bfhi(x1.y) + a2 * bfhi(x2.y));
            w.z = pk2(a0 * bflo(x0.z) + a1 * bflo(x1.z) + a2 * bflo(x2.z), a0 * bfhi(x0.z) + a1 * bfhi(x1.z) + a2 * bfhi(x2.z));
            w.w = pk2(a0 * bflo(x0.w) + a1 * bflo(x1.w) + a2 * bflo(x2.w), a0 * bfhi(x0.w) + a1 * bfhi(x1.w) + a2 * bfhi(x2.w));
            *(u32x4*)(YB + (size_t)row * 512 + c0) = w;
        }
    }
}

template <int MODE> struct EpiGate {
    static constexpr bool PERM = true;
    const bf16_t* gate; bf16_t* tmp; bf16_t* outp;
    DI void operator()(const f32x4 (&acc)[2][2][4][2], const pg8::Unit& u, int wr, int wc, int fr, int fq) const {
        const int row0 = u.pm * 256 + wr * 64 + fr, col0 = u.pn * 256 + wc * 32 + 8 * fq;
#pragma unroll
        for (int ai = 0; ai < 2; ++ai)
#pragma unroll
            for (int m = 0; m < 4; ++m)
#pragma unroll
                for (int bj = 0; bj < 2; ++bj) {
                    const size_t o = (size_t)(row0 + ai * 128 + m * 16) * D + col0 + bj * 128;
                    const u32x4 gt = *(const u32x4*)(gate + o);
                    float v[8];
#pragma unroll
                    for (int e = 0; e < 4; ++e) { v[e] = acc[ai][bj][m][0][e]; v[4 + e] = acc[ai][bj][m][1][e]; }
                    v[0] *= bflo(gt.x); v[1] *= bfhi(gt.x); v[2] *= bflo(gt.y); v[3] *= bfhi(gt.y); v[4] *= bflo(gt.z); v[5] *= bfhi(gt.z); v[6] *= bflo(gt.w); v[7] *= bfhi(gt.w);
                    if (MODE == 1) { const u32x4 tp = *(const u32x4*)(tmp + o);
                        v[0] += bflo(tp.x); v[1] += bfhi(tp.x); v[2] += bflo(tp.y); v[3] += bfhi(tp.y); v[4] += bflo(tp.z); v[5] += bfhi(tp.z); v[6] += bflo(tp.w); v[7] += bfhi(tp.w); }
                    u32x4 w; w.x = pg8::cvt_pk_bf16(v[0], v[1]); w.y = pg8::cvt_pk_bf16(v[2], v[3]); w.z = pg8::cvt_pk_bf16(v[4], v[5]); w.w = pg8::cvt_pk_bf16(v[6], v[7]);
                    *(u32x4*)((MODE == 1 ? outp : tmp) + o) = w;
                }
    }
};
struct EpiOut {
    static constexpr bool PERM = true;
    const float* x; float* x1; bf16_t* x1b;
    DI void operator()(const f32x4 (&acc)[2][2][4][2], const pg8::Unit& u, int wr, int wc, int fr, int fq) const {
        const int row0 = u.pm * 256 + wr * 64 + fr, col0 = u.pn * 256 + wc * 32 + 8 * fq;
#pragma unroll
        for (int ai = 0; ai < 2; ++ai)
#pragma unroll
            for (int m = 0; m < 4; ++m)
#pragma unroll
                for (int bj = 0; bj < 2; ++bj) {
                    const size_t o = (size_t)(row0 + ai * 128 + m * 16) * D + col0 + bj * 128;
                    const f32x4 a0 = *(const f32x4*)(x + o) + acc[ai][bj][m][0], a1 = *(const f32x4*)(x + o + 4) + acc[ai][bj][m][1];
                    *(f32x4*)(x1 + o) = a0; *(f32x4*)(x1 + o + 4) = a1;
                    u32x4 w; w.x = pg8::cvt_pk_bf16(a0[0], a0[1]); w.y = pg8::cvt_pk_bf16(a0[2], a0[3]); w.z = pg8::cvt_pk_bf16(a1[0], a1[1]); w.w = pg8::cvt_pk_bf16(a1[2], a1[3]);
                    *(u32x4*)(x1b + o) = w;
                }
    }
};

DI void p7_router(Frame& F, const Args& A) {
    const float* X1 = (const float*)(F.ws + WS_X1); const float* g2 = A.in[9]; const float* wrg = A.in[10]; const float* brg = A.in[11]; const float* wre = A.in[12]; const float* bre = A.in[13];
    int* EID = (int*)(F.ws + WS_EID); float* GWT = (float*)(F.ws + WS_GWT); float* R2 = (float*)(F.ws + WS_R2);
    unsigned* cnt = (unsigned*)(F.ws + WS_CTL) + CW_CNT;
    int* rowtok = (int*)(F.ws + WS_ROWTOK); int* rowdst = (int*)(F.ws + WS_ROWDST);
    const int gw = F.vcu * NWAVES + F.wave, NGW = F.G * NWAVES, lane = F.lane;
    for (int p = F.vcu * NTHREADS + F.tid; p < PMAX; p += F.G * NTHREADS) { rowtok[p] = 0; rowdst[p] = -1; }
    for (int row = gw; row < T; row += NGW) {
        const f32x4* xr = (const f32x4*)(X1 + (size_t)row * D) + lane;
        f32x4 v[8]; float ss = 0.f;
#pragma unroll
        for (int j = 0; j < 8; ++j) { v[j] = xr[64 * j]; ss += (v[j][0] * v[j][0] + v[j][1] * v[j][1]) + (v[j][2] * v[j][2] + v[j][3] * v[j][3]); }
        const float r = rsqrtf(wave_sum(ss) * (1.0f / D) + EPS);
#pragma unroll
        for (int j = 0; j < 8; ++j) { const f32x4 g = ((const f32x4*)g2)[lane + 64 * j]; v[j] = v[j] * r * g; }
        float a[8];
#pragma unroll
        for (int e = 0; e < 8; ++e) a[e] = 0.f;
#pragma unroll
        for (int j = 0; j < 8; ++j)
#pragma unroll
            for (int i = 0; i < 4; ++i) { const int c = 4 * lane + 256 * j + i; const f32x4 w0 = *(const f32x4*)(wrg + (size_t)c * 8), w1 = *(const f32x4*)(wrg + (size_t)c * 8 + 4); const float h = v[j][i];
#pragma unroll
                for (int e = 0; e < 4; ++e) { a[e] += h * w0[e]; a[4 + e] += h * w1[e]; }
                if (i == 3) __builtin_amdgcn_sched_barrier(0); }
        int gsel = 0; float gmax = -3.0e38f;
#pragma unroll
        for (int e = 0; e < 8; ++e) { a[e] = wave_sum(a[e]) + brg[e]; if (a[e] > gmax) { gmax = a[e]; gsel = e; } }
        float gden = 0.f;
#pragma unroll
        for (int e = 0; e < 8; ++e) gden += __expf(a[e] - gmax);
        const float pg = 1.0f / gden;
        gsel = __builtin_amdgcn_readfirstlane(gsel);
#pragma unroll
        for (int e = 0; e < 8; ++e) a[e] = 0.f;
#pragma unroll
        for (int j = 0; j < 8; ++j)
#pragma unroll
            for (int i = 0; i < 4; ++i) { const int c = 4 * lane + 256 * j + i; const f32x4 w0 = *(const f32x4*)(wre + (size_t)c * 64 + gsel * 8), w1 = *(const f32x4*)(wre + (size_t)c * 64 + gsel * 8 + 4); const float h = v[j][i];
#pragma unroll
                for (int e = 0; e < 4; ++e) { a[e] += h * w0[e]; a[4 + e] += h * w1[e]; }
                if (i == 3) __builtin_amdgcn_sched_barrier(0); }
        int i1 = 0; float v1 = -3.0e38f;
#pragma unroll
        for (int e = 0; e < 8; ++e) { a[e] = wave_sum(a[e]) + bre[gsel * 8 + e]; if (a[e] > v1) { v1 = a[e]; i1 = e; } }
        int i2 = 0; float v2 = -3.0e38f;
#pragma unroll
        for (int e = 0; e < 8; ++e) { if (e != i1 && a[e] > v2) { v2 = a[e]; i2 = e; } }
        const float e2 = __expf(v2 - v1), p1 = 1.0f / (1.0f + e2), p2 = e2 * p1;
        if (lane == 0) {
            const int ea = gsel * 8 + i1, eb = gsel * 8 + i2;
            EID[row * 2] = ea; EID[row * 2 + 1] = eb; GWT[row * 2] = pg * p1; GWT[row * 2 + 1] = pg * p2; R2[row] = r;
            atomicAdd(&cnt[ea], 1u); atomicAdd(&cnt[eb], 1u);
        }
    }
    LAS unsigned* scr = (LAS unsigned*)(F.lds + F.wave * 8192);
    constexpr int I_G = NE * 32 * 8, I_D = NE * 8 * 32;
    for (int it = gw; it < 2 * I_G + I_D; it += NGW) {
        int r_ = it;
        if (r_ < 2 * I_G) { const int up = r_ >= I_G; if (up) r_ -= I_G; const int e = r_ >> 8, rem = r_ & 255;
            const float* W = (up ? A.in[15] : A.in[14]) + (size_t)e * D * FF; bf16_t* WT = (bf16_t*)(F.ws + WS_WGU) + (size_t)e * 1024 * D;
            if (up) cvt_item<2>(W, FF, D, WT, g2, scr, rem >> 3, rem & 7, lane); else cvt_item<1>(W, FF, D, WT, g2, scr, rem >> 3, rem & 7, lane);
            continue; }
        r_ -= 2 * I_G; { const int e = r_ >> 8, rem = r_ & 255;
            cvt_item<0>(A.in[16] + (size_t)e * FF * D, D, FF, (bf16_t*)(F.ws + WS_WD) + (size_t)e * D * FF, nullptr, scr, rem >> 5, rem & 31, lane); }
    }
}

DI int moe_tables(Frame& F, LAS int* rbe, LAS int* bstart) {
    const unsigned* cnt = (const unsigned*)(F.ws + WS_CTL) + CW_CNT;
    __syncthreads();
    if (F.tid == 0) {
        int acc = 0;
        for (int e = 0; e < NE; ++e) { const int c = (int)__hip_atomic_load(cnt + e, __ATOMIC_RELAXED, __HIP_MEMORY_SCOPE_AGENT); const int nb = (c + 255) >> 8; bstart[e] = acc; for (int k = 0; k < nb; ++k) rbe[acc + k] = e; acc += nb; }
        bstart[NE] = acc;
    }
    __syncthreads();
    return bstart[NE];
}

DI void p8_scatter(Frame& F, const Args& A) {
    LAS int* rbe = (LAS int*)(F.lds + LDSCTL_OFF); LAS int* bstart = (LAS int*)(F.lds);
    (void)moe_tables(F, rbe, bstart);
    const int* EID = (const int*)(F.ws + WS_EID); const float* GWT = (const float*)(F.ws + WS_GWT); const float* R2 = (const float*)(F.ws + WS_R2);
    unsigned* fill = (unsigned*)(F.ws + WS_CTL) + CW_FILL;
    int* rowtok = (int*)(F.ws + WS_ROWTOK); int* rowdst = (int*)(F.ws + WS_ROWDST); float* roww = (float*)(F.ws + WS_ROWW); float* rowr2 = (float*)(F.ws + WS_ROWR2);
    for (int a = F.vcu * NTHREADS + F.tid; a < 2 * T; a += F.G * NTHREADS) {
        const int e = EID[a]; const unsigned k = atomicAdd(&fill[e], 1u); const int p = bstart[e] * 256 + (int)k;
        rowtok[p] = a >> 1; rowdst[p] = a; roww[p] = GWT[a]; rowr2[p] = R2[a >> 1];
    }
    __syncthreads();
}

struct EpiGU {
    static constexpr bool PERM = true;
    const float* rowr2; bf16_t* U;
    DI void operator()(const f32x4 (&acc)[2][2][4][2], const pg8::Unit& u, int wr, int wc, int fr, int fq) const {
        const int row0 = u.pm * 256 + wr * 64 + fr, pnr = u.pn & 3;
#pragma unroll
        for (int ai = 0; ai < 2; ++ai)
#pragma unroll
            for (int m = 0; m < 4; ++m) {
                const int p = row0 + ai * 128 + m * 16; const float r = rowr2[p];
#pragma unroll
                for (int bj = 0; bj < 2; ++bj) {
                    const int f0 = 128 * pnr + 64 * bj + 16 * wc + 4 * fq;
                    float o[4];
#pragma unroll
                    for (int e = 0; e < 4; ++e) { const float g = acc[ai][bj][m][0][e] * r, up = acc[ai][bj][m][1][e] * r; o[e] = g * sigmoidf_(g) * up; }
                    u32x2 w; w.x = pg8::cvt_pk_bf16(o[0], o[1]); w.y = pg8::cvt_pk_bf16(o[2], o[3]);
                    *(u32x2*)(U + (size_t)p * FF + f0) = w;
                }
            }
    }
};
struct EpiDown {
    static constexpr bool PERM = true;
    const int* rowdst; const float* roww; bf16_t* YK;
    DI void operator()(const f32x4 (&acc)[2][2][4][2], const pg8::Unit& u, int wr, int wc, int fr, int fq) const {
        const int row0 = u.pm * 256 + wr * 64 + fr, col0 = (u.pn & 7) * 256 + wc * 32 + 8 * fq;
#pragma unroll
        for (int ai = 0; ai < 2; ++ai)
#pragma unroll
            for (int m = 0; m < 4; ++m) {
                const int p = row0 + ai * 128 + m * 16; const int dst = rowdst[p]; const float w = roww[p];
                if (dst >= 0) {
#pragma unroll
                    for (int bj = 0; bj < 2; ++bj) {
                        const f32x4 a0 = acc[ai][bj][m][0] * w, a1 = acc[ai][bj][m][1] * w;
                        u32x4 o; o.x = pg8::cvt_pk_bf16(a0[0], a0[1]); o.y = pg8::cvt_pk_bf16(a0[2], a0[3]); o.z = pg8::cvt_pk_bf16(a1[0], a1[1]); o.w = pg8::cvt_pk_bf16(a1[2], a1[3]);
                        *(u32x4*)(YK + (size_t)dst * D + col0 + bj * 128) = o;
                    }
                }
            }
    }
};

DI void p11_final(Frame& F, const Args& A) {
    const float* X1 = (const float*)(F.ws + WS_X1); const bf16_t* YK = (const bf16_t*)(F.ws + WS_YK); const float* gf = A.in[17];
    const int gw = F.vcu * NWAVES + F.wave, NGW = F.G * NWAVES, lane = F.lane;
    for (int row = gw; row < T; row += NGW) {
        float v[32]; float ss = 0.f;
#pragma unroll
        for (int j = 0; j < 4; ++j) {
            const int c0 = 512 * j + 8 * lane;
            const f32x4 a0 = *(const f32x4*)(X1 + (size_t)row * D + c0), a1 = *(const f32x4*)(X1 + (size_t)row * D + c0 + 4);
            const u32x4 y0 = *(const u32x4*)(YK + (size_t)(2 * row) * D + c0), y1 = *(const u32x4*)(YK + (size_t)(2 * row + 1) * D + c0);
            v[8 * j + 0] = a0[0] + (bflo(y0.x) + bflo(y1.x)); v[8 * j + 1] = a0[1] + (bfhi(y0.x) + bfhi(y1.x)); v[8 * j + 2] = a0[2] + (bflo(y0.y) + bflo(y1.y)); v[8 * j + 3] = a0[3] + (bfhi(y0.y) + bfhi(y1.y));
            v[8 * j + 4] = a1[0] + (bflo(y0.z) + bflo(y1.z)); v[8 * j + 5] = a1[1] + (bfhi(y0.z) + bfhi(y1.z)); v[8 * j + 6] = a1[2] + (bflo(y0.w) + bflo(y1.w)); v[8 * j + 7] = a1[3] + (bfhi(y0.w) + bfhi(y1.w));
#pragma unroll
            for (int e = 0; e < 8; ++e) ss += v[8 * j + e] * v[8 * j + e];
        }
        const float r = rsqrtf(wave_sum(ss) * (1.0f / D) + EPS);
#pragma unroll
        for (int j = 0; j < 4; ++j) {
            const int c0 = 512 * j + 8 * lane;
            const f32x4 g0 = *(const f32x4*)(gf + c0), g1 = *(const f32x4*)(gf + c0 + 4);
            *(f32x4*)(F.out + (size_t)row * D + c0) = (f32x4){v[8 * j] * r * g0[0], v[8 * j + 1] * r * g0[1], v[8 * j + 2] * r * g0[2], v[8 * j + 3] * r * g0[3]};
            *(f32x4*)(F.out + (size_t)row * D + c0 + 4) = (f32x4){v[8 * j + 4] * r * g1[0], v[8 * j + 5] * r * g1[1], v[8 * j + 6] * r * g1[2], v[8 * j + 7] * r * g1[3]};
        }
    }
}

constexpr int N_PHASES = 12;
__global__ void __launch_bounds__(NTHREADS, 2) fwd(Args args) {
    extern __shared__ __attribute__((aligned(16))) unsigned char lds_raw[];
    Frame F;
    F.lds = (LAS unsigned char*)lds_raw;
    F.tid = threadIdx.x; F.lane = F.tid & 63; F.wave = __builtin_amdgcn_readfirstlane(F.tid >> 6);
    F.G = gridDim.x; { const int bx = blockIdx.x; F.vcu = (F.G % 8 == 0) ? (bx % 8) * (F.G / 8) + bx / 8 : bx; }
    F.ws = args.ws; F.out = args.out;
    volatile LAS unsigned* MISC = (volatile LAS unsigned*)(F.lds + MISC_OFF);
    for (int u = F.tid; u < (LDS_BYTES - LDSCTL_OFF) / 4; u += NTHREADS) ((LAS unsigned*)(F.lds + LDSCTL_OFF))[u] = 0u;
    __syncthreads();
    unsigned* ctl = (unsigned*)(F.ws + WS_CTL);
    XcdBarrier bar; bar.bar = ctl + CW_BAR; bar.x = 0; bar.st = nullptr;
    if (MK_N_LAUNCHES == 1) bar = xcd_barrier_post(ctl + CW_BAR, MISC + 8);
#define GRID_BAR() do { if (MK_N_LAUNCHES == 1) xcd_barrier(bar); } while (0)
    const int lo = args.ph_lo, hi = args.ph_hi;
#ifndef PHASE_MASK
#define PHASE_MASK 0xFFF
#endif
#define IN(k) (((PHASE_MASK >> (k)) & 1) && lo <= (k) && (k) < hi)
#define BOTH(k) (IN(k) && IN((k) + 1))
#ifndef REPEAT_MASK
#define REPEAT_MASK 0
#endif
#define RUN(k, ...) do { __VA_ARGS__; if constexpr (((REPEAT_MASK >> (k)) & 1) != 0) { __syncthreads(); __VA_ARGS__; } } while (0)

    if (IN(0)) { RUN(0, p0_prologue(F, args)); if (BOTH(0)) GRID_BAR(); }
    if (IN(1)) {
        pg8::Gemm g{(const bf16_t*)(F.ws + WS_H), (const bf16_t*)(F.ws + WS_WIN), D, nullptr}; pg8::StaticOrder S; S.init(T, INW, F.G, (int)blockIdx.x);
        EpiProj E{F.ws, args.in[3]};
        RUN(1, pg8::gemm_phase<EpiProj, pg8::StaticOrder, true, true, false>(F.lds, g, S, E));
        if (BOTH(1)) GRID_BAR();
    }
    if (IN(2)) { RUN(2, p2_hgrn_simple(F, args)); }
    if (IN(3)) { RUN(3, p3_attn_mfma(F, args)); if (BOTH(3)) GRID_BAR(); }
    if (IN(4)) { RUN(4, p4_fixups(F, args)); if (BOTH(4)) GRID_BAR(); }
    if (IN(5)) { {
        {   pg8::Gemm g{(const bf16_t*)(F.ws + WS_YB), (const bf16_t*)(F.ws + WS_WB), 512, nullptr}; pg8::StaticOrder S; S.init(T, D, F.G, (int)blockIdx.x);
            EpiGate<0> E{(const bf16_t*)(F.ws + WS_GB), (bf16_t*)(F.ws + WS_TMP), nullptr};
            RUN(5, pg8::gemm_phase<EpiGate<0>, pg8::StaticOrder, true, true, false>(F.lds, g, S, E)); }
        VM_WAIT(); __syncthreads();
        {   pg8::Gemm g{(const bf16_t*)(F.ws + WS_YA), (const bf16_t*)(F.ws + WS_WA), D, nullptr}; pg8::StaticOrder S; S.init(T, D, F.G, (int)blockIdx.x);
            EpiGate<1> E{(const bf16_t*)(F.ws + WS_GA), (bf16_t*)(F.ws + WS_TMP), (bf16_t*)(F.ws + WS_MERGED)};
            RUN(5, pg8::gemm_phase<EpiGate<1>, pg8::StaticOrder, true, true, false>(F.lds, g, S, E)); }
        }
        if (BOTH(5)) GRID_BAR();
    }
    if (IN(6)) {
        pg8::Gemm g{(const bf16_t*)(F.ws + WS_MERGED), (const bf16_t*)(F.ws + WS_WOUT), D, nullptr}; pg8::StaticOrder S; S.init(T, D, F.G, (int)blockIdx.x);
        EpiOut E{args.in[0], (float*)(F.ws + WS_X1), (bf16_t*)(F.ws + WS_X1B)};
        RUN(6, pg8::gemm_phase<EpiOut, pg8::StaticOrder, true, true, false>(F.lds, g, S, E));
        if (BOTH(6)) GRID_BAR();
    }
    if (IN(7)) { p7_router(F, args); if (BOTH(7)) GRID_BAR(); }
    if (IN(8)) { p8_scatter(F, args); if (BOTH(8)) GRID_BAR(); }
    if (IN(9)) {
        LAS int* rbe = (LAS int*)(F.lds + LDSCTL_OFF); LAS int* bstart = (LAS int*)(F.lds + LDSCTL_OFF + 768 + 256 + 64);
        const int nrb = moe_tables(F, rbe, bstart);
        pg8::Gemm g{(const bf16_t*)(F.ws + WS_X1B), (const bf16_t*)(F.ws + WS_WGU), D, (const int*)(F.ws + WS_ROWTOK)};
        pg8::MoeOrder S{rbe, nrb, 4, F.G, F.vcu};
        EpiGU E{(const float*)(F.ws + WS_ROWR2), (bf16_t*)(F.ws + WS_U)};
        RUN(9, pg8::gemm_phase<EpiGU, pg8::MoeOrder, true, true, true>(F.lds, g, S, E));
        if (BOTH(9)) GRID_BAR();
    }
    if (IN(10)) {
        LAS int* rbe = (LAS int*)(F.lds + LDSCTL_OFF); LAS int* bstart = (LAS int*)(F.lds + LDSCTL_OFF + 768 + 256 + 64);
        const int nrb = moe_tables(F, rbe, bstart);
        pg8::Gemm g{(const bf16_t*)(F.ws + WS_U), (const bf16_t*)(F.ws + WS_WD), FF, nullptr};
        pg8::MoeOrder S{rbe, nrb, 8, F.G, F.vcu};
        EpiDown E{(const int*)(F.ws + WS_ROWDST), (const float*)(F.ws + WS_ROWW), (bf16_t*)(F.ws + WS_YK)};
        RUN(10, pg8::gemm_phase<EpiDown, pg8::MoeOrder, true, true, false>(F.lds, g, S, E));
        if (BOTH(10)) GRID_BAR();
    }
    if (IN(11)) { RUN(11, p11_final(F, args)); }
#undef IN
#undef BOTH
}

extern "C" void kernel_launch(void* const* d_in, const int* in_sizes, int n_in, void* d_out, int out_size, void* d_ws, size_t ws_size, hipStream_t stream) {
    static int grid = 0;
    if (grid == 0) {
        if (n_in != 18 || in_sizes[0] != T * D || out_size != T * D || ws_size < WS_END) { fprintf(stderr, "kernel_launch: unexpected shapes: n_in %d in0 %d out %d ws %zu (need %zu)\n", n_in, n_in > 0 ? in_sizes[0] : -1, out_size, ws_size, (size_t)WS_END); grid = -1; return; }
        int dev = 0, cus = 0, per_cu = 0;
        if (hipGetDevice(&dev) != hipSuccess || hipDeviceGetAttribute(&cus, hipDeviceAttributeMultiprocessorCount, dev) != hipSuccess) { grid = -1; return; }
        if (hipFuncSetAttribute((const void*)fwd, hipFuncAttributeMaxDynamicSharedMemorySize, LDS_BYTES) != hipSuccess) { fprintf(stderr, "kernel_launch: hipFuncSetAttribute failed\n"); grid = -1; return; }
        if (hipOccupancyMaxActiveBlocksPerMultiprocessor(&per_cu, (const void*)fwd, NTHREADS, LDS_BYTES) != hipSuccess || per_cu < 1) fprintf(stderr, "kernel_launch: occupancy query reports %d\n", per_cu);
        (void)hipGetLastError();
        grid = cus;
        fprintf(stderr, "kernel_launch: grid %d, occupancy query %d, ws %zu\n", grid, per_cu, ws_size);
    }
    if (grid < 0) return;
    if (hipMemsetAsync((char*)d_ws + WS_CTL, 0, CTL_ZERO_BYTES, stream) != hipSuccess) return;
    Args a{};
    for (int i = 0; i < 18; ++i) a.in[i] = (const float*)d_in[i];
    a.out = (float*)d_out; a.ws = (unsigned char*)d_ws;
    const int nl = MK_N_LAUNCHES;
    for (int li = 0; li < nl; ++li) {
        a.ph_lo = (nl == 1) ? 0 : li; a.ph_hi = (nl == 1) ? N_PHASES : li + 1; a.li = li; a.pad = 0;
        hipLaunchKernelGGL(fwd, dim3(grid), dim3(NTHREADS), LDS_BYTES, stream, a);
        const hipError_t le = hipPeekAtLastError();
        if (le != hipSuccess) { fprintf(stderr, "kernel_launch: launch %d failed: %s\n", li, hipGetErrorName(le)); break; }
    }
}
```

```cpp
#include <hip/hip_runtime.h>
#include <cstdio>
#include <cstdint>

#ifndef MK_N_LAUNCHES
#define MK_N_LAUNCHES 1
#endif

#define DI __device__ __forceinline__
#define GAS __attribute__((address_space(1)))
#define LAS __attribute__((address_space(3)))
typedef unsigned short bf16_t;
typedef short bf16x8 __attribute__((ext_vector_type(8)));
typedef float f32x4 __attribute__((ext_vector_type(4)));
typedef unsigned u32x4 __attribute__((ext_vector_type(4)));
typedef unsigned u32x2 __attribute__((ext_vector_type(2)));

constexpr int NB = 8, SEQ = 2048, T = NB * SEQ, D = 2048;
constexpr int INW = 16896;
constexpr int NE = 64, FF = 512;
constexpr int PMAX = 49152;
constexpr float EPS = 1e-6f;
constexpr int NWAVES = 8, NTHREADS = 512;

constexpr size_t MiB = 1u << 20;
constexpr size_t WS_CTL = 0, CTL_ZERO_BYTES = 1 * MiB;
constexpr size_t WS_EID = 1 * MiB, WS_GWT = WS_EID + 256 * 1024, WS_R2 = WS_GWT + 256 * 1024;
constexpr size_t WS_ROWTOK = 2 * MiB, WS_ROWDST = WS_ROWTOK + 256 * 1024, WS_ROWW = WS_ROWDST + 256 * 1024, WS_ROWR2 = WS_ROWW + 256 * 1024;
constexpr size_t WS_LSE = 3 * MiB;
constexpr size_t WS_WA = 8 * MiB, WS_WB = 16 * MiB, WS_WOUT = 18 * MiB;
constexpr size_t WS_WIN = 32 * MiB, WS_H = 98 * MiB;
constexpr size_t WS_QA = 162 * MiB, WS_LF = 226 * MiB, WS_IA = 290 * MiB, WS_SG = 354 * MiB;
constexpr size_t WS_QB = 418 * MiB, WS_KB = 466 * MiB, WS_VT = 514 * MiB, WS_GA = 562 * MiB, WS_GB = 626 * MiB;
constexpr size_t WS_OH = 690 * MiB, WS_OG = 754 * MiB;
constexpr size_t WS_YA = 803 * MiB, WS_YB = 867 * MiB, WS_TMP = 883 * MiB, WS_MERGED = 947 * MiB, WS_END = 1011 * MiB;
constexpr size_t WS_X1 = 162 * MiB, WS_X1B = 290 * MiB, WS_WGU = 354 * MiB, WS_WD = 610 * MiB, WS_U = 738 * MiB, WS_YK = 32 * MiB;
static_assert(WS_U + (size_t)PMAX * FF * 2 <= WS_YA, "ws map");
constexpr int CW_BAR = 4096;
constexpr int CW_CNT = 16384;
constexpr int CW_FILL = 16384 + 64;

constexpr int RING_BYTES = 131072;
constexpr int LDSCTL_OFF = RING_BYTES;
constexpr int MISC_OFF = LDSCTL_OFF + 1024;
constexpr int LDS_BYTES = 147456;

DI unsigned f2bf(float f) { unsigned u = __builtin_bit_cast(unsigned, f); return (u + 0x7fffu + ((u >> 16) & 1u)) >> 16; }
DI unsigned pk2(float lo, float hi) { return f2bf(lo) | (f2bf(hi) << 16); }
DI float bflo(unsigned w) { return __builtin_bit_cast(float, w << 16); }
DI float bfhi(unsigned w) { return __builtin_bit_cast(float, w & 0xffff0000u); }
DI float bf1(bf16_t b) { return __builtin_bit_cast(float, (unsigned)b << 16); }
DI float sigmoidf_(float x) { return 1.0f / (1.0f + __expf(-x)); }
#define LDS_WAIT() asm volatile("s_waitcnt lgkmcnt(0)" ::: "memory")
#define VM_WAIT() asm volatile("s_waitcnt vmcnt(0)" ::: "memory")

namespace pg8 {
constexpr int BM = 256, BK = 64, HALF = 128, HTB = HALF * BK * 2, STAGE_BYTES = 8 * HTB, NXCD = 8, WGM = 8;
__host__ __device__ __forceinline__ int lds_byte(int r, int c) { const int st = (r >> 4) * 2 + (c >> 5), rr = r & 15, cc = c & 31, ob = rr * 64 + cc * 2; return st * 1024 + (ob ^ (((ob >> 9) & 1) << 5)); }
__host__ __device__ __forceinline__ void stage_rc(int b, int& R, int& C) { const int st = b / 1024, sb = b % 1024, swz = sb ^ (((sb >> 9) & 1) << 5); R = (st >> 1) * 16 + swz / 64; C = (st & 1) * 32 + (swz % 64) / 2; }
__host__ __device__ __forceinline__ int perm32(int rho) { const int n = rho >> 4, i = rho & 15; return 8 * (i >> 2) + 4 * n + (i & 3); }

struct Unit { int pm, pn; };
struct Gemm { const bf16_t* A; const bf16_t* Bt; int K; const int* rowtok; };

struct StaticOrder {
    int nM, nN, nwg, G, c;
    __host__ __device__ void init(int M, int N, int G_, int c_) { nM = M / BM; nN = N / BM; nwg = nM * nN; G = G_; c = c_; }
    __host__ __device__ bool next(int i, Unit& u) const {
        const long L = (long)i * G + c; if (L >= nwg) return false;
        int wgid = (int)L; { const int q = nwg / NXCD, r = nwg % NXCD, xcd = wgid % NXCD, off = wgid / NXCD; wgid = (xcd < r ? xcd * (q + 1) : r * (q + 1) + (xcd - r) * q) + off; }
        const int nig = WGM * nN, gid = wgid / nig, fm = gid * WGM, gsz = (nM - fm) < WGM ? (nM - fm) : WGM;
        u.pm = fm + ((wgid % nig) % gsz); u.pn = (wgid % nig) / gsz; return true;
    }
};
struct MoeOrder {
    const LAS int* rbe; int nrb, NT, G, vcu;
    DI bool next(int i, Unit& u) const {
        const int L = i * G + vcu; if (L >= nrb * NT) return false;
        const int rb = L / NT, pnr = L - rb * NT; u.pm = rb; u.pn = rbe[rb] * NT + pnr; return true;
    }
};

DI unsigned cvt_pk_bf16(float lo, float hi) { unsigned r; asm volatile("v_cvt_pk_bf16_f32 %0, %1, %2" : "=v"(r) : "v"(lo), "v"(hi)); return r; }

template <class Epi, class Sched, bool ALIGN_EPI, bool SP2, bool GATHER>
DI void gemm_phase(LAS unsigned char* lds, const Gemm g, const Sched& S, const Epi& E) {
    const int tid = threadIdx.x, wid = __builtin_amdgcn_readfirstlane(tid >> 6), lane = tid & 63, wr = wid >> 2, wc = wid & 3, fr = lane & 15, fq = lane >> 4;
    const int K = g.K, nt = K / BK;
    unsigned voffA[2], voffB[2]; int RA[2], CA[2];
#pragma unroll
    for (int i = 0; i < 2; ++i) { int R, C; stage_rc(tid * 16 + i * 8192, R, C); const int Rb = Epi::PERM ? ((R & ~31) + perm32(R & 31)) : R;
        voffA[i] = (unsigned)(R * K + C) * 2u; voffB[i] = (unsigned)(Rb * K + C) * 2u; RA[i] = R; CA[i] = C; }
    const size_t kstep = (size_t)(BK * 2);
    const size_t hstep = (size_t)HALF * K * 2;
    const size_t tstep = 2 * hstep;
    const size_t hstepA = GATHER ? 0 : hstep;
    const unsigned ldsw = (unsigned)wid * 1024u;
    const int aoff = lds_byte(wr * 64 + fr, fq * 8), boff = lds_byte(wc * 32 + fr, fq * 8);
#define PG8_SA(b, h) (((b) * 2 + (h)) * HTB)
#define PG8_SB(b, h) ((4 + (b) * 2 + (h)) * HTB)
#define PG8_STAGE2(bufoff, gbase, v0, v1) do { \
        __builtin_amdgcn_global_load_lds((const unsigned*)((const char*)(gbase) + (v0)), (LAS unsigned*)(lds + (bufoff) + ldsw), 16, 0, 0); \
        __builtin_amdgcn_global_load_lds((const unsigned*)((const char*)(gbase) + (v1)), (LAS unsigned*)(lds + (bufoff) + ldsw + 8192), 16, 0, 0); } while (0)
#define PG8_STAGE(bufoff, gbase, voff) PG8_STAGE2(bufoff, gbase, (voff)[0], (voff)[1])
#define PG8_LDA(dst, b, h) do { _Pragma("unroll") for (int m = 0; m < 4; ++m) _Pragma("unroll") for (int k = 0; k < 2; ++k) dst[m][k] = *(const LAS bf16x8*)(lds + PG8_SA(b, h) + aoff + m * 2048 + k * 1024); } while (0)
#define PG8_LDB(dst, b, h) do { _Pragma("unroll") for (int n = 0; n < 2; ++n) _Pragma("unroll") for (int k = 0; k < 2; ++k) dst[n][k] = *(const LAS bf16x8*)(lds + PG8_SB(b, h) + boff + n * 2048 + k * 1024); } while (0)
#define PG8_MMA(ai, bj, At, Bt) do { __builtin_amdgcn_s_setprio(1); _Pragma("unroll") for (int m = 0; m < 4; ++m) _Pragma("unroll") for (int n = 0; n < 2; ++n) _Pragma("unroll") for (int k = 0; k < 2; ++k) \
        acc[ai][bj][m][n] = __builtin_amdgcn_mfma_f32_16x16x32_bf16(Bt[n][k], At[m][k], acc[ai][bj][m][n], 0, 0, 0); __builtin_amdgcn_s_setprio(0); } while (0)
#define PG8_WAIT_V(n) asm volatile("s_waitcnt vmcnt(" #n ")" ::: "memory")
#define PG8_WAIT_L(n) asm volatile("s_waitcnt lgkmcnt(" #n ")" ::: "memory")
#define PG8_BAR __builtin_amdgcn_s_barrier()
#define PG8_SCHED __builtin_amdgcn_sched_barrier(0)
#define PG8_GATHER(u, dst) do { _Pragma("unroll") for (int _h = 0; _h < 2; ++_h) _Pragma("unroll") for (int _i = 0; _i < 2; ++_i) { \
        const int _tok = g.rowtok[(u).pm * BM + _h * HALF + RA[_i]]; dst[_h][_i] = (unsigned)(_tok * K + CA[_i]) * 2u; } } while (0)
    Unit cur, nxt; int ui = 0;
    if (!S.next(0, cur)) return;
    f32x4 acc[2][2][4][2];
#pragma unroll
    for (int a = 0; a < 2; ++a)
#pragma unroll
        for (int b = 0; b < 2; ++b)
#pragma unroll
            for (int m = 0; m < 4; ++m)
#pragma unroll
                for (int n = 0; n < 2; ++n) acc[a][b][m][n] = (f32x4){0.f, 0.f, 0.f, 0.f};
    bf16x8 At[4][2], B0[2][2], B1[2][2];
    unsigned gC[2][2], gN[2][2];
    if constexpr (GATHER) { PG8_GATHER(cur, gC); } else { gC[0][0] = voffA[0]; gC[0][1] = voffA[1]; gC[1][0] = voffA[0]; gC[1][1] = voffA[1]; }
#pragma unroll
    for (int h = 0; h < 2; ++h) { gN[h][0] = gC[h][0]; gN[h][1] = gC[h][1]; }
    const char* cA = (const char*)g.A + (GATHER ? 0 : (size_t)cur.pm * tstep); const char* cB = (const char*)g.Bt + (size_t)cur.pn * tstep;
    static_assert(SP2, "only the SP2 loop is kept in this file");
    PG8_STAGE(PG8_SB(0, 0), cB, voffB); PG8_STAGE(PG8_SB(0, 1), cB + hstep, voffB); PG8_STAGE2(PG8_SA(0, 0), cA, gC[0][0], gC[0][1]); PG8_STAGE2(PG8_SA(0, 1), cA + hstepA, gC[1][0], gC[1][1]);
    if (wr == 1) PG8_BAR;
    PG8_WAIT_V(2); PG8_BAR;
    PG8_STAGE(PG8_SB(1, 0), cB + kstep, voffB); PG8_STAGE2(PG8_SA(1, 0), cA + kstep, gC[0][0], gC[0][1]); PG8_STAGE(PG8_SB(1, 1), cB + hstep + kstep, voffB);
    PG8_WAIT_V(6); PG8_BAR;
    for (;;) {
        const bool has_next = S.next(ui + 1, nxt);
        const char* nA = (has_next && !GATHER) ? (const char*)g.A + (size_t)nxt.pm * tstep : cA; const char* nB = has_next ? (const char*)g.Bt + (size_t)nxt.pn * tstep : cB;
        if constexpr (GATHER) { if (has_next) { PG8_GATHER(nxt, gN); } else {
#pragma unroll
            for (int h = 0; h < 2; ++h) { gN[h][0] = gC[h][0]; gN[h][1] = gC[h][1]; } } }
        for (int t = 0; t < nt; t += 2) {
            const bool last = (t == nt - 2);
            const char* a1 = cA + (size_t)(t + 1) * kstep;
            const char* a2 = last ? nA : cA + (size_t)(t + 2) * kstep; const char* b2 = last ? nB : cB + (size_t)(t + 2) * kstep;
            const char* a3 = a2 + kstep; const char* b3 = b2 + kstep;
            unsigned x00 = gC[0][0], x01 = gC[0][1], x10 = gC[1][0], x11 = gC[1][1];
            if constexpr (GATHER) { if (last) { x00 = gN[0][0]; x01 = gN[0][1]; x10 = gN[1][0]; x11 = gN[1][1]; } }
            PG8_LDB(B0, 0, 0); PG8_LDB(B1, 0, 1); PG8_SCHED; PG8_LDA(At, 0, 0); PG8_STAGE2(PG8_SA(1, 1), a1 + hstepA, gC[1][0], gC[1][1]);
            PG8_WAIT_V(8); PG8_WAIT_L(0); PG8_BAR; PG8_MMA(0, 0, At, B0); PG8_MMA(0, 1, At, B1); PG8_BAR; PG8_SCHED;
            PG8_LDA(At, 0, 1); PG8_STAGE(PG8_SB(0, 0), b2, voffB); PG8_STAGE(PG8_SB(0, 1), b2 + hstep, voffB); PG8_STAGE2(PG8_SA(0, 0), a2, x00, x01);
            PG8_WAIT_V(8); PG8_WAIT_L(0); PG8_BAR; PG8_MMA(1, 0, At, B0); PG8_MMA(1, 1, At, B1); PG8_BAR; PG8_SCHED;
            PG8_LDB(B0, 1, 0); PG8_LDB(B1, 1, 1); PG8_SCHED; PG8_LDA(At, 1, 0); PG8_STAGE2(PG8_SA(0, 1), a2 + hstepA, x10, x11);
            PG8_WAIT_V(8); PG8_WAIT_L(0); PG8_BAR; PG8_MMA(0, 0, At, B0); PG8_MMA(0, 1, At, B1); PG8_BAR; PG8_SCHED;
            PG8_LDA(At, 1, 1); PG8_STAGE(PG8_SB(1, 0), b3, voffB); PG8_STAGE(PG8_SB(1, 1), b3 + hstep, voffB); PG8_STAGE2(PG8_SA(1, 0), a3, x00, x01);
            PG8_WAIT_V(8); PG8_WAIT_L(0); PG8_BAR; PG8_MMA(1, 0, At, B0); PG8_MMA(1, 1, At, B1); PG8_BAR; PG8_SCHED;
        }
        if constexpr (ALIGN_EPI) { if (wr == 0) PG8_BAR; }
        E(acc, cur, wr, wc, fr, fq);
        if (!has_next) break;
#pragma unroll
        for (int a = 0; a < 2; ++a)
#pragma unroll
            for (int b = 0; b < 2; ++b)
#pragma unroll
                for (int m = 0; m < 4; ++m)
#pragma unroll
                    for (int n = 0; n < 2; ++n) acc[a][b][m][n] = (f32x4){0.f, 0.f, 0.f, 0.f};
        cur = nxt; cA = nA; cB = nB; ++ui;
#pragma unroll
        for (int h = 0; h < 2; ++h) { gC[h][0] = gN[h][0]; gC[h][1] = gN[h][1]; }
        if constexpr (ALIGN_EPI) { if (wr == 1) PG8_BAR; }
    }
    PG8_WAIT_V(0);
    if constexpr (!ALIGN_EPI) { if (wr == 0) PG8_BAR; }
    PG8_BAR;
#undef PG8_SA
#undef PG8_SB
#undef PG8_STAGE
#undef PG8_STAGE2
#undef PG8_LDA
#undef PG8_LDB
#undef PG8_MMA
#undef PG8_WAIT_V
#undef PG8_WAIT_L
#undef PG8_BAR
#undef PG8_SCHED
#undef PG8_GATHER
}
}

#define XB_TMO      128
#define XB_XCNT(j)  (256  + 64 * (j))
#define XB_XSUB(j)  (1280 + 64 * (j))
#define XB_XGEN(j)  (2304 + 64 * (j))
#define XB_TOP      3328
#define XB_TOPGEN   3392
#define XCD_BAR_WORDS 3456
#define XB_SPIN_CAP (1u << 18)
__device__ __forceinline__ unsigned xb_ld(unsigned* p)              { return __hip_atomic_load(p, __ATOMIC_RELAXED, __HIP_MEMORY_SCOPE_AGENT); }
__device__ __forceinline__ unsigned xb_add(unsigned* p, unsigned v) { return __hip_atomic_fetch_add(p, v, __ATOMIC_RELAXED, __HIP_MEMORY_SCOPE_AGENT); }
__device__ __forceinline__ unsigned xb_xcc_id() { return (unsigned)__builtin_amdgcn_s_getreg((3 << 11) | 20) & 0xFu; }
#define XB_SPIN(cond, bar) do { unsigned _sp = 0; while (cond) { __builtin_amdgcn_s_sleep(1); \
    if ((++_sp & 255u) == 0u) { if (xb_ld(&(bar)[XB_TMO])) break; if (_sp > XB_SPIN_CAP) { atomicAdd(&(bar)[XB_TMO], 1u); break; } } } } while (0)
struct XcdBarrier { unsigned* bar; unsigned x; volatile LAS unsigned* st; };
__device__ __forceinline__ XcdBarrier xcd_barrier_post(unsigned* bar, volatile LAS unsigned* st) {
    XcdBarrier b; b.bar = bar; b.x = xb_xcc_id(); b.st = st;
    if (threadIdx.x == 0) (void)xb_add(&bar[XB_XCNT(b.x)], 1u);
    return b;
}
__device__ __forceinline__ void xcd_barrier_complete(unsigned* bar, unsigned x, unsigned& nloc, unsigned& nx) {
    const unsigned G = gridDim.x * gridDim.y * gridDim.z;
    unsigned sum, cnt, mine, sp = 0u;
    for (;;) {
        sum = 0u; cnt = 0u; mine = 0u;
#pragma unroll
        for (unsigned j = 0; j < 16; ++j) { const unsigned c = xb_ld(&bar[XB_XCNT(j)]); sum += c; cnt += (c > 0u) ? 1u : 0u; mine = (j == x) ? c : mine; }
        if (sum == G) break;
        __builtin_amdgcn_s_sleep(1);
        if ((++sp & 255u) == 0u) { if (xb_ld(&bar[XB_TMO])) break; if (sp > XB_SPIN_CAP) { atomicAdd(&bar[XB_TMO], 1u); break; } }
    }
    nloc = mine > 0u ? mine : 1u; nx = cnt > 0u ? cnt : 1u;
}
__device__ __forceinline__ void xcd_barrier(const XcdBarrier& b) {
    asm volatile("s_waitcnt vmcnt(0)" ::: "memory");
    __syncthreads();
    if (threadIdx.x == 0) {
        unsigned* bar = b.bar;
        __builtin_amdgcn_s_waitcnt(0);
        unsigned nloc = b.st[0], nx = b.st[1];
        if (nloc == 0u) { xcd_barrier_complete(bar, b.x, nloc, nx); b.st[0] = nloc; b.st[1] = nx; }
        const unsigned old = xb_add(&bar[XB_XSUB(b.x)], 1u);
        const unsigned gen = old / nloc;
        if (old + 1u == (gen + 1u) * nloc) {
            __builtin_amdgcn_fence(__ATOMIC_RELEASE, "agent");
            asm volatile("s_waitcnt vmcnt(0)" ::: "memory");
            const unsigned og = xb_add(&bar[XB_TOP], 1u);
            const unsigned tg = og / nx;
            if (og + 1u == (tg + 1u) * nx) xb_add(&bar[XB_TOPGEN], 1u);
            else XB_SPIN(xb_ld(&bar[XB_TOPGEN]) == tg, bar);
            __builtin_amdgcn_fence(__ATOMIC_ACQUIRE, "agent");
            xb_add(&bar[XB_XGEN(b.x)], 1u);
            asm volatile("s_waitcnt vmcnt(0)" ::: "memory");
        } else {
            XB_SPIN(xb_ld(&bar[XB_XGEN(b.x)]) == gen, bar);
            __builtin_amdgcn_fence(__ATOMIC_ACQUIRE, "agent");
            asm volatile("s_waitcnt vmcnt(0)" ::: "memory");
        }
    }
    __syncthreads();
}

struct Frame {
    LAS unsigned char* lds;
    int wave, vcu, G;
    unsigned char* ws;
    float* out;
};
struct Args { const float* in[18]; float* out; unsigned char* ws; int ph_lo, ph_hi, li, pad; };
DI int opaque_tid() { int t = threadIdx.x; asm volatile("" : "+v"(t)); return t; }
DI float wave_sum(float v) {
#pragma unroll
    for (int o = 1; o < 64; o <<= 1) v += __shfl_xor(v, o);
    return v;
}
DI float wave_max(float v) {
#pragma unroll
    for (int o = 1; o < 64; o <<= 1) v = fmaxf(v, __shfl_xor(v, o));
    return v;
}

template <int MAP>
DI void cvt_item(const float* W, int N, int K, bf16_t* WT, const float* gain, LAS unsigned* scr, int kb, int nb, int lane) {
    const int nq = lane & 15, kr = lane >> 4, k0 = kb * 64, n0 = nb * 64;
    f32x4 v[8][2];
#pragma unroll
    for (int j = 0; j < 8; ++j)
#pragma unroll
        for (int e = 0; e < 2; ++e) v[j][e] = *(const f32x4*)(W + (size_t)(k0 + 8 * j + 2 * kr + e) * N + n0 + 4 * nq);
    if (gain) {
#pragma unroll
        for (int j = 0; j < 8; ++j) { const float g0 = gain[k0 + 8 * j + 2 * kr], g1 = gain[k0 + 8 * j + 2 * kr + 1]; v[j][0] = v[j][0] * g0; v[j][1] = v[j][1] * g1; }
    }
#pragma unroll
    for (int j = 0; j < 8; ++j)
#pragma unroll
        for (int i = 0; i < 4; ++i) scr[(4 * nq + i) * 32 + ((j ^ (nq & 7)) << 2) + kr] = pk2(v[j][0][i], v[j][1][i]);
    LDS_WAIT(); asm volatile("" ::: "memory");
#pragma unroll
    for (int jj = 0; jj < 8; ++jj) {
        const int nl = (lane >> 3) + 8 * jj, c = lane & 7;
        const u32x4 o = *(const LAS u32x4*)(scr + nl * 32 + ((c ^ ((nl >> 2) & 7)) << 2));
        const int n = n0 + nl;
        const int row = (MAP == 0) ? n : ((n >> 2) * 8 + (MAP == 2 ? 4 : 0) + (n & 3));
        *(u32x4*)(WT + (size_t)row * K + k0 + 8 * c) = o;
    }
    LDS_WAIT(); asm volatile("" ::: "memory");
}

DI void p0_prologue(Frame& F, const Args& A) {
    const int ftid = opaque_tid(), flane = ftid & 63;
    LAS unsigned* scr = (LAS unsigned*)(F.lds + F.wave * 8192);
    const int gw = F.vcu * NWAVES + F.wave, NGW = F.G * NWAVES;
    constexpr int I_IN = 32 * 264, I_A = 32 * 32, I_B = 8 * 32, I_O = 32 * 32;
    for (int it = gw; it < I_IN + I_A + I_B + I_O; it += NGW) {
        int r = it;
        if (r < I_IN) { cvt_item<0>(A.in[2], INW, D, (bf16_t*)(F.ws + WS_WIN), nullptr, scr, r / 264, r % 264, flane); continue; } r -= I_IN;
        if (r < I_A) { cvt_item<0>(A.in[6], D, D, (bf16_t*)(F.ws + WS_WA), nullptr, scr, r / 32, r % 32, flane); continue; } r -= I_A;
        if (r < I_B) { cvt_item<0>(A.in[7], D, 512, (bf16_t*)(F.ws + WS_WB), nullptr, scr, r / 32, r % 32, flane); continue; } r -= I_B;
        cvt_item<0>(A.in[8], D, D, (bf16_t*)(F.ws + WS_WOUT), nullptr, scr, r / 32, r % 32, flane);
    }
    const float* x = A.in[0]; const float* g1 = A.in[1]; bf16_t* H = (bf16_t*)(F.ws + WS_H);
    for (int row = gw; row < T; row += NGW) {
        const f32x4* xr = (const f32x4*)(x + (size_t)row * D) + flane;
        f32x4 v[8]; float ss = 0.f;
#pragma unroll
        for (int j = 0; j < 8; ++j) { v[j] = xr[64 * j]; ss += (v[j][0] * v[j][0] + v[j][1] * v[j][1]) + (v[j][2] * v[j][2] + v[j][3] * v[j][3]); }
        const float r = rsqrtf(wave_sum(ss) * (1.0f / D) + EPS);
        u32x2* o = (u32x2*)(H + (size_t)row * D) + flane;
#pragma unroll
        for (int j = 0; j < 8; ++j) { const f32x4 g = ((const f32x4*)g1)[flane + 64 * j]; u32x2 w; w.x = pk2(v[j][0] * r * g[0], v[j][1] * r * g[1]); w.y = pk2(v[j][2] * r * g[2], v[j][3] * r * g[3]); o[64 * j] = w; }
    }
}

struct EpiProj {
    static constexpr bool PERM = true;
    unsigned char* ws; const float* lbl;
    DI void operator()(const f32x4 (&acc)[2][2][4][2], const pg8::Unit& u, int wr, int wc, int fr, int fq) const {
        const int pn = u.pn, row0 = u.pm * 256 + wr * 64 + fr, cw = wc * 32 + 8 * fq;
        if (pn < 32 || pn >= 50) {
            size_t off; int tile, mode;
            if (pn < 8) { off = WS_QA; tile = pn; mode = 0; } else if (pn < 16) { off = WS_LF; tile = pn - 8; mode = 1; } else if (pn < 24) { off = WS_IA; tile = pn - 16; mode = 0; }
            else if (pn < 32) { off = WS_SG; tile = pn - 24; mode = 2; } else if (pn < 58) { off = WS_GA; tile = pn - 50; mode = 2; } else { off = WS_GB; tile = pn - 58; mode = 2; }
            bf16_t* base = (bf16_t*)(ws + off);
#pragma unroll
            for (int bj = 0; bj < 2; ++bj) {
                const int col = tile * 256 + bj * 128 + cw;
                float lb[8];
                if (mode == 1) {
#pragma unroll
                    for (int e = 0; e < 8; ++e) lb[e] = 1.0f / (1.0f + __expf(lbl[2048 + col + e] - lbl[col + e]));
                }
#pragma unroll
                for (int ai = 0; ai < 2; ++ai)
#pragma unroll
                    for (int m = 0; m < 4; ++m) {
                        const int row = row0 + ai * 128 + m * 16;
                        float v[8];
#pragma unroll
                        for (int e = 0; e < 4; ++e) { v[e] = acc[ai][bj][m][0][e]; v[4 + e] = acc[ai][bj][m][1][e]; }
                        if (mode == 1) {
#pragma unroll
                            for (int e = 0; e < 8; ++e) v[e] = __logf(lb[e] + (1.0f - lb[e]) * sigmoidf_(v[e]));
                        } else if (mode == 2) {
#pragma unroll
                            for (int e = 0; e < 8; ++e) v[e] = sigmoidf_(v[e]);
                        }
                        u32x4 w; w.x = pg8::cvt_pk_bf16(v[0], v[1]); w.y = pg8::cvt_pk_bf16(v[2], v[3]); w.z = pg8::cvt_pk_bf16(v[4], v[5]); w.w = pg8::cvt_pk_bf16(v[6], v[7]);
                        *(u32x4*)(base + (size_t)row * D + col) = w;
                    }
            }
        } else {
            const int a = pn - 32, kind = a / 6, ht = a - kind * 6;
#pragma unroll
            for (int bj = 0; bj < 2; ++bj) {
                const int head = ht * 2 + bj, sh = 2 * (head >> 2);
#pragma unroll
                for (int ai = 0; ai < 2; ++ai)
#pragma unroll
                    for (int m = 0; m < 4; ++m) {
                        const int row = row0 + ai * 128 + m * 16, b = row >> 11, s = row & 2047;
                        const int pos = ((s & ((1 << sh) - 1)) << (11 - sh)) + (s >> sh);
                        float v[8];
#pragma unroll
                        for (int e = 0; e < 4; ++e) { v[e] = acc[ai][bj][m][0][e]; v[4 + e] = acc[ai][bj][m][1][e]; }
                        if (kind < 2) {
                            const float sc = (kind == 0) ? 0.08838834764831845f : 1.0f;
                            u32x4 w; w.x = pg8::cvt_pk_bf16(v[0] * sc, v[1] * sc); w.y = pg8::cvt_pk_bf16(v[2] * sc, v[3] * sc); w.z = pg8::cvt_pk_bf16(v[4] * sc, v[5] * sc); w.w = pg8::cvt_pk_bf16(v[6] * sc, v[7] * sc);
                            bf16_t* base = (bf16_t*)(ws + (kind == 0 ? WS_QB : WS_KB));
                            *(u32x4*)(base + ((size_t)(b * 12 + head) * 2048 + pos) * 128 + cw) = w;
                        } else {
                            bf16_t* base = (bf16_t*)(ws + WS_VT) + ((size_t)(b * 12 + head) * 128 + cw) * 2048 + pos;
#pragma unroll
                            for (int e = 0; e < 8; ++e) base[(size_t)e * 2048] = (bf16_t)f2bf(v[e]);
                        }
                    }
            }
        }
    }
};

DI void p2_hgrn_simple(Frame& F, const Args& A) {
    const int ftid = opaque_tid(), flane = ftid & 63;
    LAS float* qs = (LAS float*)F.lds; LAS float* fs = qs + 16 * 128; LAS float* is = fs + 16 * 128; LAS float* red = is + 16 * 128;
    const bf16_t* QA = (const bf16_t*)(F.ws + WS_QA); const bf16_t* LF = (const bf16_t*)(F.ws + WS_LF); const bf16_t* IA = (const bf16_t*)(F.ws + WS_IA); bf16_t* OH = (bf16_t*)(F.ws + WS_OH);
    const int tid = ftid, v = tid & 127, kq = __builtin_amdgcn_readfirstlane(tid >> 7), lt = tid >> 5, c4 = tid & 31;
    for (int item = F.vcu; item < 128; item += F.G) {
        const int b = item >> 4, h = item & 15;
        float S[32];
#pragma unroll
        for (int k = 0; k < 32; ++k) S[k] = 0.f;
        for (int t0 = 0; t0 < SEQ; t0 += 16) {
            {
                const size_t g = ((size_t)(b * SEQ + t0 + lt)) * D + h * 128 + 4 * c4;
                const u32x2 q2 = *(const u32x2*)(QA + g), f2 = *(const u32x2*)(LF + g), i2 = *(const u32x2*)(IA + g);
                *(LAS f32x4*)(qs + lt * 128 + 4 * c4) = (f32x4){bflo(q2.x), bfhi(q2.x), bflo(q2.y), bfhi(q2.y)};
                *(LAS f32x4*)(fs + lt * 128 + 4 * c4) = (f32x4){__expf(bflo(f2.x)), __expf(bfhi(f2.x)), __expf(bflo(f2.y)), __expf(bfhi(f2.y))};
                *(LAS f32x4*)(is + lt * 128 + 4 * c4) = (f32x4){bflo(i2.x), bfhi(i2.x), bflo(i2.y), bfhi(i2.y)};
            }
            __syncthreads();
#pragma unroll 2
            for (int t = 0; t < 16; ++t) {
                const float iv = is[t * 128 + v]; float o = 0.f;
#pragma unroll
                for (int k4 = 0; k4 < 8; ++k4) {
                    const f32x4 f = *(const LAS f32x4*)(fs + t * 128 + kq * 32 + 4 * k4), q = *(const LAS f32x4*)(qs + t * 128 + kq * 32 + 4 * k4);
#pragma unroll
                    for (int e = 0; e < 4; ++e) { float s = S[4 * k4 + e]; s = iv + f[e] * (s - iv); S[4 * k4 + e] = s; o += s * q[e]; }
                }
                red[(kq * 16 + t) * 128 + v] = o;
            }
            __syncthreads();
            {
                f32x4 s = *(const LAS f32x4*)(red + (0 * 16 + lt) * 128 + 4 * c4);
#pragma unroll
                for (int q = 1; q < 4; ++q) s = s + *(const LAS f32x4*)(red + (q * 16 + lt) * 128 + 4 * c4);
                u32x2 w; w.x = pk2(s[0], s[1]); w.y = pk2(s[2], s[3]);
                *(u32x2*)(OH + ((size_t)(b * SEQ + t0 + lt)) * D + h * 128 + 4 * c4) = w;
            }
        }
        __syncthreads();
    }
}

DI int t5_bucket(int dist) {
    if (dist < 16) return dist;
    int b = 16;
    b += (dist >= 22); b += (dist >= 30); b += (dist >= 40); b += (dist >= 54); b += (dist >= 73); b += (dist >= 99); b += (dist >= 134); b += (dist >= 182);
    b += (dist >= 246); b += (dist >= 332); b += (dist >= 450); b += (dist >= 609); b += (dist >= 825); b += (dist >= 1117); b += (dist >= 1513);
    return b;
}
DI void p3_attn_simple(Frame& F, const Args& A) {
    const int ftid = opaque_tid(), flane = ftid & 63;
    const bf16_t* QB = (const bf16_t*)(F.ws + WS_QB); const bf16_t* KB = (const bf16_t*)(F.ws + WS_KB); const bf16_t* VT = (const bf16_t*)(F.ws + WS_VT);
    bf16_t* OG = (bf16_t*)(F.ws + WS_OG); float* LSE = (float*)(F.ws + WS_LSE); const float* relb = A.in[5];
    LAS float* pb = (LAS float*)F.lds + F.wave * 320; LAS float* qf = pb + 192;
    const int gw = F.vcu * NWAVES + F.wave, NGW = F.G * NWAVES, lane = flane;
    for (int idx = gw; idx < NB * 12 * SEQ; idx += NGW) {
        const int pos = idx & 2047, bh = idx >> 11, head = bh % 12, b = bh / 12, g = head >> 2, sh = 2 * g;
        const int r = pos >> (11 - sh), l = pos & ((2048 >> sh) - 1), s = (l << sh) + r;
        { const unsigned qw = *(const unsigned*)(QB + (size_t)idx * 128 + 2 * lane); qf[2 * lane] = bflo(qw); qf[2 * lane + 1] = bfhi(qw); }
        LDS_WAIT(); asm volatile("" ::: "memory");
        float mx = -3.0e38f;
#pragma unroll 1
        for (int rr = 0; rr < 3; ++rr) {
            const int j = rr * 64 + lane; const bool valid = (j <= 128) && (j <= l);
            const bf16_t* kp = KB + (size_t)(valid ? idx - j : idx) * 128;
            float d = 0.f;
#pragma unroll
            for (int i = 0; i < 16; ++i) { const u32x4 k = *(const u32x4*)(kp + 8 * i); const f32x4 qa = *(const LAS f32x4*)(qf + 8 * i), qb = *(const LAS f32x4*)(qf + 8 * i + 4);
                d += qa[0] * bflo(k.x) + qa[1] * bfhi(k.x) + qa[2] * bflo(k.y) + qa[3] * bfhi(k.y)
                   + qb[0] * bflo(k.z) + qb[1] * bfhi(k.z) + qb[2] * bflo(k.w) + qb[3] * bfhi(k.w); }
            const float bias = relb[t5_bucket((valid ? j : 0) << sh) * 12 + head];
            const float lgv = valid ? d + bias : -3.0e38f;
            pb[rr * 64 + lane] = lgv;
            mx = fmaxf(mx, lgv);
        }
        mx = wave_max(mx);
        float den = 0.f;
#pragma unroll 1
        for (int rr = 0; rr < 3; ++rr) { const float lgv = pb[rr * 64 + lane]; const float p = (lgv > -1.0e38f) ? __expf(lgv - mx) : 0.f; den += p; pb[rr * 64 + lane] = p; }
        den = wave_sum(den);
        LDS_WAIT(); asm volatile("" ::: "memory");
        const int nk = (l < 128 ? l : 128) + 1;
        const bf16_t* v0 = VT + ((size_t)(b * 12 + head) * 128 + lane) * 2048 + pos;
        const bf16_t* v1 = v0 + (size_t)64 * 2048;
        float o0 = 0.f, o1 = 0.f;
        for (int j = 0; j < nk; ++j) { const float p = pb[j]; o0 += p * bf1(*(v0 - j)); o1 += p * bf1(*(v1 - j)); }
        const float inv = 1.0f / den;
        const size_t orow = (size_t)g * T + (size_t)b * SEQ + s;
        OG[orow * 512 + (head & 3) * 128 + lane] = (bf16_t)f2bf(o0 * inv);
        OG[orow * 512 + (head & 3) * 128 + 64 + lane] = (bf16_t)f2bf(o1 * inv);
        if (lane == 0) LSE[orow * 4 + (head & 3)] = mx + __logf(den);
        LDS_WAIT(); asm volatile("" ::: "memory");
    }
}

typedef float f32x16 __attribute__((ext_vector_type(16)));
typedef __bf16 bf16x2_t __attribute__((ext_vector_type(2)));
typedef float f32x2_t __attribute__((ext_vector_type(2)));
DI unsigned cvtpk_s(float lo, float hi) { f32x2_t v = {lo, hi}; bf16x2_t b = __builtin_convertvector(v, bf16x2_t); return __builtin_bit_cast(unsigned, b); }
DI int crow(int reg, int h) { return (reg & 3) + 8 * (reg >> 2) + 4 * h; }
DI bf16x8 pack_step(const f32x16& x, int s) {
    u32x4 p; p.x = cvtpk_s(x[8 * s], x[8 * s + 1]); p.y = cvtpk_s(x[8 * s + 2], x[8 * s + 3]); p.z = cvtpk_s(x[8 * s + 4], x[8 * s + 5]); p.w = cvtpk_s(x[8 * s + 6], x[8 * s + 7]);
    return __builtin_bit_cast(bf16x8, p);
}
#define MFMA32(a, b, c) __builtin_amdgcn_mfma_f32_32x32x16_bf16((a), (b), (c), 0, 0, 0)
DI void p3_attn_mfma(Frame& F, const Args& A) {
    const int ftid = opaque_tid(), flane = ftid & 63;
    const bf16_t* QB = (const bf16_t*)(F.ws + WS_QB); const bf16_t* KB = (const bf16_t*)(F.ws + WS_KB); const bf16_t* VT = (const bf16_t*)(F.ws + WS_VT);
    bf16_t* OG = (bf16_t*)(F.ws + WS_OG); float* LSE = (float*)(F.ws + WS_LSE); const float* relb = A.in[5];
    LAS float* tb = (LAS float*)F.lds + F.wave * 256;
    const int gw = F.vcu * NWAVES + F.wave, NGW = F.G * NWAVES, lane = flane, r32 = lane & 31, h = lane >> 5;
    for (int u = gw; u < NB * 12 * 64; u += NGW) {
        const int bh = u >> 6, qt = u & 63, head = bh % 12, b = bh / 12, g = head >> 2, sh = 2 * g;
        const int pos0 = qt * 32, r = pos0 >> (11 - sh), l0 = pos0 & ((2048 >> sh) - 1), cbase = pos0 - l0;
#pragma unroll
        for (int k = 0; k < 3; ++k) { const int j = lane + 64 * k; tb[32 + j] = (j <= 128) ? relb[t5_bucket(j << sh) * 12 + head] : 0.f; }
        if (lane < 32) tb[lane] = 0.f;
        LDS_WAIT(); asm volatile("" ::: "memory");
        bf16x8 qf[8];
        { const bf16_t* qp = QB + ((size_t)bh * 2048 + pos0 + r32) * 128 + 8 * h; asm volatile("" : "+v"(qp));
#pragma unroll
          for (int st = 0; st < 8; ++st) qf[st] = *(const bf16x8*)(qp + 16 * st); }
        const bf16_t* kbase = KB + ((size_t)bh * 2048 + cbase + (l0 - 128) + r32) * 128 + 8 * h; asm volatile("" : "+v"(kbase));
        f32x16 S[5];
        float mx = -3.0e38f;
        int rq = r32; asm volatile("" : "+v"(rq));
#pragma unroll
        for (int t = 0; t < 5; ++t) {
            const int k0 = l0 - 128 + 32 * t;
            if (k0 >= 0) {
                const bf16_t* kp = kbase + t * (32 * 128);
                f32x16 acc;
#pragma unroll
                for (int i = 0; i < 16; ++i) acc[i] = 0.f;
#pragma unroll
                for (int st = 0; st < 8; ++st) { acc = MFMA32(*(const bf16x8*)(kp + 16 * st), qf[st], acc); if (st == 3) __builtin_amdgcn_sched_barrier(0); }
#pragma unroll
                for (int i = 0; i < 16; ++i) {
                    const int key = crow(i, h); const int delta = 128 - 32 * t + rq - key;
                    const float v = acc[i] + tb[32 + delta];
                    const bool valid = (t == 0) ? (key >= rq) : ((t == 4) ? (key <= rq) : true);
                    S[t][i] = valid ? v : -3.0e38f; mx = fmaxf(mx, S[t][i]);
                }
            }
            __builtin_amdgcn_sched_barrier(0);
        }
        mx = fmaxf(mx, __shfl_xor(mx, 32));
        float den = 0.f;
#pragma unroll
        for (int t = 0; t < 5; ++t) {
            const int k0 = l0 - 128 + 32 * t;
            if (k0 >= 0) {
#pragma unroll
                for (int i = 0; i < 16; ++i) { const float p = (S[t][i] > -1.0e38f) ? __expf(S[t][i] - mx) : 0.f; S[t][i] = p; den += p; }
            }
        }
        den += __shfl_xor(den, 32);
        const float inv = 1.0f / den;
        u32x4 Pp[5][2];
#pragma unroll
        for (int t = 0; t < 5; ++t) {
            const int k0 = l0 - 128 + 32 * t;
            if (k0 >= 0) {
#pragma unroll
                for (int s2 = 0; s2 < 2; ++s2) {
                    Pp[t][s2].x = cvtpk_s(S[t][8 * s2] * inv, S[t][8 * s2 + 1] * inv); Pp[t][s2].y = cvtpk_s(S[t][8 * s2 + 2] * inv, S[t][8 * s2 + 3] * inv);
                    Pp[t][s2].z = cvtpk_s(S[t][8 * s2 + 4] * inv, S[t][8 * s2 + 5] * inv); Pp[t][s2].w = cvtpk_s(S[t][8 * s2 + 6] * inv, S[t][8 * s2 + 7] * inv);
                }
            }
        }
        __builtin_amdgcn_sched_barrier(0);
        f32x16 O[4];
        const bf16_t* vbp[4];
#pragma unroll
        for (int db = 0; db < 4; ++db) { vbp[db] = VT + ((size_t)bh * 128 + db * 32 + r32) * 2048 + (cbase + l0 - 128 + 4 * h); asm volatile("" : "+v"(vbp[db]));
#pragma unroll
            for (int i = 0; i < 16; ++i) O[db][i] = 0.f; }
#pragma unroll
        for (int t = 0; t < 5; ++t) {
            const int k0 = l0 - 128 + 32 * t;
            if (k0 >= 0) {
#pragma unroll
                for (int s2 = 0; s2 < 2; ++s2) {
                    const bf16x8 pa = __builtin_bit_cast(bf16x8, Pp[t][s2]);
#pragma unroll
                    for (int db = 0; db < 4; ++db) {
                        const bf16_t* vp = vbp[db] + (32 * t + 16 * s2);
                        const u32x2 lo = *(const u32x2*)vp, hi = *(const u32x2*)(vp + 8);
                        u32x4 vv; vv.x = lo.x; vv.y = lo.y; vv.z = hi.x; vv.w = hi.y;
                        O[db] = MFMA32(pa, __builtin_bit_cast(bf16x8, vv), O[db]);
                    }
                }
            }
            __builtin_amdgcn_sched_barrier(0);
        }
        const size_t obase = (size_t)g * T + (size_t)b * SEQ;
#pragma unroll
        for (int i = 0; i < 16; ++i) {
            const int l = l0 + crow(i, h); const int tok = (l << sh) + r;
            bf16_t* op = OG + (obase + tok) * 512 + (head & 3) * 128 + r32;
#pragma unroll
            for (int db = 0; db < 4; ++db) op[db * 32] = (bf16_t)f2bf(O[db][i]);
        }
        if (h == 0) { const int tok = ((l0 + r32) << sh) + r; LSE[(obase + tok) * 4 + (head & 3)] = mx + __logf(den); }
        LDS_WAIT(); asm volatile("" ::: "memory");
    }
}

constexpr int H_QI = 0, H_QS = 8704, H_KS = 17408, H_KU = 26112, H_VT = 36352, H_DEC = 41472, H_TOT = 41984, H_RED = 46080;
struct HRaw { unsigned q[4], f[4]; unsigned i[4]; };
DI void h_load(HRaw& R, const bf16_t* qp, const bf16_t* fp, const bf16_t* ip, int c) {
#pragma unroll
    for (int j = 0; j < 4; ++j) { const size_t ro = (size_t)(32 * c + j) * D; R.q[j] = *(const unsigned*)(qp + ro); R.f[j] = *(const unsigned*)(fp + ro); R.i[j] = ip[ro]; }
}
DI void h_totals(const HRaw& R, LAS unsigned char* lds, int tg, int k2) {
    float lo = 0.f, hi = 0.f;
#pragma unroll
    for (int j = 0; j < 4; ++j) { lo += bflo(R.f[j]); hi += bfhi(R.f[j]); }
    *(LAS f32x2_t*)(lds + H_TOT + (tg * 128 + 2 * k2) * 4) = (f32x2_t){lo, hi};
}
DI void h_prep(const HRaw& R, LAS unsigned char* lds, int tg, int k2, int v64) {
    float base0 = 0.f, base1 = 0.f, bm0 = 0.f, bm1 = 0.f, bl0 = 0.f, bl1 = 0.f;
#pragma unroll
    for (int g = 0; g < 8; ++g) { const f32x2_t tt = *(const LAS f32x2_t*)(lds + H_TOT + (g * 128 + 2 * k2) * 4);
        if (g < tg) { base0 += tt[0]; base1 += tt[1]; } if (g < 4) { bm0 += tt[0]; bm1 += tt[1]; } bl0 += tt[0]; bl1 += tt[1]; }
    const float ebm0 = __expf(bm0), ebm1 = __expf(bm1), elm0 = __expf(bl0 - bm0), elm1 = __expf(bl1 - bm1);
    float b0 = base0, b1 = base1; float ku0[4], ku1[4];
#pragma unroll
    for (int j = 0; j < 4; ++j) {
        const float lf0 = bflo(R.f[j]), lf1 = bfhi(R.f[j]), q0 = bflo(R.q[j]), q1 = bfhi(R.q[j]);
        b0 += lf0; b1 += lf1;
        const float e20 = __expf(b0 - bm0), e21 = __expf(b1 - bm1), e30 = __builtin_amdgcn_rcpf(e20), e31 = __builtin_amdgcn_rcpf(e21);
        const float kk0 = 1.0f - __expf(lf0), kk1 = 1.0f - __expf(lf1);
        const int t = 4 * tg + j;
        *(LAS unsigned*)(lds + H_QS + t * 272 + 4 * k2) = pk2(q0 * e20, q1 * e21);
        *(LAS unsigned*)(lds + H_QI + t * 272 + 4 * k2) = pk2(q0 * e20 * ebm0, q1 * e21 * ebm1);
        *(LAS unsigned*)(lds + H_KS + t * 272 + 4 * k2) = pk2(kk0 * e30, kk1 * e31);
        ku0[j] = kk0 * e30 * elm0; ku1[j] = kk1 * e31 * elm1;
    }
    { u32x2 w; w.x = pk2(ku0[0], ku0[1]); w.y = pk2(ku0[2], ku0[3]); *(LAS u32x2*)(lds + H_KU + (2 * k2) * 80 + 8 * tg) = w;
      w.x = pk2(ku1[0], ku1[1]); w.y = pk2(ku1[2], ku1[3]); *(LAS u32x2*)(lds + H_KU + (2 * k2 + 1) * 80 + 8 * tg) = w; }
    if (tg == 0) *(LAS f32x2_t*)(lds + H_DEC + 8 * k2) = (f32x2_t){__expf(bl0), __expf(bl1)};
    { u32x2 w; w.x = (R.i[0] & 0xffffu) | (R.i[1] << 16); w.y = (R.i[2] & 0xffffu) | (R.i[3] << 16); *(LAS u32x2*)(lds + H_VT + v64 * 80 + 8 * tg) = w; }
}
DI void h_mma(f32x16& S, LAS unsigned char* lds, int kb, int vb, int r32, int hh) {
    f32x16 X, O;
    int rq = r32; asm volatile("" : "+v"(rq));
#pragma unroll
    for (int i = 0; i < 16; ++i) { X[i] = 0.f; O[i] = 0.f; }
#pragma unroll
    for (int st = 0; st < 2; ++st) {
        const bf16x8 a = *(const LAS bf16x8*)(lds + H_KS + r32 * 272 + (kb * 32 + 16 * st + 8 * hh) * 2);
        const bf16x8 b = *(const LAS bf16x8*)(lds + H_QS + r32 * 272 + (kb * 32 + 16 * st + 8 * hh) * 2);
        X = MFMA32(a, b, X);
    }
#pragma unroll
    for (int i = 0; i < 16; ++i) X[i] = (crow(i, hh) <= rq) ? X[i] : 0.f;
#pragma unroll
    for (int s2 = 0; s2 < 2; ++s2) {
        const bf16x8 pa = pack_step(X, s2);
        const LAS unsigned char* vp = lds + H_VT + (vb * 32 + r32) * 80 + (16 * s2 + 4 * hh) * 2;
        const u32x2 v0 = *(const LAS u32x2*)vp, v1 = *(const LAS u32x2*)(vp + 16);
        u32x4 vv; vv.x = v0.x; vv.y = v0.y; vv.z = v1.x; vv.w = v1.y;
        O = MFMA32(pa, __builtin_bit_cast(bf16x8, vv), O);
        const LAS unsigned char* qp = lds + H_QI + r32 * 272 + (kb * 32 + 16 * s2 + 4 * hh) * 2;
        const u32x2 q0 = *(const LAS u32x2*)qp, q1 = *(const LAS u32x2*)(qp + 16);
        u32x4 qq; qq.x = q0.x; qq.y = q0.y; qq.z = q1.x; qq.w = q1.y;
        O = MFMA32(__builtin_bit_cast(bf16x8, qq), pack_step(S, s2), O);
    }
#pragma unroll
    for (int i = 0; i < 16; ++i) *(LAS float*)(lds + H_RED + ((kb * 32 + crow(i, hh)) * 64 + vb * 32 + r32) * 4) = O[i];
#pragma unroll
    for (int g = 0; g < 4; ++g) { const f32x4 d = *(const LAS f32x4*)(lds + H_DEC + (kb * 32 + 8 * g + 4 * hh) * 4);
#pragma unroll
        for (int e = 0; e < 4; ++e) S[4 * g + e] *= d[e]; }
#pragma unroll
    for (int st = 0; st < 2; ++st) {
        const bf16x8 a = *(const LAS bf16x8*)(lds + H_KU + (kb * 32 + r32) * 80 + (16 * st + 8 * hh) * 2);
        const bf16x8 b = *(const LAS bf16x8*)(lds + H_VT + (vb * 32 + r32) * 80 + (16 * st + 8 * hh) * 2);
        S = MFMA32(a, b, S);
    }
}
DI void h_reduce_store(LAS unsigned char* lds, bf16_t* op, int c, int tid) {
    const int t = tid >> 4, c4 = tid & 15;
    f32x4 s = *(const LAS f32x4*)(lds + H_RED + ((0 * 32 + t) * 64 + 4 * c4) * 4);
#pragma unroll
    for (int q = 1; q < 4; ++q) s = s + *(const LAS f32x4*)(lds + H_RED + ((q * 32 + t) * 64 + 4 * c4) * 4);
    u32x2 w; w.x = pk2(s[0], s[1]); w.y = pk2(s[2], s[3]);
    *(u32x2*)(op + (size_t)(32 * c + t) * D + 4 * c4) = w;
}
DI void p2_hgrn_mfma(Frame& F, const Args& A) {
    const int ftid = opaque_tid(), flane = ftid & 63;
    const bf16_t* QA = (const bf16_t*)(F.ws + WS_QA); const bf16_t* LF = (const bf16_t*)(F.ws + WS_LF); const bf16_t* IA = (const bf16_t*)(F.ws + WS_IA); bf16_t* OH = (bf16_t*)(F.ws + WS_OH);
    LAS unsigned char* lds = F.lds;
    const int tid = ftid, k2 = tid & 63, tg = F.wave, v64 = tid & 63, r32 = flane & 31, hh = flane >> 5, kb = F.wave >> 1, vb = F.wave & 1;
    for (int item = F.vcu; item < 256; item += F.G) {
        const int bh = item >> 1, vhalf = item & 1, b = bh >> 4, h = bh & 15;
        const size_t rb = (size_t)b * SEQ * D;
        const bf16_t* qp = QA + rb + (size_t)(4 * tg) * D + h * 128 + 2 * k2;
        const bf16_t* fp = LF + rb + (size_t)(4 * tg) * D + h * 128 + 2 * k2;
        const bf16_t* ip = IA + rb + (size_t)(4 * tg) * D + h * 128 + vhalf * 64 + v64;
        bf16_t* op = OH + rb + h * 128 + vhalf * 64;
        f32x16 S;
#pragma unroll
        for (int i = 0; i < 16; ++i) S[i] = 0.f;
        HRaw R0, R1;
        h_load(R0, qp, fp, ip, 0); h_load(R1, qp, fp, ip, 1);
        h_totals(R0, lds, tg, k2);
        __syncthreads();
        h_prep(R0, lds, tg, k2, v64);
        __syncthreads();
        for (int c = 0; c < 64; c += 2) {
            if (c + 2 < 64) h_load(R0, qp, fp, ip, c + 2);
            h_mma(S, lds, kb, vb, r32, hh);
            h_totals(R1, lds, tg, k2);
            __syncthreads();
            h_reduce_store(lds, op, c, tid);
            h_prep(R1, lds, tg, k2, v64);
            __syncthreads();
            if (c + 3 < 64) h_load(R1, qp, fp, ip, c + 3);
            h_mma(S, lds, kb, vb, r32, hh);
            if (c + 2 < 64) h_totals(R0, lds, tg, k2);
            __syncthreads();
            h_reduce_store(lds, op, c + 1, tid);
            if (c + 2 < 64) h_prep(R0, lds, tg, k2, v64);
            __syncthreads();
        }
    }
}

DI void p4_fixups(Frame& F, const Args& A) {
    const int ftid = opaque_tid(), flane = ftid & 63;
    const bf16_t* OH = (const bf16_t*)(F.ws + WS_OH); const bf16_t* SG = (const bf16_t*)(F.ws + WS_SG); const float* hg = A.in[4];
    const bf16_t* OG = (const bf16_t*)(F.ws + WS_OG); const float* LSE = (const float*)(F.ws + WS_LSE);
    bf16_t* YA = (bf16_t*)(F.ws + WS_YA); bf16_t* YB = (bf16_t*)(F.ws + WS_YB);
    const int gw = F.vcu * NWAVES + F.wave, NGW = F.G * NWAVES, lane = flane;
    for (int row = gw; row < T; row += NGW) {
#pragma unroll
        for (int j = 0; j < 4; ++j) {
            const int c0 = 512 * j + 8 * lane;
            const u32x4 o = *(const u32x4*)(OH + (size_t)row * D + c0), sg = *(const u32x4*)(SG + (size_t)row * D + c0);
            float v[8] = {bflo(o.x), bfhi(o.x), bflo(o.y), bfhi(o.y), bflo(o.z), bfhi(o.z), bflo(o.w), bfhi(o.w)};
            const float s[8] = {bflo(sg.x), bfhi(sg.x), bflo(sg.y), bfhi(sg.y), bflo(sg.z), bfhi(sg.z), bflo(sg.w), bfhi(sg.w)};
            float ss = 0.f;
#pragma unroll
            for (int e = 0; e < 8; ++e) ss += v[e] * v[e];
            ss += __shfl_xor(ss, 1); ss += __shfl_xor(ss, 2); ss += __shfl_xor(ss, 4); ss += __shfl_xor(ss, 8);
            const float rinv = rsqrtf(ss * (1.0f / 128.0f) + EPS);
            const f32x4 g0 = *(const f32x4*)(hg + c0), g1 = *(const f32x4*)(hg + c0 + 4);
#pragma unroll
            for (int e = 0; e < 4; ++e) { v[e] = v[e] * rinv * g0[e] * s[e]; v[4 + e] = v[4 + e] * rinv * g1[e] * s[4 + e]; }
            u32x4 w; w.x = pk2(v[0], v[1]); w.y = pk2(v[2], v[3]); w.z = pk2(v[4], v[5]); w.w = pk2(v[6], v[7]);
            *(u32x4*)(YA + (size_t)row * D + c0) = w;
        }
        {
            const int c0 = 8 * lane, hs = lane >> 4;
            const float l0 = LSE[((size_t)0 * T + row) * 4 + hs], l1 = LSE[((size_t)1 * T + row) * 4 + hs], l2 = LSE[((size_t)2 * T + row) * 4 + hs];
            const float mx = fmaxf(l0, fmaxf(l1, l2)); float a0 = __expf(l0 - mx), a1 = __expf(l1 - mx), a2 = __expf(l2 - mx);
            const float inv = 1.0f / (a0 + a1 + a2); a0 *= inv; a1 *= inv; a2 *= inv;
            const u32x4 x0 = *(const u32x4*)(OG + ((size_t)0 * T + row) * 512 + c0), x1 = *(const u32x4*)(OG + ((size_t)1 * T + row) * 512 + c0), x2 = *(const u32x4*)(OG + ((size_t)2 * T + row) * 512 + c0);
            u32x4 w;
            w.x = pk2(a0 * bflo(x0.x) + a1 * bflo(x1.x) + a2 * bflo(x2.x), a0 * bfhi(x0.x) + a1 * bfhi(x1.x) + a2 * bfhi(x2.x));
            w.y = pk2(a0 * bflo(x0.y) + a1 * bflo(x1.y) + a2 * bflo(x2.y), a0 * bfhi(x0.y) + a1 * bfhi(x1.y) + a2 * bfhi(x2.y));
            w.z = pk2(a0 * bflo(x0.z) + a1 * bflo(x1.z) + a2 * bflo(x2.z), a0 * bfhi(x0.z) + a1 * bfhi(x1.z) + a2 * bfhi(x2.z));
            w.w = pk2(a0 * bflo(x0.w) + a1 * bflo(x1.w) + a2 * bflo(x2.w), a0 * bfhi(x0.w) + a1 * bfhi(x1.w) + a2 * bfhi(x2.w));
            *(u32x4*)(YB + (size_t)row * 512 + c0) = w;
        }
    }
}

template <int MODE> struct EpiGate {
    static constexpr bool PERM = true;
    const bf16_t* gate; bf16_t* tmp; bf16_t* outp;
    DI void operator()(const f32x4 (&acc)[2][2][4][2], const pg8::Unit& u, int wr, int wc, int fr, int fq) const {
        const int row0 = u.pm * 256 + wr * 64 + fr, col0 = u.pn * 256 + wc * 32 + 8 * fq;
#pragma unroll
        for (int ai = 0; ai < 2; ++ai)
#pragma unroll
            for (int m = 0; m < 4; ++m)
#pragma unroll
                for (int bj = 0; bj < 2; ++bj) {
                    const size_t o = (size_t)(row0 + ai * 128 + m * 16) * D + col0 + bj * 128;
                    const u32x4 gt = *(const u32x4*)(gate + o);
                    float v[8];
#pragma unroll
                    for (int e = 0; e < 4; ++e) { v[e] = acc[ai][bj][m][0][e]; v[4 + e] = acc[ai][bj][m][1][e]; }
                    v[0] *= bflo(gt.x); v[1] *= bfhi(gt.x); v[2] *= bflo(gt.y); v[3] *= bfhi(gt.y); v[4] *= bflo(gt.z); v[5] *= bfhi(gt.z); v[6] *= bflo(gt.w); v[7] *= bfhi(gt.w);
                    if (MODE == 1) { const u32x4 tp = *(const u32x4*)(tmp + o);
                        v[0] += bflo(tp.x); v[1] += bfhi(tp.x); v[2] += bflo(tp.y); v[3] += bfhi(tp.y); v[4] += bflo(tp.z); v[5] += bfhi(tp.z); v[6] += bflo(tp.w); v[7] += bfhi(tp.w); }
                    u32x4 w; w.x = pg8::cvt_pk_bf16(v[0], v[1]); w.y = pg8::cvt_pk_bf16(v[2], v[3]); w.z = pg8::cvt_pk_bf16(v[4], v[5]); w.w = pg8::cvt_pk_bf16(v[6], v[7]);
                    *(u32x4*)((MODE == 1 ? outp : tmp) + o) = w;
                }
    }
};
struct EpiOut {
    static constexpr bool PERM = true;
    const float* x; float* x1; bf16_t* x1b;
    DI void operator()(const f32x4 (&acc)[2][2][4][2], const pg8::Unit& u, int wr, int wc, int fr, int fq) const {
        const int row0 = u.pm * 256 + wr * 64 + fr, col0 = u.pn * 256 + wc * 32 + 8 * fq;
#pragma unroll
        for (int ai = 0; ai < 2; ++ai)
#pragma unroll
            for (int m = 0; m < 4; ++m)
#pragma unroll
                for (int bj = 0; bj < 2; ++bj) {
                    const size_t o = (size_t)(row0 + ai * 128 + m * 16) * D + col0 + bj * 128;
                    const f32x4 a0 = *(const f32x4*)(x + o) + acc[ai][bj][m][0], a1 = *(const f32x4*)(x + o + 4) + acc[ai][bj][m][1];
                    *(f32x4*)(x1 + o) = a0; *(f32x4*)(x1 + o + 4) = a1;
                    u32x4 w; w.x = pg8::cvt_pk_bf16(a0[0], a0[1]); w.y = pg8::cvt_pk_bf16(a0[2], a0[3]); w.z = pg8::cvt_pk_bf16(a1[0], a1[1]); w.w = pg8::cvt_pk_bf16(a1[2], a1[3]);
                    *(u32x4*)(x1b + o) = w;
                }
    }
};

DI void p7_router(Frame& F, const Args& A) {
    const int ftid = opaque_tid(), flane = ftid & 63;
    const float* X1 = (const float*)(F.ws + WS_X1); const float* g2 = A.in[9]; const float* wrg = A.in[10]; const float* brg = A.in[11]; const float* wre = A.in[12]; const float* bre = A.in[13];
    int* EID = (int*)(F.ws + WS_EID); float* GWT = (float*)(F.ws + WS_GWT); float* R2 = (float*)(F.ws + WS_R2);
    unsigned* cnt = (unsigned*)(F.ws + WS_CTL) + CW_CNT;
    int* rowtok = (int*)(F.ws + WS_ROWTOK); int* rowdst = (int*)(F.ws + WS_ROWDST);
    const int gw = F.vcu * NWAVES + F.wave, NGW = F.G * NWAVES, lane = flane;
    for (int p = F.vcu * NTHREADS + ftid; p < PMAX; p += F.G * NTHREADS) { rowtok[p] = 0; rowdst[p] = -1; }
    for (int row = gw; row < T; row += NGW) {
        const f32x4* xr = (const f32x4*)(X1 + (size_t)row * D) + lane;
        f32x4 v[8]; float ss = 0.f;
#pragma unroll
        for (int j = 0; j < 8; ++j) { v[j] = xr[64 * j]; ss += (v[j][0] * v[j][0] + v[j][1] * v[j][1]) + (v[j][2] * v[j][2] + v[j][3] * v[j][3]); }
        const float r = rsqrtf(wave_sum(ss) * (1.0f / D) + EPS);
#pragma unroll
        for (int j = 0; j < 8; ++j) { const f32x4 g = ((const f32x4*)g2)[lane + 64 * j]; v[j] = v[j] * r * g; }
        float a[8];
#pragma unroll
        for (int e = 0; e < 8; ++e) a[e] = 0.f;
#pragma unroll
        for (int j = 0; j < 8; ++j)
#pragma unroll
            for (int i = 0; i < 4; ++i) { const int c = 4 * lane + 256 * j + i; const f32x4 w0 = *(const f32x4*)(wrg + (size_t)c * 8), w1 = *(const f32x4*)(wrg + (size_t)c * 8 + 4); const float h = v[j][i];
#pragma unroll
                for (int e = 0; e < 4; ++e) { a[e] += h * w0[e]; a[4 + e] += h * w1[e]; }
                if (i == 3) __builtin_amdgcn_sched_barrier(0); }
        int gsel = 0; float gmax = -3.0e38f;
#pragma unroll
        for (int e = 0; e < 8; ++e) { a[e] = wave_sum(a[e]) + brg[e]; if (a[e] > gmax) { gmax = a[e]; gsel = e; } }
        float gden = 0.f;
#pragma unroll
        for (int e = 0; e < 8; ++e) gden += __expf(a[e] - gmax);
        const float pg = 1.0f / gden;
        gsel = __builtin_amdgcn_readfirstlane(gsel);
#pragma unroll
        for (int e = 0; e < 8; ++e) a[e] = 0.f;
#pragma unroll
        for (int j = 0; j < 8; ++j)
#pragma unroll
            for (int i = 0; i < 4; ++i) { const int c = 4 * lane + 256 * j + i; const f32x4 w0 = *(const f32x4*)(wre + (size_t)c * 64 + gsel * 8), w1 = *(const f32x4*)(wre + (size_t)c * 64 + gsel * 8 + 4); const float h = v[j][i];
#pragma unroll
                for (int e = 0; e < 4; ++e) { a[e] += h * w0[e]; a[4 + e] += h * w1[e]; }
                if (i == 3) __builtin_amdgcn_sched_barrier(0); }
        int i1 = 0; float v1 = -3.0e38f;
#pragma unroll
        for (int e = 0; e < 8; ++e) { a[e] = wave_sum(a[e]) + bre[gsel * 8 + e]; if (a[e] > v1) { v1 = a[e]; i1 = e; } }
        int i2 = 0; float v2 = -3.0e38f;
#pragma unroll
        for (int e = 0; e < 8; ++e) { if (e != i1 && a[e] > v2) { v2 = a[e]; i2 = e; } }
        const float e2 = __expf(v2 - v1), p1 = 1.0f / (1.0f + e2), p2 = e2 * p1;
        if (lane == 0) {
            const int ea = gsel * 8 + i1, eb = gsel * 8 + i2;
            EID[row * 2] = ea; EID[row * 2 + 1] = eb; GWT[row * 2] = pg * p1; GWT[row * 2 + 1] = pg * p2; R2[row] = r;
            atomicAdd(&cnt[ea], 1u); atomicAdd(&cnt[eb], 1u);
        }
    }
    LAS unsigned* scr = (LAS unsigned*)(F.lds + F.wave * 8192);
    constexpr int I_G = NE * 32 * 8, I_D = NE * 8 * 32;
    for (int it = gw; it < 2 * I_G + I_D; it += NGW) {
        int r_ = it;
        if (r_ < 2 * I_G) { const int up = r_ >= I_G; if (up) r_ -= I_G; const int e = r_ >> 8, rem = r_ & 255;
            const float* W = (up ? A.in[15] : A.in[14]) + (size_t)e * D * FF; bf16_t* WT = (bf16_t*)(F.ws + WS_WGU) + (size_t)e * 1024 * D;
            if (up) cvt_item<2>(W, FF, D, WT, g2, scr, rem >> 3, rem & 7, lane); else cvt_item<1>(W, FF, D, WT, g2, scr, rem >> 3, rem & 7, lane);
            continue; }
        r_ -= 2 * I_G; { const int e = r_ >> 8, rem = r_ & 255;
            cvt_item<0>(A.in[16] + (size_t)e * FF * D, D, FF, (bf16_t*)(F.ws + WS_WD) + (size_t)e * D * FF, nullptr, scr, rem >> 5, rem & 31, lane); }
    }
}

DI int moe_tables(Frame& F, LAS int* rbe, LAS int* bstart) {
    const int ftid = opaque_tid();
    const unsigned* cnt = (const unsigned*)(F.ws + WS_CTL) + CW_CNT;
    __syncthreads();
    if (ftid == 0) {
        int acc = 0;
        for (int e = 0; e < NE; ++e) { const int c = (int)__hip_atomic_load(cnt + e, __ATOMIC_RELAXED, __HIP_MEMORY_SCOPE_AGENT); const int nb = (c + 255) >> 8; bstart[e] = acc; for (int k = 0; k < nb; ++k) rbe[acc + k] = e; acc += nb; }
        bstart[NE] = acc;
    }
    __syncthreads();
    return bstart[NE];
}

DI void p8_scatter(Frame& F, const Args& A) {
    const int ftid = opaque_tid(), flane = ftid & 63;
    LAS int* rbe = (LAS int*)(F.lds + LDSCTL_OFF); LAS int* bstart = (LAS int*)(F.lds);
    (void)moe_tables(F, rbe, bstart);
    const int* EID = (const int*)(F.ws + WS_EID); const float* GWT = (const float*)(F.ws + WS_GWT); const float* R2 = (const float*)(F.ws + WS_R2);
    unsigned* fill = (unsigned*)(F.ws + WS_CTL) + CW_FILL;
    int* rowtok = (int*)(F.ws + WS_ROWTOK); int* rowdst = (int*)(F.ws + WS_ROWDST); float* roww = (float*)(F.ws + WS_ROWW); float* rowr2 = (float*)(F.ws + WS_ROWR2);
    for (int a = F.vcu * NTHREADS + ftid; a < 2 * T; a += F.G * NTHREADS) {
        const int e = EID[a]; const unsigned k = atomicAdd(&fill[e], 1u); const int p = bstart[e] * 256 + (int)k;
        rowtok[p] = a >> 1; rowdst[p] = a; roww[p] = GWT[a]; rowr2[p] = R2[a >> 1];
    }
    __syncthreads();
}

struct EpiGU {
    static constexpr bool PERM = true;
    const float* rowr2; bf16_t* U;
    DI void operator()(const f32x4 (&acc)[2][2][4][2], const pg8::Unit& u, int wr, int wc, int fr, int fq) const {
        const int row0 = u.pm * 256 + wr * 64 + fr, pnr = u.pn & 3;
#pragma unroll
        for (int ai = 0; ai < 2; ++ai)
#pragma unroll
            for (int m = 0; m < 4; ++m) {
                const int p = row0 + ai * 128 + m * 16; const float r = rowr2[p];
#pragma unroll
                for (int bj = 0; bj < 2; ++bj) {
                    const int f0 = 128 * pnr + 64 * bj + 16 * wc + 4 * fq;
                    float o[4];
#pragma unroll
                    for (int e = 0; e < 4; ++e) { const float g = acc[ai][bj][m][0][e] * r, up = acc[ai][bj][m][1][e] * r; o[e] = g * sigmoidf_(g) * up; }
                    u32x2 w; w.x = pg8::cvt_pk_bf16(o[0], o[1]); w.y = pg8::cvt_pk_bf16(o[2], o[3]);
                    *(u32x2*)(U + (size_t)p * FF + f0) = w;
                }
            }
    }
};
struct EpiDown {
    static constexpr bool PERM = true;
    const int* rowdst; const float* roww; bf16_t* YK;
    DI void operator()(const f32x4 (&acc)[2][2][4][2], const pg8::Unit& u, int wr, int wc, int fr, int fq) const {
        const int row0 = u.pm * 256 + wr * 64 + fr, col0 = (u.pn & 7) * 256 + wc * 32 + 8 * fq;
#pragma unroll
        for (int ai = 0; ai < 2; ++ai)
#pragma unroll
            for (int m = 0; m < 4; ++m) {
                const int p = row0 + ai * 128 + m * 16; const int dst = rowdst[p]; const float w = roww[p];
                if (dst >= 0) {
#pragma unroll
                    for (int bj = 0; bj < 2; ++bj) {
                        const f32x4 a0 = acc[ai][bj][m][0] * w, a1 = acc[ai][bj][m][1] * w;
                        u32x4 o; o.x = pg8::cvt_pk_bf16(a0[0], a0[1]); o.y = pg8::cvt_pk_bf16(a0[2], a0[3]); o.z = pg8::cvt_pk_bf16(a1[0], a1[1]); o.w = pg8::cvt_pk_bf16(a1[2], a1[3]);
                        *(u32x4*)(YK + (size_t)dst * D + col0 + bj * 128) = o;
                    }
                }
            }
    }
};

DI void p11_final(Frame& F, const Args& A) {
    const int ftid = opaque_tid(), flane = ftid & 63;
    const float* X1 = (const float*)(F.ws + WS_X1); const bf16_t* YK = (const bf16_t*)(F.ws + WS_YK); const float* gf = A.in[17];
    const int gw = F.vcu * NWAVES + F.wave, NGW = F.G * NWAVES, lane = flane;
    for (int row = gw; row < T; row += NGW) {
        float v[32]; float ss = 0.f;
#pragma unroll
        for (int j = 0; j < 4; ++j) {
            const int c0 = 512 * j + 8 * lane;
            const f32x4 a0 = *(const f32x4*)(X1 + (size_t)row * D + c0), a1 = *(const f32x4*)(X1 + (size_t)row * D + c0 + 4);
            const u32x4 y0 = *(const u32x4*)(YK + (size_t)(2 * row) * D + c0), y1 = *(const u32x4*)(YK + (size_t)(2 * row + 1) * D + c0);
            v[8 * j + 0] = a0[0] + (bflo(y0.x) + bflo(y1.x)); v[8 * j + 1] = a0[1] + (bfhi(y0.x) + bfhi(y1.x)); v[8 * j + 2] = a0[2] + (bflo(y0.y) + bflo(y1.y)); v[8 * j + 3] = a0[3] + (bfhi(y0.y) + bfhi(y1.y));
            v[8 * j + 4] = a1[0] + (bflo(y0.z) + bflo(y1.z)); v[8 * j + 5] = a1[1] + (bfhi(y0.z) + bfhi(y1.z)); v[8 * j + 6] = a1[2] + (bflo(y0.w) + bflo(y1.w)); v[8 * j + 7] = a1[3] + (bfhi(y0.w) + bfhi(y1.w));
#pragma unroll
            for (int e = 0; e < 8; ++e) ss += v[8 * j + e] * v[8 * j + e];
        }
        const float r = rsqrtf(wave_sum(ss) * (1.0f / D) + EPS);
#pragma unroll
        for (int j = 0; j < 4; ++j) {
            const int c0 = 512 * j + 8 * lane;
            const f32x4 g0 = *(const f32x4*)(gf + c0), g1 = *(const f32x4*)(gf + c0 + 4);
            *(f32x4*)(F.out + (size_t)row * D + c0) = (f32x4){v[8 * j] * r * g0[0], v[8 * j + 1] * r * g0[1], v[8 * j + 2] * r * g0[2], v[8 * j + 3] * r * g0[3]};
            *(f32x4*)(F.out + (size_t)row * D + c0 + 4) = (f32x4){v[8 * j + 4] * r * g1[0], v[8 * j + 5] * r * g1[1], v[8 * j + 6] * r * g1[2], v[8 * j + 7] * r * g1[3]};
        }
    }
}

constexpr int N_PHASES = 12;
__global__ void __launch_bounds__(NTHREADS, 2) fwd(Args args) {
    extern __shared__ __attribute__((aligned(16))) unsigned char lds_raw[];
    Frame F;
    F.lds = (LAS unsigned char*)lds_raw;
    F.wave = __builtin_amdgcn_readfirstlane(threadIdx.x >> 6);
    F.G = gridDim.x; { const int bx = blockIdx.x; F.vcu = (F.G % 8 == 0) ? (bx % 8) * (F.G / 8) + bx / 8 : bx; }
    F.ws = args.ws; F.out = args.out;
    volatile LAS unsigned* MISC = (volatile LAS unsigned*)(F.lds + MISC_OFF);
    for (int u = threadIdx.x; u < (LDS_BYTES - LDSCTL_OFF) / 4; u += NTHREADS) ((LAS unsigned*)(F.lds + LDSCTL_OFF))[u] = 0u;
    __syncthreads();
    unsigned* ctl = (unsigned*)(F.ws + WS_CTL);
    XcdBarrier bar; bar.bar = ctl + CW_BAR; bar.x = 0; bar.st = nullptr;
    if (MK_N_LAUNCHES == 1) bar = xcd_barrier_post(ctl + CW_BAR, MISC + 8);
#define GRID_BAR() do { if (MK_N_LAUNCHES == 1) xcd_barrier(bar); } while (0)
    const int lo = args.ph_lo, hi = args.ph_hi;
#ifndef PHASE_MASK
#define PHASE_MASK 0xFFF
#endif
#define IN(k) (((PHASE_MASK >> (k)) & 1) && lo <= (k) && (k) < hi)
#define BOTH(k) (IN(k) && IN((k) + 1))
#ifndef REPEAT_MASK
#define REPEAT_MASK 0
#endif
#define RUN(k, ...) do { __VA_ARGS__; if constexpr (((REPEAT_MASK >> (k)) & 1) != 0) { __syncthreads(); __VA_ARGS__; } } while (0)

    if (IN(0)) { RUN(0, p0_prologue(F, args)); if (BOTH(0)) GRID_BAR(); }
    if (IN(1)) {
        pg8::Gemm g{(const bf16_t*)(F.ws + WS_H), (const bf16_t*)(F.ws + WS_WIN), D, nullptr}; pg8::StaticOrder S; S.init(T, INW, F.G, (int)blockIdx.x);
        EpiProj E{F.ws, args.in[3]};
        RUN(1, pg8::gemm_phase<EpiProj, pg8::StaticOrder, true, true, false>(F.lds, g, S, E));
        if (BOTH(1)) GRID_BAR();
    }
    if (IN(2)) { RUN(2, p2_hgrn_mfma(F, args)); }
    if (IN(3)) { RUN(3, p3_attn_mfma(F, args)); if (BOTH(3)) GRID_BAR(); }
    if (IN(4)) { RUN(4, p4_fixups(F, args)); if (BOTH(4)) GRID_BAR(); }
    if (IN(5)) { {
        {   pg8::Gemm g{(const bf16_t*)(F.ws + WS_YB), (const bf16_t*)(F.ws + WS_WB), 512, nullptr}; pg8::StaticOrder S; S.init(T, D, F.G, (int)blockIdx.x);
            EpiGate<0> E{(const bf16_t*)(F.ws + WS_GB), (bf16_t*)(F.ws + WS_TMP), nullptr};
            RUN(5, pg8::gemm_phase<EpiGate<0>, pg8::StaticOrder, true, true, false>(F.lds, g, S, E)); }
        VM_WAIT(); __syncthreads();
        {   pg8::Gemm g{(const bf16_t*)(F.ws + WS_YA), (const bf16_t*)(F.ws + WS_WA), D, nullptr}; pg8::StaticOrder S; S.init(T, D, F.G, (int)blockIdx.x);
            EpiGate<1> E{(const bf16_t*)(F.ws + WS_GA), (bf16_t*)(F.ws + WS_TMP), (bf16_t*)(F.ws + WS_MERGED)};
            RUN(5, pg8::gemm_phase<EpiGate<1>, pg8::StaticOrder, true, true, false>(F.lds, g, S, E)); }
        }
        if (BOTH(5)) GRID_BAR();
    }
    if (IN(6)) {
        pg8::Gemm g{(const bf16_t*)(F.ws + WS_MERGED), (const bf16_t*)(F.ws + WS_WOUT), D, nullptr}; pg8::StaticOrder S; S.init(T, D, F.G, (int)blockIdx.x);
        EpiOut E{args.in[0], (float*)(F.ws + WS_X1), (bf16_t*)(F.ws + WS_X1B)};
        RUN(6, pg8::gemm_phase<EpiOut, pg8::StaticOrder, true, true, false>(F.lds, g, S, E));
        if (BOTH(6)) GRID_BAR();
    }
    if (IN(7)) { p7_router(F, args); if (BOTH(7)) GRID_BAR(); }
    if (IN(8)) { p8_scatter(F, args); if (BOTH(8)) GRID_BAR(); }
    if (IN(9)) {
        LAS int* rbe = (LAS int*)(F.lds + LDSCTL_OFF); LAS int* bstart = (LAS int*)(F.lds + LDSCTL_OFF + 768 + 256 + 64);
        const int nrb = moe_tables(F, rbe, bstart);
        pg8::Gemm g{(const bf16_t*)(F.ws + WS_X1B), (const bf16_t*)(F.ws + WS_WGU), D, (const int*)(F.ws + WS_ROWTOK)};
        pg8::MoeOrder S{rbe, nrb, 4, F.G, F.vcu};
        EpiGU E{(const float*)(F.ws + WS_ROWR2), (bf16_t*)(F.ws + WS_U)};
        RUN(9, pg8::gemm_phase<EpiGU, pg8::MoeOrder, true, true, true>(F.lds, g, S, E));
        if (BOTH(9)) GRID_BAR();
    }
    if (IN(10)) {
        LAS int* rbe = (LAS int*)(F.lds + LDSCTL_OFF); LAS int* bstart = (LAS int*)(F.lds + LDSCTL_OFF + 768 + 256 + 64);
        const int nrb = moe_tables(F, rbe, bstart);
        pg8::Gemm g{(const bf16_t*)(F.ws + WS_U), (const bf16_t*)(F.ws + WS_WD), FF, nullptr};
        pg8::MoeOrder S{rbe, nrb, 8, F.G, F.vcu};
        EpiDown E{(const int*)(F.ws + WS_ROWDST), (const float*)(F.ws + WS_ROWW), (bf16_t*)(F.ws + WS_YK)};
        RUN(10, pg8::gemm_phase<EpiDown, pg8::MoeOrder, true, true, false>(F.lds, g, S, E));
        if (BOTH(10)) GRID_BAR();
    }
    if (IN(11)) { RUN(11, p11_final(F, args)); }
#undef IN
#undef BOTH
}

extern "C" void kernel_launch(void* const* d_in, const int* in_sizes, int n_in, void* d_out, int out_size, void* d_ws, size_t ws_size, hipStream_t stream) {
    static int grid = 0;
    if (grid == 0) {
        if (n_in != 18 || in_sizes[0] != T * D || out_size != T * D || ws_size < WS_END) { fprintf(stderr, "kernel_launch: unexpected shapes: n_in %d in0 %d out %d ws %zu (need %zu)\n", n_in, n_in > 0 ? in_sizes[0] : -1, out_size, ws_size, (size_t)WS_END); grid = -1; return; }
        int dev = 0, cus = 0, per_cu = 0;
        if (hipGetDevice(&dev) != hipSuccess || hipDeviceGetAttribute(&cus, hipDeviceAttributeMultiprocessorCount, dev) != hipSuccess) { grid = -1; return; }
        if (hipFuncSetAttribute((const void*)fwd, hipFuncAttributeMaxDynamicSharedMemorySize, LDS_BYTES) != hipSuccess) { fprintf(stderr, "kernel_launch: hipFuncSetAttribute failed\n"); grid = -1; return; }
        if (hipOccupancyMaxActiveBlocksPerMultiprocessor(&per_cu, (const void*)fwd, NTHREADS, LDS_BYTES) != hipSuccess || per_cu < 1) fprintf(stderr, "kernel_launch: occupancy query reports %d\n", per_cu);
        (void)hipGetLastError();
        grid = cus;
        fprintf(stderr, "kernel_launch: grid %d, occupancy query %d, ws %zu\n", grid, per_cu, ws_size);
    }
    if (grid < 0) return;
    if (hipMemsetAsync((char*)d_ws + WS_CTL, 0, CTL_ZERO_BYTES, stream) != hipSuccess) return;
    Args a{};
    for (int i = 0; i < 18; ++i) a.in[i] = (const float*)d_in[i];
    a.out = (float*)d_out; a.ws = (unsigned char*)d_ws;
    const int nl = MK_N_LAUNCHES;
    for (int li = 0; li < nl; ++li) {
        a.ph_lo = (nl == 1) ? 0 : li; a.ph_hi = (nl == 1) ? N_PHASES : li + 1; a.li = li; a.pad = 0;
        hipLaunchKernelGGL(fwd, dim3(grid), dim3(NTHREADS), LDS_BYTES, stream, a);
        const hipError_t le = hipPeekAtLastError();
        if (le != hipSuccess) { fprintf(stderr, "kernel_launch: launch %d failed: %s\n", li, hipGetErrorName(le)); break; }
    }
}
```

```cpp
#include <hip/hip_runtime.h>
#include <cstdio>
#include <cstdint>

#ifndef MK_N_LAUNCHES
#define MK_N_LAUNCHES 1
#endif

#define DI __device__ __forceinline__
#define GAS __attribute__((address_space(1)))
#define LAS __attribute__((address_space(3)))
typedef unsigned short bf16_t;
typedef short bf16x8 __attribute__((ext_vector_type(8)));
typedef float f32x4 __attribute__((ext_vector_type(4)));
typedef unsigned u32x4 __attribute__((ext_vector_type(4)));
typedef unsigned u32x2 __attribute__((ext_vector_type(2)));

constexpr int NB = 8, SEQ = 2048, T = NB * SEQ, D = 2048;
constexpr int INW = 16896;
constexpr int NE = 64, FF = 512;
constexpr int PMAX = 49152;
constexpr int WD_EARLY = 16;
constexpr int GU_EARLY = 12;
constexpr float EPS = 1e-6f;
constexpr int NWAVES = 8, NTHREADS = 512;

constexpr size_t MiB = 1u << 20;
constexpr size_t WS_CTL = 0, CTL_ZERO_BYTES = 1 * MiB;
constexpr size_t WS_EID = 1 * MiB, WS_GWT = WS_EID + 256 * 1024, WS_R2 = WS_GWT + 256 * 1024;
constexpr size_t WS_ROWTOK = 2 * MiB, WS_ROWDST = WS_ROWTOK + 256 * 1024, WS_ROWW = WS_ROWDST + 256 * 1024, WS_ROWR2 = WS_ROWW + 256 * 1024;
constexpr size_t WS_WRT = 4 * MiB;
constexpr size_t WS_LSE = 3 * MiB;
constexpr size_t WS_WCAT = 8 * MiB, WS_WOUT = 18 * MiB;
constexpr size_t WS_WIN = 32 * MiB, WS_H = 98 * MiB;
constexpr size_t WS_QA = 162 * MiB, WS_LF = 226 * MiB, WS_IA = 290 * MiB, WS_SG = 354 * MiB;
constexpr size_t WS_QB = 418 * MiB, WS_KB = 466 * MiB, WS_VT = 514 * MiB, WS_GA = 562 * MiB, WS_GB = 626 * MiB;
constexpr size_t WS_OH = 690 * MiB, WS_OG = 754 * MiB;
constexpr size_t WS_YCAT = 803 * MiB, WS_MERGED = 98 * MiB  , WS_WD = 883 * MiB  , WS_WGU_E = 1014 * MiB  , WS_END = 1062 * MiB;
constexpr int KCAT = 2560;
constexpr size_t WS_X1 = 162 * MiB, WS_X1B = 290 * MiB, WS_WGU = 354 * MiB, WS_U = 738 * MiB, WS_YK = 32 * MiB;
static_assert(WS_U + (size_t)PMAX * FF * 2 <= WS_YCAT, "ws map");
constexpr int CW_BAR = 4096;
constexpr int CW_CNT = 16384;
constexpr int CW_FILL = 16384 + 64;

constexpr int RING_BYTES = 131072;
constexpr int LDSCTL_OFF = RING_BYTES;
constexpr int MISC_OFF = LDSCTL_OFF + 1024;
constexpr int LDS_BYTES = 147456;

DI unsigned f2bf(float f) { unsigned u = __builtin_bit_cast(unsigned, f); return (u + 0x7fffu + ((u >> 16) & 1u)) >> 16; }
typedef __bf16 bf16x2_t __attribute__((ext_vector_type(2)));
typedef float f32x2_t __attribute__((ext_vector_type(2)));
DI unsigned cvtpk_s(float lo, float hi) { f32x2_t v = {lo, hi}; bf16x2_t b = __builtin_convertvector(v, bf16x2_t); return __builtin_bit_cast(unsigned, b); }
DI unsigned pk2(float lo, float hi) { return cvtpk_s(lo, hi); }
DI float bflo(unsigned w) { return __builtin_bit_cast(float, w << 16); }
DI float bfhi(unsigned w) { return __builtin_bit_cast(float, w & 0xffff0000u); }
DI float bf1(bf16_t b) { return __builtin_bit_cast(float, (unsigned)b << 16); }
DI float sigmoidf_(float x) { return __builtin_amdgcn_rcpf(1.0f + __expf(-x)); }
#ifndef EPI_SC1
#define EPI_SC1 0
#endif
DI void st16_stream(void* p, u32x4 v) {
#if EPI_SC1
    asm volatile("global_store_dwordx4 %0, %1, off sc1\n\ts_nop 1" :: "v"(p), "v"(v) : "memory");
#else
    *(u32x4*)p = v;
#endif
}
#define LDS_WAIT() asm volatile("s_waitcnt lgkmcnt(0)" ::: "memory")
#define VM_WAIT() asm volatile("s_waitcnt vmcnt(0)" ::: "memory")

namespace pg8 {
constexpr int BM = 256, BK = 64, HALF = 128, HTB = HALF * BK * 2, STAGE_BYTES = 8 * HTB, NXCD = 8, WGM = 8;
__host__ __device__ __forceinline__ int lds_byte(int r, int c) { const int st = (r >> 4) * 2 + (c >> 5), rr = r & 15, cc = c & 31, ob = rr * 64 + cc * 2; return st * 1024 + (ob ^ (((ob >> 9) & 1) << 5)); }
__host__ __device__ __forceinline__ void stage_rc(int b, int& R, int& C) { const int st = b / 1024, sb = b % 1024, swz = sb ^ (((sb >> 9) & 1) << 5); R = (st >> 1) * 16 + swz / 64; C = (st & 1) * 32 + (swz % 64) / 2; }
__host__ __device__ __forceinline__ int perm32(int rho) { const int n = rho >> 4, i = rho & 15; return 8 * (i >> 2) + 4 * n + (i & 3); }

struct Unit { int pm, pn; };
struct Gemm { const bf16_t* A; const bf16_t* Bt; int K; const int* rowtok; };

struct StaticOrder {
    int nM, nN, nwg, G, c;
    __host__ __device__ void init(int M, int N, int G_, int c_) { nM = M / BM; nN = N / BM; nwg = nM * nN; G = G_; c = c_; }
    __host__ __device__ bool next(int i, Unit& u) const {
        const long L = (long)i * G + c; if (L >= nwg) return false;
        int wgid = (int)L; { const int q = nwg / NXCD, r = nwg % NXCD, xcd = wgid % NXCD, off = wgid / NXCD; wgid = (xcd < r ? xcd * (q + 1) : r * (q + 1) + (xcd - r) * q) + off; }
        const int nig = WGM * nN, gid = wgid / nig, fm = gid * WGM, gsz = (nM - fm) < WGM ? (nM - fm) : WGM;
        u.pm = fm + ((wgid % nig) % gsz); u.pn = (wgid % nig) / gsz; return true;
    }
};
struct MoeOrder {
    const LAS int* rbe; int nrb, NT, G, vcu, n_early, early_off;
    DI bool next(int i, Unit& u) const {
        const int L = i * G + vcu; if (L >= nrb * NT) return false;
        const int rb = L / NT, pnr = L - rb * NT; const int e = rbe[rb]; u.pm = rb; u.pn = e * NT + pnr + (e < n_early ? early_off : 0); return true;
    }
};

DI unsigned cvt_pk_bf16(float lo, float hi) { unsigned r; asm volatile("v_cvt_pk_bf16_f32 %0, %1, %2" : "=v"(r) : "v"(lo), "v"(hi)); return r; }

template <class Epi, class Sched, bool ALIGN_EPI, bool SP2, bool GATHER>
DI void gemm_phase(LAS unsigned char* lds, const Gemm g, const Sched& S, const Epi& E) {
    const int tid = threadIdx.x, wid = __builtin_amdgcn_readfirstlane(tid >> 6), lane = tid & 63, wr = wid >> 2, wc = wid & 3, fr = lane & 15, fq = lane >> 4;
    const int K = g.K, nt = K / BK;
    unsigned voffA[2], voffB[2]; int RA[2], CA[2];
#pragma unroll
    for (int i = 0; i < 2; ++i) { int R, C; stage_rc(tid * 16 + i * 8192, R, C); const int Rb = Epi::PERM ? ((R & ~31) + perm32(R & 31)) : R;
        voffA[i] = (unsigned)(R * K + C) * 2u; voffB[i] = (unsigned)(Rb * K + C) * 2u; RA[i] = R; CA[i] = C; }
    const size_t kstep = (size_t)(BK * 2);
    const size_t hstep = (size_t)HALF * K * 2;
    const size_t tstep = 2 * hstep;
    const size_t hstepA = GATHER ? 0 : hstep;
    const unsigned ldsw = (unsigned)wid * 1024u;
    const int aoff = lds_byte(wr * 64 + fr, fq * 8), boff = lds_byte(wc * 32 + fr, fq * 8);
#define PG8_SA(b, h) (((b) * 2 + (h)) * HTB)
#define PG8_SB(b, h) ((4 + (b) * 2 + (h)) * HTB)
#define PG8_STAGE2(bufoff, gbase, v0, v1) do { \
        __builtin_amdgcn_global_load_lds((const unsigned*)((const char*)(gbase) + (v0)), (LAS unsigned*)(lds + (bufoff) + ldsw), 16, 0, 0); \
        __builtin_amdgcn_global_load_lds((const unsigned*)((const char*)(gbase) + (v1)), (LAS unsigned*)(lds + (bufoff) + ldsw + 8192), 16, 0, 0); } while (0)
#define PG8_STAGE(bufoff, gbase, voff) PG8_STAGE2(bufoff, gbase, (voff)[0], (voff)[1])
#define PG8_LDA(dst, b, h) do { _Pragma("unroll") for (int m = 0; m < 4; ++m) _Pragma("unroll") for (int k = 0; k < 2; ++k) dst[m][k] = *(const LAS bf16x8*)(lds + PG8_SA(b, h) + aoff + m * 2048 + k * 1024); } while (0)
#define PG8_LDB(dst, b, h) do { _Pragma("unroll") for (int n = 0; n < 2; ++n) _Pragma("unroll") for (int k = 0; k < 2; ++k) dst[n][k] = *(const LAS bf16x8*)(lds + PG8_SB(b, h) + boff + n * 2048 + k * 1024); } while (0)
#define PG8_MMA(ai, bj, At, Bt) do { __builtin_amdgcn_s_setprio(1); _Pragma("unroll") for (int m = 0; m < 4; ++m) _Pragma("unroll") for (int n = 0; n < 2; ++n) _Pragma("unroll") for (int k = 0; k < 2; ++k) \
        acc[ai][bj][m][n] = __builtin_amdgcn_mfma_f32_16x16x32_bf16(Bt[n][k], At[m][k], acc[ai][bj][m][n], 0, 0, 0); __builtin_amdgcn_s_setprio(0); } while (0)
#define PG8_WAIT_V(n) asm volatile("s_waitcnt vmcnt(" #n ")" ::: "memory")
#define PG8_WAIT_L(n) asm volatile("s_waitcnt lgkmcnt(" #n ")" ::: "memory")
#define PG8_BAR __builtin_amdgcn_s_barrier()
#define PG8_SCHED __builtin_amdgcn_sched_barrier(0)
#define PG8_GATHER(u, dst) do { _Pragma("unroll") for (int _h = 0; _h < 2; ++_h) _Pragma("unroll") for (int _i = 0; _i < 2; ++_i) { \
        const int _tok = g.rowtok[(u).pm * BM + _h * HALF + RA[_i]]; dst[_h][_i] = (unsigned)(_tok * K + CA[_i]) * 2u; } } while (0)
    Unit cur, nxt; int ui = 0;
    if (!S.next(0, cur)) return;
    f32x4 acc[2][2][4][2];
#pragma unroll
    for (int a = 0; a < 2; ++a)
#pragma unroll
        for (int b = 0; b < 2; ++b)
#pragma unroll
            for (int m = 0; m < 4; ++m)
#pragma unroll
                for (int n = 0; n < 2; ++n) acc[a][b][m][n] = (f32x4){0.f, 0.f, 0.f, 0.f};
    bf16x8 At[4][2], B0[2][2], B1[2][2];
    unsigned gC[2][2], gN[2][2];
    if constexpr (GATHER) { PG8_GATHER(cur, gC); } else { gC[0][0] = voffA[0]; gC[0][1] = voffA[1]; gC[1][0] = voffA[0]; gC[1][1] = voffA[1]; }
#pragma unroll
    for (int h = 0; h < 2; ++h) { gN[h][0] = gC[h][0]; gN[h][1] = gC[h][1]; }
    const char* cA = (const char*)g.A + (GATHER ? 0 : (size_t)cur.pm * tstep); const char* cB = (const char*)g.Bt + (size_t)cur.pn * tstep;
    static_assert(SP2, "only the SP2 loop is kept in this file");
    PG8_STAGE(PG8_SB(0, 0), cB, voffB); PG8_STAGE(PG8_SB(0, 1), cB + hstep, voffB); PG8_STAGE2(PG8_SA(0, 0), cA, gC[0][0], gC[0][1]); PG8_STAGE2(PG8_SA(0, 1), cA + hstepA, gC[1][0], gC[1][1]);
    if (wr == 1) PG8_BAR;
    PG8_WAIT_V(2); PG8_BAR;
    PG8_STAGE(PG8_SB(1, 0), cB + kstep, voffB); PG8_STAGE2(PG8_SA(1, 0), cA + kstep, gC[0][0], gC[0][1]); PG8_STAGE(PG8_SB(1, 1), cB + hstep + kstep, voffB);
    PG8_WAIT_V(6); PG8_BAR;
    for (;;) {
        const bool has_next = S.next(ui + 1, nxt);
        const char* nA = (has_next && !GATHER) ? (const char*)g.A + (size_t)nxt.pm * tstep : cA; const char* nB = has_next ? (const char*)g.Bt + (size_t)nxt.pn * tstep : cB;
        if constexpr (GATHER) { if (has_next) { PG8_GATHER(nxt, gN); } else {
#pragma unroll
            for (int h = 0; h < 2; ++h) { gN[h][0] = gC[h][0]; gN[h][1] = gC[h][1]; } } }
        for (int t = 0; t < nt; t += 2) {
            if constexpr (Epi::MID_T >= 0) { if (t == Epi::MID_T) { E.mid(acc, cur, wr, wc, fr, fq); PG8_SCHED; } }
            const bool last = (t == nt - 2);
            const char* a1 = cA + (size_t)(t + 1) * kstep;
            const char* a2 = last ? nA : cA + (size_t)(t + 2) * kstep; const char* b2 = last ? nB : cB + (size_t)(t + 2) * kstep;
            const char* a3 = a2 + kstep; const char* b3 = b2 + kstep;
            unsigned x00 = gC[0][0], x01 = gC[0][1], x10 = gC[1][0], x11 = gC[1][1];
            if constexpr (GATHER) { if (last) { x00 = gN[0][0]; x01 = gN[0][1]; x10 = gN[1][0]; x11 = gN[1][1]; } }
            PG8_LDB(B0, 0, 0); PG8_LDB(B1, 0, 1); PG8_SCHED; PG8_LDA(At, 0, 0); PG8_STAGE2(PG8_SA(1, 1), a1 + hstepA, gC[1][0], gC[1][1]);
            PG8_WAIT_V(8); PG8_WAIT_L(0); PG8_BAR; PG8_MMA(0, 0, At, B0); PG8_MMA(0, 1, At, B1); PG8_BAR; PG8_SCHED;
            PG8_LDA(At, 0, 1); PG8_STAGE(PG8_SB(0, 0), b2, voffB); PG8_STAGE(PG8_SB(0, 1), b2 + hstep, voffB); PG8_STAGE2(PG8_SA(0, 0), a2, x00, x01);
            PG8_WAIT_V(8); PG8_WAIT_L(0); PG8_BAR; PG8_MMA(1, 0, At, B0); PG8_MMA(1, 1, At, B1); PG8_BAR; PG8_SCHED;
            PG8_LDB(B0, 1, 0); PG8_LDB(B1, 1, 1); PG8_SCHED; PG8_LDA(At, 1, 0); PG8_STAGE2(PG8_SA(0, 1), a2 + hstepA, x10, x11);
            PG8_WAIT_V(8); PG8_WAIT_L(0); PG8_BAR; PG8_MMA(0, 0, At, B0); PG8_MMA(0, 1, At, B1); PG8_BAR; PG8_SCHED;
            PG8_LDA(At, 1, 1); PG8_STAGE(PG8_SB(1, 0), b3, voffB); PG8_STAGE(PG8_SB(1, 1), b3 + hstep, voffB); PG8_STAGE2(PG8_SA(1, 0), a3, x00, x01);
            PG8_WAIT_V(8); PG8_WAIT_L(0); PG8_BAR; PG8_MMA(1, 0, At, B0); PG8_MMA(1, 1, At, B1); PG8_BAR; PG8_SCHED;
        }
        if constexpr (ALIGN_EPI) { if (wr == 0) PG8_BAR; }
        E(acc, cur, wr, wc, fr, fq);
        if (!has_next) break;
#pragma unroll
        for (int a = 0; a < 2; ++a)
#pragma unroll
            for (int b = 0; b < 2; ++b)
#pragma unroll
                for (int m = 0; m < 4; ++m)
#pragma unroll
                    for (int n = 0; n < 2; ++n) acc[a][b][m][n] = (f32x4){0.f, 0.f, 0.f, 0.f};
        cur = nxt; cA = nA; cB = nB; ++ui;
#pragma unroll
        for (int h = 0; h < 2; ++h) { gC[h][0] = gN[h][0]; gC[h][1] = gN[h][1]; }
        if constexpr (ALIGN_EPI) { if (wr == 1) PG8_BAR; }
    }
    PG8_WAIT_V(0);
    if constexpr (!ALIGN_EPI) { if (wr == 0) PG8_BAR; }
    PG8_BAR;
#undef PG8_SA
#undef PG8_SB
#undef PG8_STAGE
#undef PG8_STAGE2
#undef PG8_LDA
#undef PG8_LDB
#undef PG8_MMA
#undef PG8_WAIT_V
#undef PG8_WAIT_L
#undef PG8_BAR
#undef PG8_SCHED
#undef PG8_GATHER
}
}

DI int opaque_tid() { int t = threadIdx.x; asm volatile("" : "+v"(t)); return t; }
#define XB_TMO      128
#define XB_XCNT(j)  (256  + 64 * (j))
#define XB_XSUB(j)  (1280 + 64 * (j))
#define XB_XGEN(j)  (2304 + 64 * (j))
#define XB_TOP      3328
#define XB_TOPGEN   3392
#define XCD_BAR_WORDS 3456
#define XB_SPIN_CAP (1u << 18)
__device__ __forceinline__ unsigned xb_ld(unsigned* p)              { return __hip_atomic_load(p, __ATOMIC_RELAXED, __HIP_MEMORY_SCOPE_AGENT); }
__device__ __forceinline__ unsigned xb_add(unsigned* p, unsigned v) { return __hip_atomic_fetch_add(p, v, __ATOMIC_RELAXED, __HIP_MEMORY_SCOPE_AGENT); }
__device__ __forceinline__ unsigned xb_xcc_id() { return (unsigned)__builtin_amdgcn_s_getreg((3 << 11) | 20) & 0xFu; }
#define XB_SPIN(cond, bar) do { unsigned _sp = 0; while (cond) { __builtin_amdgcn_s_sleep(1); \
    if ((++_sp & 255u) == 0u) { if (xb_ld(&(bar)[XB_TMO])) break; if (_sp > XB_SPIN_CAP) { atomicAdd(&(bar)[XB_TMO], 1u); break; } } } } while (0)
struct XcdBarrier { unsigned* bar; unsigned x; volatile LAS unsigned* st; };
__device__ __forceinline__ XcdBarrier xcd_barrier_post(unsigned* bar, volatile LAS unsigned* st) {
    XcdBarrier b; b.bar = bar; b.x = xb_xcc_id(); b.st = st;
    if (threadIdx.x == 0) (void)xb_add(&bar[XB_XCNT(b.x)], 1u);
    return b;
}
__device__ __forceinline__ void xcd_barrier_complete(unsigned* bar, unsigned x, unsigned& nloc, unsigned& nx) {
    const unsigned G = gridDim.x * gridDim.y * gridDim.z;
    unsigned sum, cnt, mine, sp = 0u;
    for (;;) {
        sum = 0u; cnt = 0u; mine = 0u;
#pragma unroll
        for (unsigned j = 0; j < 16; ++j) { const unsigned c = xb_ld(&bar[XB_XCNT(j)]); sum += c; cnt += (c > 0u) ? 1u : 0u; mine = (j == x) ? c : mine; }
        if (sum == G) break;
        __builtin_amdgcn_s_sleep(1);
        if ((++sp & 255u) == 0u) { if (xb_ld(&bar[XB_TMO])) break; if (sp > XB_SPIN_CAP) { atomicAdd(&bar[XB_TMO], 1u); break; } }
    }
    nloc = mine > 0u ? mine : 1u; nx = cnt > 0u ? cnt : 1u;
}
__device__ __forceinline__ void xcd_barrier(const XcdBarrier& b) {
    asm volatile("s_waitcnt vmcnt(0)" ::: "memory");
    __syncthreads();
    if (opaque_tid() == 0) {
        unsigned* bar = b.bar;
        __builtin_amdgcn_s_waitcnt(0);
        unsigned nloc = b.st[0], nx = b.st[1];
        if (nloc == 0u) { xcd_barrier_complete(bar, b.x, nloc, nx); b.st[0] = nloc; b.st[1] = nx; }
        const unsigned old = xb_add(&bar[XB_XSUB(b.x)], 1u);
        const unsigned gen = old / nloc;
        if (old + 1u == (gen + 1u) * nloc) {
            __builtin_amdgcn_fence(__ATOMIC_RELEASE, "agent");
            asm volatile("s_waitcnt vmcnt(0)" ::: "memory");
            const unsigned og = xb_add(&bar[XB_TOP], 1u);
            const unsigned tg = og / nx;
            if (og + 1u == (tg + 1u) * nx) xb_add(&bar[XB_TOPGEN], 1u);
            else XB_SPIN(xb_ld(&bar[XB_TOPGEN]) == tg, bar);
            __builtin_amdgcn_fence(__ATOMIC_ACQUIRE, "agent");
            xb_add(&bar[XB_XGEN(b.x)], 1u);
            asm volatile("s_waitcnt vmcnt(0)" ::: "memory");
        } else {
            XB_SPIN(xb_ld(&bar[XB_XGEN(b.x)]) == gen, bar);
            __builtin_amdgcn_fence(__ATOMIC_ACQUIRE, "agent");
            asm volatile("s_waitcnt vmcnt(0)" ::: "memory");
        }
    }
    __syncthreads();
}

struct Frame {
    LAS unsigned char* lds;
    int wave, vcu, G;
};
struct Args { const float* in[18]; float* out; unsigned char* ws; int ph_lo, ph_hi, li, pad; };
typedef const __attribute__((address_space(4))) Args* ArgsP;
DI ArgsP ka_ptr() { ArgsP p = (ArgsP)__builtin_amdgcn_kernarg_segment_ptr(); asm volatile("" : "+s"(p)); return p; }
DI float wave_sum(float v) {
#pragma unroll
    for (int o = 1; o < 64; o <<= 1) v += __shfl_xor(v, o);
    return v;
}
DI float wave_max(float v) {
#pragma unroll
    for (int o = 1; o < 64; o <<= 1) v = fmaxf(v, __shfl_xor(v, o));
    return v;
}

template <int MAP>
DI void cvt_item(const float* W, int N, int ldk, bf16_t* WT, const float* gain, LAS unsigned* scr, int kb, int nb, int lane) {
    const int nq = lane & 15, kr = lane >> 4, k0 = kb * 64, n0 = nb * 64;
    f32x4 v[8][2];
#pragma unroll
    for (int j = 0; j < 8; ++j)
#pragma unroll
        for (int e = 0; e < 2; ++e) v[j][e] = __builtin_nontemporal_load((const f32x4*)(W + (size_t)(k0 + 8 * j + 2 * kr + e) * N + n0 + 4 * nq));
    if (gain) {
#pragma unroll
        for (int j = 0; j < 8; ++j) { const float g0 = gain[k0 + 8 * j + 2 * kr], g1 = gain[k0 + 8 * j + 2 * kr + 1]; v[j][0] = v[j][0] * g0; v[j][1] = v[j][1] * g1; }
    }
#pragma unroll
    for (int j = 0; j < 8; ++j)
#pragma unroll
        for (int i = 0; i < 4; ++i) scr[(4 * nq + i) * 32 + ((j ^ (nq & 7)) << 2) + kr] = pk2(v[j][0][i], v[j][1][i]);
    LDS_WAIT(); asm volatile("" ::: "memory");
#pragma unroll
    for (int jj = 0; jj < 8; ++jj) {
        const int nl = (lane >> 3) + 8 * jj, c = lane & 7;
        const u32x4 o = *(const LAS u32x4*)(scr + nl * 32 + ((c ^ ((nl >> 2) & 7)) << 2));
        const int n = n0 + nl;
        const int row = (MAP == 0) ? n : ((n >> 2) * 8 + (MAP == 2 ? 4 : 0) + (n & 3));
        *(u32x4*)(WT + (size_t)row * ldk + k0 + 8 * c) = o;
    }
    LDS_WAIT(); asm volatile("" ::: "memory");
}

DI void p0_prologue(Frame& F, ArgsP A) {
    const int ftid = opaque_tid(), flane = ftid & 63;
    LAS unsigned* scr = (LAS unsigned*)(F.lds + F.wave * 8192);
    const int gw = F.vcu * NWAVES + F.wave, NGW = F.G * NWAVES;
    constexpr int I_IN = 32 * 264;
    for (int it = gw; it < I_IN; it += NGW) cvt_item<0>(A->in[2], INW, D, (bf16_t*)(A->ws + WS_WIN), nullptr, scr, it / 264, it % 264, flane);
    { bf16_t* WH = (bf16_t*)(A->ws + WS_WRT); bf16_t* WL = WH + 96 * D; const float* g2 = A->in[9]; const float* wrg = A->in[10]; const float* wre = A->in[12];
      for (int idx = F.vcu * NTHREADS + ftid; idx < 96 * D; idx += F.G * NTHREADS) {
          const int j = idx >> 11, k = idx & 2047;
          float w = 0.f; if (j < 8) w = wrg[k * 8 + j]; else if (j < 72) w = wre[k * 64 + (j - 8)];
          w *= g2[k];
          const unsigned hi = cvtpk_s(w, 0.f) & 0xffffu; const float rem = w - __builtin_bit_cast(float, hi << 16);
          WH[idx] = (bf16_t)hi; WL[idx] = (bf16_t)(cvtpk_s(rem, 0.f) & 0xffffu); } }
    const float* x = A->in[0]; const float* g1 = A->in[1]; bf16_t* H = (bf16_t*)(A->ws + WS_H);
    for (int row = gw; row < T; row += 2 * NGW) {
        const int row2 = row + NGW; const bool has2 = row2 < T;
        const f32x4* xr = (const f32x4*)(x + (size_t)row * D) + flane; const f32x4* xr2 = (const f32x4*)(x + (size_t)(has2 ? row2 : row) * D) + flane;
        f32x4 v[8], v2[8]; float ss = 0.f, ss2 = 0.f;
#pragma unroll
        for (int j = 0; j < 8; ++j) { v[j] = __builtin_nontemporal_load(xr + 64 * j); v2[j] = __builtin_nontemporal_load(xr2 + 64 * j); }
#pragma unroll
        for (int j = 0; j < 8; ++j) { ss += (v[j][0] * v[j][0] + v[j][1] * v[j][1]) + (v[j][2] * v[j][2] + v[j][3] * v[j][3]); ss2 += (v2[j][0] * v2[j][0] + v2[j][1] * v2[j][1]) + (v2[j][2] * v2[j][2] + v2[j][3] * v2[j][3]); }
        const float r = rsqrtf(wave_sum(ss) * (1.0f / D) + EPS), r2 = rsqrtf(wave_sum(ss2) * (1.0f / D) + EPS);
        u32x2* o = (u32x2*)(H + (size_t)row * D) + flane; u32x2* o2 = (u32x2*)(H + (size_t)row2 * D) + flane;
#pragma unroll
        for (int j = 0; j < 8; ++j) { const f32x4 g = ((const f32x4*)g1)[flane + 64 * j];
            u32x2 w; w.x = pk2(v[j][0] * r * g[0], v[j][1] * r * g[1]); w.y = pk2(v[j][2] * r * g[2], v[j][3] * r * g[3]); o[64 * j] = w;
            if (has2) { u32x2 w2; w2.x = pk2(v2[j][0] * r2 * g[0], v2[j][1] * r2 * g[1]); w2.y = pk2(v2[j][2] * r2 * g[2], v2[j][3] * r2 * g[3]); o2[64 * j] = w2; } }
    }
}

DI bf16_t* wgu_ptr(unsigned char* ws, int e) { return (bf16_t*)(ws + (e < GU_EARLY ? WS_WGU_E : WS_WGU)) + (size_t)e * 1024 * D; }
DI void p1_tail_convert(Frame& F, ArgsP A, int rank, int nranks) {
    const int ftid = opaque_tid(), flane = ftid & 63;
    LAS unsigned* scr = (LAS unsigned*)(F.lds + F.wave * 8192);
    const int gw = rank * NWAVES + F.wave, NGW = nranks * NWAVES;
    constexpr int I_A = 32 * 32, I_B = 8 * 32, I_O = 32 * 32, I_D = WD_EARLY * 256, I_GU = GU_EARLY * 512;
    for (int it = gw; it < I_A + I_B + I_O + I_D + I_GU; it += NGW) {
        int r = it;
        if (r < I_A) { cvt_item<0>(A->in[6], D, KCAT, (bf16_t*)(A->ws + WS_WCAT) + 512, nullptr, scr, r / 32, r % 32, flane); continue; } r -= I_A;
        if (r < I_B) { cvt_item<0>(A->in[7], D, KCAT, (bf16_t*)(A->ws + WS_WCAT), nullptr, scr, r / 32, r % 32, flane); continue; } r -= I_B;
        if (r < I_O) { cvt_item<0>(A->in[8], D, D, (bf16_t*)(A->ws + WS_WOUT), nullptr, scr, r / 32, r % 32, flane); continue; } r -= I_O;
        if (r < I_D) { const int e = r >> 8, rem = r & 255;
          cvt_item<0>(A->in[16] + (size_t)e * FF * D, D, FF, (bf16_t*)(A->ws + WS_WD) + (size_t)e * D * FF, nullptr, scr, rem >> 5, rem & 31, flane); continue; } r -= I_D;
        { const int e = r >> 9, up = (r >> 8) & 1, rem = r & 255;
          const float* W = (up ? A->in[15] : A->in[14]) + (size_t)e * D * FF;
          if (up) cvt_item<2>(W, FF, D, wgu_ptr(A->ws, e), A->in[9], scr, rem >> 3, rem & 7, flane); else cvt_item<1>(W, FF, D, wgu_ptr(A->ws, e), A->in[9], scr, rem >> 3, rem & 7, flane); }
    }
}
template <int NOSTORE> struct EpiProjT {
    static constexpr bool PERM = true; static constexpr int MID_T = -1;
    unsigned char* ws; const float* lbl;
    DI void operator()(const f32x4 (&acc)[2][2][4][2], const pg8::Unit& u, int wr, int wc, int fr, int fq) const {
        const int pn = u.pn, row0 = u.pm * 256 + wr * 64 + fr, cw = wc * 32 + 8 * fq;
        if (pn < 32 || pn >= 50) {
            size_t off; int tile, mode;
            if (pn < 8) { off = WS_QA; tile = pn; mode = 0; } else if (pn < 16) { off = WS_LF; tile = pn - 8; mode = 1; } else if (pn < 24) { off = WS_IA; tile = pn - 16; mode = 0; }
            else if (pn < 32) { off = WS_SG; tile = pn - 24; mode = 2; } else if (pn < 58) { off = WS_GA; tile = pn - 50; mode = 2; } else { off = WS_GB; tile = pn - 58; mode = 2; }
            bf16_t* base = (bf16_t*)(ws + off);
#pragma unroll
            for (int bj = 0; bj < 2; ++bj) {
                const int col = tile * 256 + bj * 128 + cw;
                float lb[8];
                if (mode == 1) {
#pragma unroll
                    for (int e = 0; e < 8; ++e) lb[e] = 1.0f / (1.0f + __expf(lbl[2048 + col + e] - lbl[col + e]));
                }
#pragma unroll
                for (int ai = 0; ai < 2; ++ai)
#pragma unroll
                    for (int m = 0; m < 4; ++m) {
                        const int row = row0 + ai * 128 + m * 16;
                        float v[8];
#pragma unroll
                        for (int e = 0; e < 4; ++e) { v[e] = acc[ai][bj][m][0][e]; v[4 + e] = acc[ai][bj][m][1][e]; }
                        if (mode == 1) {
#pragma unroll
                            for (int e = 0; e < 8; ++e) v[e] = __logf(lb[e] + (1.0f - lb[e]) * sigmoidf_(v[e]));
                        } else if (mode == 2) {
#pragma unroll
                            for (int e = 0; e < 8; ++e) v[e] = sigmoidf_(v[e]);
                        }
                        u32x4 w; w.x = pg8::cvt_pk_bf16(v[0], v[1]); w.y = pg8::cvt_pk_bf16(v[2], v[3]); w.z = pg8::cvt_pk_bf16(v[4], v[5]); w.w = pg8::cvt_pk_bf16(v[6], v[7]);
                        if (NOSTORE) asm volatile("" :: "v"(w)); else st16_stream(base + (size_t)row * D + col, w);
                    }
            }
        } else {
            const int a = pn - 32, kind = a / 6, ht = a - kind * 6;
#pragma unroll
            for (int bj = 0; bj < 2; ++bj) {
                const int head = ht * 2 + bj, sh = 2 * (head >> 2);
#pragma unroll
                for (int ai = 0; ai < 2; ++ai)
#pragma unroll
                    for (int m = 0; m < 4; ++m) {
                        const int row = row0 + ai * 128 + m * 16, b = row >> 11, s = row & 2047;
                        const int pos = ((s & ((1 << sh) - 1)) << (11 - sh)) + (s >> sh);
                        float v[8];
#pragma unroll
                        for (int e = 0; e < 4; ++e) { v[e] = acc[ai][bj][m][0][e]; v[4 + e] = acc[ai][bj][m][1][e]; }
                        if (kind < 2) {
                            const float sc = (kind == 0) ? 0.08838834764831845f : 1.0f;
                            u32x4 w; w.x = pg8::cvt_pk_bf16(v[0] * sc, v[1] * sc); w.y = pg8::cvt_pk_bf16(v[2] * sc, v[3] * sc); w.z = pg8::cvt_pk_bf16(v[4] * sc, v[5] * sc); w.w = pg8::cvt_pk_bf16(v[6] * sc, v[7] * sc);
                            bf16_t* base = (bf16_t*)(ws + (kind == 0 ? WS_QB : WS_KB));
                            if (NOSTORE) asm volatile("" :: "v"(w)); else st16_stream(base + ((size_t)(b * 12 + head) * 2048 + pos) * 128 + cw, w);
                        } else if (sh != 4) {
                            bf16_t* base = (bf16_t*)(ws + WS_VT) + ((size_t)(b * 12 + head) * 128 + cw) * 2048 + pos;
#pragma unroll
                            for (int e = 0; e < 8; ++e) { if (NOSTORE) asm volatile("" :: "v"(v[e])); else base[(size_t)e * 2048] = (bf16_t)f2bf(v[e]); }
                        } else if (m == 0) {
                            bf16_t* base = (bf16_t*)(ws + WS_VT) + ((size_t)(b * 12 + head) * 128 + cw) * 2048 + pos;
#pragma unroll
                            for (int e = 0; e < 8; ++e) {
                                u32x2 w; w.x = pg8::cvt_pk_bf16(acc[ai][bj][0][e >> 2][e & 3], acc[ai][bj][1][e >> 2][e & 3]); w.y = pg8::cvt_pk_bf16(acc[ai][bj][2][e >> 2][e & 3], acc[ai][bj][3][e >> 2][e & 3]);
                                if (NOSTORE) asm volatile("" :: "v"(w)); else *(u32x2*)(base + (size_t)e * 2048) = w;
                            }
                        }
                    }
            }
        }
    }
};

struct EpiPlainScratch {
    static constexpr bool PERM = true; static constexpr int MID_T = -1;
    bf16_t* base;
    DI void operator()(const f32x4 (&acc)[2][2][4][2], const pg8::Unit& u, int wr, int wc, int fr, int fq) const {
        const int row0 = (u.pm & 15) * 256 + wr * 64 + fr, col0 = (u.pn & 7) * 256 + wc * 32 + 8 * fq;
#pragma unroll
        for (int ai = 0; ai < 2; ++ai)
#pragma unroll
            for (int m = 0; m < 4; ++m)
#pragma unroll
                for (int bj = 0; bj < 2; ++bj) {
                    const f32x4 a0 = acc[ai][bj][m][0], a1 = acc[ai][bj][m][1];
                    u32x4 w; w.x = pg8::cvt_pk_bf16(a0[0], a0[1]); w.y = pg8::cvt_pk_bf16(a0[2], a0[3]); w.z = pg8::cvt_pk_bf16(a1[0], a1[1]); w.w = pg8::cvt_pk_bf16(a1[2], a1[3]);
                    *(u32x4*)(base + (size_t)(row0 + ai * 128 + m * 16) * D + col0 + bj * 128) = w;
                }
    }
};
struct EpiNull {
    static constexpr bool PERM = true; static constexpr int MID_T = -1;
    DI void operator()(const f32x4 (&acc)[2][2][4][2], const pg8::Unit& u, int wr, int wc, int fr, int fq) const {
#pragma unroll
        for (int ai = 0; ai < 2; ++ai)
#pragma unroll
            for (int bj = 0; bj < 2; ++bj)
#pragma unroll
                for (int m = 0; m < 4; ++m)
#pragma unroll
                    for (int n = 0; n < 2; ++n) asm volatile("" :: "v"(acc[ai][bj][m][n]));
    }
};
typedef EpiProjT<0> EpiProj;
DI void p2_hgrn_simple(Frame& F, ArgsP A) {
    const int ftid = opaque_tid(), flane = ftid & 63;
    LAS float* qs = (LAS float*)F.lds; LAS float* fs = qs + 16 * 128; LAS float* is = fs + 16 * 128; LAS float* red = is + 16 * 128;
    const bf16_t* QA = (const bf16_t*)(A->ws + WS_QA); const bf16_t* LF = (const bf16_t*)(A->ws + WS_LF); const bf16_t* IA = (const bf16_t*)(A->ws + WS_IA); bf16_t* OH = (bf16_t*)(A->ws + WS_OH);
    const int tid = ftid, v = tid & 127, kq = __builtin_amdgcn_readfirstlane(tid >> 7), lt = tid >> 5, c4 = tid & 31;
    for (int item = F.vcu; item < 128; item += F.G) {
        const int b = item >> 4, h = item & 15;
        float S[32];
#pragma unroll
        for (int k = 0; k < 32; ++k) S[k] = 0.f;
        for (int t0 = 0; t0 < SEQ; t0 += 16) {
            {
                const size_t g = ((size_t)(b * SEQ + t0 + lt)) * D + h * 128 + 4 * c4;
                const u32x2 q2 = *(const u32x2*)(QA + g), f2 = *(const u32x2*)(LF + g), i2 = *(const u32x2*)(IA + g);
                *(LAS f32x4*)(qs + lt * 128 + 4 * c4) = (f32x4){bflo(q2.x), bfhi(q2.x), bflo(q2.y), bfhi(q2.y)};
                *(LAS f32x4*)(fs + lt * 128 + 4 * c4) = (f32x4){__expf(bflo(f2.x)), __expf(bfhi(f2.x)), __expf(bflo(f2.y)), __expf(bfhi(f2.y))};
                *(LAS f32x4*)(is + lt * 128 + 4 * c4) = (f32x4){bflo(i2.x), bfhi(i2.x), bflo(i2.y), bfhi(i2.y)};
            }
            __syncthreads();
#pragma unroll 2
            for (int t = 0; t < 16; ++t) {
                const float iv = is[t * 128 + v]; float o = 0.f;
#pragma unroll
                for (int k4 = 0; k4 < 8; ++k4) {
                    const f32x4 f = *(const LAS f32x4*)(fs + t * 128 + kq * 32 + 4 * k4), q = *(const LAS f32x4*)(qs + t * 128 + kq * 32 + 4 * k4);
#pragma unroll
                    for (int e = 0; e < 4; ++e) { float s = S[4 * k4 + e]; s = iv + f[e] * (s - iv); S[4 * k4 + e] = s; o += s * q[e]; }
                }
                red[(kq * 16 + t) * 128 + v] = o;
            }
            __syncthreads();
            {
                f32x4 s = *(const LAS f32x4*)(red + (0 * 16 + lt) * 128 + 4 * c4);
#pragma unroll
                for (int q = 1; q < 4; ++q) s = s + *(const LAS f32x4*)(red + (q * 16 + lt) * 128 + 4 * c4);
                u32x2 w; w.x = pk2(s[0], s[1]); w.y = pk2(s[2], s[3]);
                *(u32x2*)(OH + ((size_t)(b * SEQ + t0 + lt)) * D + h * 128 + 4 * c4) = w;
            }
        }
        __syncthreads();
    }
}

DI int t5_bucket(int dist) {
    if (dist < 16) return dist;
    int b = 16;
    b += (dist >= 22); b += (dist >= 30); b += (dist >= 40); b += (dist >= 54); b += (dist >= 73); b += (dist >= 99); b += (dist >= 134); b += (dist >= 182);
    b += (dist >= 246); b += (dist >= 332); b += (dist >= 450); b += (dist >= 609); b += (dist >= 825); b += (dist >= 1117); b += (dist >= 1513);
    return b;
}
DI void p3_attn_simple(Frame& F, ArgsP A) {
    const int ftid = opaque_tid(), flane = ftid & 63;
    const bf16_t* QB = (const bf16_t*)(A->ws + WS_QB); const bf16_t* KB = (const bf16_t*)(A->ws + WS_KB); const bf16_t* VT = (const bf16_t*)(A->ws + WS_VT);
    bf16_t* OG = (bf16_t*)(A->ws + WS_OG); float* LSE = (float*)(A->ws + WS_LSE); const float* relb = A->in[5];
    LAS float* pb = (LAS float*)F.lds + F.wave * 320; LAS float* qf = pb + 192;
    const int gw = F.vcu * NWAVES + F.wave, NGW = F.G * NWAVES, lane = flane;
    for (int idx = gw; idx < NB * 12 * SEQ; idx += NGW) {
        const int pos = idx & 2047, bh = idx >> 11, head = bh % 12, b = bh / 12, g = head >> 2, sh = 2 * g;
        const int r = pos >> (11 - sh), l = pos & ((2048 >> sh) - 1), s = (l << sh) + r;
        { const unsigned qw = *(const unsigned*)(QB + (size_t)idx * 128 + 2 * lane); qf[2 * lane] = bflo(qw); qf[2 * lane + 1] = bfhi(qw); }
        LDS_WAIT(); asm volatile("" ::: "memory");
        float mx = -3.0e38f;
#pragma unroll 1
        for (int rr = 0; rr < 3; ++rr) {
            const int j = rr * 64 + lane; const bool valid = (j <= 128) && (j <= l);
            const bf16_t* kp = KB + (size_t)(valid ? idx - j : idx) * 128;
            float d = 0.f;
#pragma unroll
            for (int i = 0; i < 16; ++i) { const u32x4 k = *(const u32x4*)(kp + 8 * i); const f32x4 qa = *(const LAS f32x4*)(qf + 8 * i), qb = *(const LAS f32x4*)(qf + 8 * i + 4);
                d += qa[0] * bflo(k.x) + qa[1] * bfhi(k.x) + qa[2] * bflo(k.y) + qa[3] * bfhi(k.y)
                   + qb[0] * bflo(k.z) + qb[1] * bfhi(k.z) + qb[2] * bflo(k.w) + qb[3] * bfhi(k.w); }
            const float bias = relb[t5_bucket((valid ? j : 0) << sh) * 12 + head];
            const float lgv = valid ? d + bias : -3.0e38f;
            pb[rr * 64 + lane] = lgv;
            mx = fmaxf(mx, lgv);
        }
        mx = wave_max(mx);
        float den = 0.f;
#pragma unroll 1
        for (int rr = 0; rr < 3; ++rr) { const float lgv = pb[rr * 64 + lane]; const float p = (lgv > -1.0e38f) ? __expf(lgv - mx) : 0.f; den += p; pb[rr * 64 + lane] = p; }
        den = wave_sum(den);
        LDS_WAIT(); asm volatile("" ::: "memory");
        const int nk = (l < 128 ? l : 128) + 1;
        const bf16_t* v0 = VT + ((size_t)(b * 12 + head) * 128 + lane) * 2048 + pos;
        const bf16_t* v1 = v0 + (size_t)64 * 2048;
        float o0 = 0.f, o1 = 0.f;
        for (int j = 0; j < nk; ++j) { const float p = pb[j]; o0 += p * bf1(*(v0 - j)); o1 += p * bf1(*(v1 - j)); }
        const float inv = 1.0f / den;
        const size_t orow = (size_t)g * T + (size_t)b * SEQ + s;
        OG[orow * 512 + (head & 3) * 128 + lane] = (bf16_t)f2bf(o0 * inv);
        OG[orow * 512 + (head & 3) * 128 + 64 + lane] = (bf16_t)f2bf(o1 * inv);
        if (lane == 0) LSE[orow * 4 + (head & 3)] = mx + __logf(den);
        LDS_WAIT(); asm volatile("" ::: "memory");
    }
}

typedef float f32x16 __attribute__((ext_vector_type(16)));
DI int crow(int reg, int h) { return (reg & 3) + 8 * (reg >> 2) + 4 * h; }
DI bf16x8 pack_step(const f32x16& x, int s) {
    u32x4 p; p.x = cvtpk_s(x[8 * s], x[8 * s + 1]); p.y = cvtpk_s(x[8 * s + 2], x[8 * s + 3]); p.z = cvtpk_s(x[8 * s + 4], x[8 * s + 5]); p.w = cvtpk_s(x[8 * s + 6], x[8 * s + 7]);
    return __builtin_bit_cast(bf16x8, p);
}
#define MFMA32(a, b, c) __builtin_amdgcn_mfma_f32_32x32x16_bf16((a), (b), (c), 0, 0, 0)
DI void p3_attn_mfma(Frame& F, ArgsP A) {
    const int ftid = opaque_tid(), flane = ftid & 63;
    const bf16_t* QB = (const bf16_t*)(A->ws + WS_QB); const bf16_t* KB = (const bf16_t*)(A->ws + WS_KB); const bf16_t* VT = (const bf16_t*)(A->ws + WS_VT);
    bf16_t* OG = (bf16_t*)(A->ws + WS_OG); float* LSE = (float*)(A->ws + WS_LSE); const float* relb = A->in[5];
    LAS float* tb = (LAS float*)F.lds + F.wave * 256;
    const int gw = F.vcu * NWAVES + F.wave, NGW = F.G * NWAVES, lane = flane, r32 = lane & 31, h = lane >> 5;
    for (int u = gw; u < NB * 12 * 64; u += NGW) {
        const int bh = u >> 6, qt = u & 63, head = bh % 12, b = bh / 12, g = head >> 2, sh = 2 * g;
        const int pos0 = qt * 32, r = pos0 >> (11 - sh), l0 = pos0 & ((2048 >> sh) - 1), cbase = pos0 - l0;
#pragma unroll
        for (int k = 0; k < 3; ++k) { const int j = lane + 64 * k; tb[32 + j] = (j <= 128) ? relb[t5_bucket(j << sh) * 12 + head] : 0.f; }
        if (lane < 32) tb[lane] = 0.f;
        LDS_WAIT(); asm volatile("" ::: "memory");
        bf16x8 qf[8];
        { const bf16_t* qp = QB + ((size_t)bh * 2048 + pos0 + r32) * 128 + 8 * h; asm volatile("" : "+v"(qp));
#pragma unroll
          for (int st = 0; st < 8; ++st) qf[st] = *(const bf16x8*)(qp + 16 * st); }
        const bf16_t* kbase = KB + ((size_t)bh * 2048 + cbase + (l0 - 128) + r32) * 128 + 8 * h; asm volatile("" : "+v"(kbase));
        f32x16 S[5];
        float mx = -3.0e38f;
        int rq = r32; asm volatile("" : "+v"(rq));
#pragma unroll
        for (int t = 0; t < 5; ++t) {
            const int k0 = l0 - 128 + 32 * t;
            if (k0 >= 0) {
                const bf16_t* kp = kbase + t * (32 * 128);
                f32x16 acc;
                float bias[16];
#pragma unroll
                for (int i = 0; i < 16; ++i) { acc[i] = 0.f; bias[i] = tb[32 + (128 - 32 * t + rq - crow(i, h))]; }
                LDS_WAIT(); __builtin_amdgcn_sched_barrier(0);
#pragma unroll
                for (int st = 0; st < 8; ++st) { acc = MFMA32(*(const bf16x8*)(kp + 16 * st), qf[st], acc); if (st == 3) __builtin_amdgcn_sched_barrier(0); }
                __builtin_amdgcn_sched_barrier(0);
#pragma unroll
                for (int i = 0; i < 16; ++i) {
                    const int key = crow(i, h);
                    const float v = acc[i] + bias[i];
                    const bool valid = (t == 0) ? (key >= rq) : ((t == 4) ? (key <= rq) : true);
                    S[t][i] = valid ? v : -3.0e38f; mx = fmaxf(mx, S[t][i]);
                }
            }
            __builtin_amdgcn_sched_barrier(0);
        }
        mx = fmaxf(mx, __shfl_xor(mx, 32));
        float den = 0.f;
#pragma unroll
        for (int t = 0; t < 5; ++t) {
            const int k0 = l0 - 128 + 32 * t;
            if (k0 >= 0) {
#pragma unroll
                for (int i = 0; i < 16; ++i) { const float p = (S[t][i] > -1.0e38f) ? __expf(S[t][i] - mx) : 0.f; S[t][i] = p; den += p; }
            }
        }
        den += __shfl_xor(den, 32);
        const float inv = 1.0f / den;
        u32x4 Pp[5][2];
#pragma unroll
        for (int t = 0; t < 5; ++t) {
            const int k0 = l0 - 128 + 32 * t;
            if (k0 >= 0) {
#pragma unroll
                for (int s2 = 0; s2 < 2; ++s2) {
                    Pp[t][s2].x = cvtpk_s(S[t][8 * s2] * inv, S[t][8 * s2 + 1] * inv); Pp[t][s2].y = cvtpk_s(S[t][8 * s2 + 2] * inv, S[t][8 * s2 + 3] * inv);
                    Pp[t][s2].z = cvtpk_s(S[t][8 * s2 + 4] * inv, S[t][8 * s2 + 5] * inv); Pp[t][s2].w = cvtpk_s(S[t][8 * s2 + 6] * inv, S[t][8 * s2 + 7] * inv);
                }
            }
        }
        __builtin_amdgcn_sched_barrier(0);
        f32x16 O[4];
        const bf16_t* vbp[4];
#pragma unroll
        for (int db = 0; db < 4; ++db) { vbp[db] = VT + ((size_t)bh * 128 + db * 32 + r32) * 2048 + (cbase + l0 - 128 + 4 * h); asm volatile("" : "+v"(vbp[db]));
#pragma unroll
            for (int i = 0; i < 16; ++i) O[db][i] = 0.f; }
#pragma unroll
        for (int t = 0; t < 5; ++t) {
            const int k0 = l0 - 128 + 32 * t;
            if (k0 >= 0) {
#pragma unroll
                for (int s2 = 0; s2 < 2; ++s2) {
                    const bf16x8 pa = __builtin_bit_cast(bf16x8, Pp[t][s2]);
#pragma unroll
                    for (int db = 0; db < 4; ++db) {
                        const bf16_t* vp = vbp[db] + (32 * t + 16 * s2);
                        const u32x2 lo = *(const u32x2*)vp, hi = *(const u32x2*)(vp + 8);
                        u32x4 vv; vv.x = lo.x; vv.y = lo.y; vv.z = hi.x; vv.w = hi.y;
                        O[db] = MFMA32(pa, __builtin_bit_cast(bf16x8, vv), O[db]);
                    }
                }
            }
            __builtin_amdgcn_sched_barrier(0);
        }
        const size_t obase = (size_t)g * T + (size_t)b * SEQ;
#pragma unroll
        for (int i = 0; i < 16; ++i) {
            const int l = l0 + crow(i, h); const int tok = (l << sh) + r;
            bf16_t* op = OG + (obase + tok) * 512 + (head & 3) * 128 + r32;
#pragma unroll
            for (int db = 0; db < 4; ++db) op[db * 32] = (bf16_t)f2bf(O[db][i]);
        }
        if (h == 0) { const int tok = ((l0 + r32) << sh) + r; LSE[(obase + tok) * 4 + (head & 3)] = mx + __logf(den); }
        LDS_WAIT(); asm volatile("" ::: "memory");
    }
}

constexpr int H_QI = 0, H_QS = 8704, H_KS = 17408, H_KU = 26112, H_VT = 36352, H_DEC = 41472, H_TOT = 41984, H_RED = 46080;
struct HRaw { unsigned q[4], f[4]; unsigned i[4]; };
DI void h_load(HRaw& R, const bf16_t* qp, const bf16_t* fp, const bf16_t* ip, int c) {
#pragma unroll
    for (int j = 0; j < 4; ++j) { const size_t ro = (size_t)(32 * c + j) * D; R.q[j] = *(const unsigned*)(qp + ro); R.f[j] = *(const unsigned*)(fp + ro); R.i[j] = ip[ro]; }
}
DI void h_totals(const HRaw& R, LAS unsigned char* lds, int tg, int k2) {
    float lo = 0.f, hi = 0.f;
#pragma unroll
    for (int j = 0; j < 4; ++j) { lo += bflo(R.f[j]); hi += bfhi(R.f[j]); }
    *(LAS f32x2_t*)(lds + H_TOT + (tg * 128 + 2 * k2) * 4) = (f32x2_t){lo, hi};
}
DI void h_prep(const HRaw& R, LAS unsigned char* lds, int tg, int k2, int v64) {
    float base0 = 0.f, base1 = 0.f, bm0 = 0.f, bm1 = 0.f, bl0 = 0.f, bl1 = 0.f;
#pragma unroll
    for (int g = 0; g < 8; ++g) { const f32x2_t tt = *(const LAS f32x2_t*)(lds + H_TOT + (g * 128 + 2 * k2) * 4);
        if (g < tg) { base0 += tt[0]; base1 += tt[1]; } if (g < 4) { bm0 += tt[0]; bm1 += tt[1]; } bl0 += tt[0]; bl1 += tt[1]; }
    const float ebm0 = __expf(bm0), ebm1 = __expf(bm1), elm0 = __expf(bl0 - bm0), elm1 = __expf(bl1 - bm1);
    float b0 = base0, b1 = base1; float ku0[4], ku1[4];
#pragma unroll
    for (int j = 0; j < 4; ++j) {
        const float lf0 = bflo(R.f[j]), lf1 = bfhi(R.f[j]), q0 = bflo(R.q[j]), q1 = bfhi(R.q[j]);
        b0 += lf0; b1 += lf1;
        const float e20 = __expf(b0 - bm0), e21 = __expf(b1 - bm1), e30 = __builtin_amdgcn_rcpf(e20), e31 = __builtin_amdgcn_rcpf(e21);
        const float kk0 = 1.0f - __expf(lf0), kk1 = 1.0f - __expf(lf1);
        const int t = 4 * tg + j;
        *(LAS unsigned*)(lds + H_QS + t * 272 + 4 * k2) = pk2(q0 * e20, q1 * e21);
        *(LAS unsigned*)(lds + H_QI + t * 272 + 4 * k2) = pk2(q0 * e20 * ebm0, q1 * e21 * ebm1);
        *(LAS unsigned*)(lds + H_KS + t * 272 + 4 * k2) = pk2(kk0 * e30, kk1 * e31);
        ku0[j] = kk0 * e30 * elm0; ku1[j] = kk1 * e31 * elm1;
    }
    { u32x2 w; w.x = pk2(ku0[0], ku0[1]); w.y = pk2(ku0[2], ku0[3]); *(LAS u32x2*)(lds + H_KU + (2 * k2) * 80 + 8 * tg) = w;
      w.x = pk2(ku1[0], ku1[1]); w.y = pk2(ku1[2], ku1[3]); *(LAS u32x2*)(lds + H_KU + (2 * k2 + 1) * 80 + 8 * tg) = w; }
    if (tg == 0) *(LAS f32x2_t*)(lds + H_DEC + 8 * k2) = (f32x2_t){__expf(bl0), __expf(bl1)};
    { u32x2 w; w.x = (R.i[0] & 0xffffu) | (R.i[1] << 16); w.y = (R.i[2] & 0xffffu) | (R.i[3] << 16); *(LAS u32x2*)(lds + H_VT + v64 * 80 + 8 * tg) = w; }
}
DI void h_mma(f32x16& S, LAS unsigned char* lds, int kb, int vb, int r32, int hh) {
    f32x16 X, O;
    int rq = r32; asm volatile("" : "+v"(rq));
#pragma unroll
    for (int i = 0; i < 16; ++i) { X[i] = 0.f; O[i] = 0.f; }
#pragma unroll
    for (int st = 0; st < 2; ++st) {
        const bf16x8 a = *(const LAS bf16x8*)(lds + H_KS + r32 * 272 + (kb * 32 + 16 * st + 8 * hh) * 2);
        const bf16x8 b = *(const LAS bf16x8*)(lds + H_QS + r32 * 272 + (kb * 32 + 16 * st + 8 * hh) * 2);
        X = MFMA32(a, b, X);
    }
#pragma unroll
    for (int i = 0; i < 16; ++i) X[i] = (crow(i, hh) <= rq) ? X[i] : 0.f;
#pragma unroll
    for (int s2 = 0; s2 < 2; ++s2) {
        const bf16x8 pa = pack_step(X, s2);
        const LAS unsigned char* vp = lds + H_VT + (vb * 32 + r32) * 80 + (16 * s2 + 4 * hh) * 2;
        const u32x2 v0 = *(const LAS u32x2*)vp, v1 = *(const LAS u32x2*)(vp + 16);
        u32x4 vv; vv.x = v0.x; vv.y = v0.y; vv.z = v1.x; vv.w = v1.y;
        O = MFMA32(pa, __builtin_bit_cast(bf16x8, vv), O);
        const LAS unsigned char* qp = lds + H_QI + r32 * 272 + (kb * 32 + 16 * s2 + 4 * hh) * 2;
        const u32x2 q0 = *(const LAS u32x2*)qp, q1 = *(const LAS u32x2*)(qp + 16);
        u32x4 qq; qq.x = q0.x; qq.y = q0.y; qq.z = q1.x; qq.w = q1.y;
        O = MFMA32(__builtin_bit_cast(bf16x8, qq), pack_step(S, s2), O);
    }
#pragma unroll
    for (int i = 0; i < 16; ++i) *(LAS float*)(lds + H_RED + ((kb * 32 + crow(i, hh)) * 64 + vb * 32 + r32) * 4) = O[i];
#pragma unroll
    for (int g = 0; g < 4; ++g) { const f32x4 d = *(const LAS f32x4*)(lds + H_DEC + (kb * 32 + 8 * g + 4 * hh) * 4);
#pragma unroll
        for (int e = 0; e < 4; ++e) S[4 * g + e] *= d[e]; }
#pragma unroll
    for (int st = 0; st < 2; ++st) {
        const bf16x8 a = *(const LAS bf16x8*)(lds + H_KU + (kb * 32 + r32) * 80 + (16 * st + 8 * hh) * 2);
        const bf16x8 b = *(const LAS bf16x8*)(lds + H_VT + (vb * 32 + r32) * 80 + (16 * st + 8 * hh) * 2);
        S = MFMA32(a, b, S);
    }
}
DI void h_reduce_store(LAS unsigned char* lds, bf16_t* op, int c, int tid) {
    const int t = tid >> 4, c4 = tid & 15;
    f32x4 s = *(const LAS f32x4*)(lds + H_RED + ((0 * 32 + t) * 64 + 4 * c4) * 4);
#pragma unroll
    for (int q = 1; q < 4; ++q) s = s + *(const LAS f32x4*)(lds + H_RED + ((q * 32 + t) * 64 + 4 * c4) * 4);
    u32x2 w; w.x = pk2(s[0], s[1]); w.y = pk2(s[2], s[3]);
    *(u32x2*)(op + (size_t)(32 * c + t) * D + 4 * c4) = w;
}
template <int PV>
DI void p2_hgrn_mfma(Frame& F, ArgsP A) {
    const int ftid = opaque_tid(), flane = ftid & 63;
    const bf16_t* QA = (const bf16_t*)(A->ws + WS_QA); const bf16_t* LF = (const bf16_t*)(A->ws + WS_LF); const bf16_t* IA = (const bf16_t*)(A->ws + WS_IA); bf16_t* OH = (bf16_t*)(A->ws + (PV ? WS_YCAT : WS_OH));
    LAS unsigned char* lds = F.lds;
    const int tid = ftid, k2 = tid & 63, tg = F.wave, v64 = tid & 63, r32 = flane & 31, hh = flane >> 5, kb = F.wave >> 1, vb = F.wave & 1;
    for (int item = F.vcu; item < 256; item += F.G) {
        const int bh = item >> 1, vhalf = item & 1, b = bh >> 4, h = bh & 15;
        const size_t rb = (size_t)b * SEQ * D;
        const bf16_t* qp = QA + rb + (size_t)(4 * tg) * D + h * 128 + 2 * k2;
        const bf16_t* fp = LF + rb + (size_t)(4 * tg) * D + h * 128 + 2 * k2;
        const bf16_t* ip = IA + rb + (size_t)(4 * tg) * D + h * 128 + vhalf * 64 + v64;
        bf16_t* op = OH + rb + h * 128 + vhalf * 64;
        f32x16 S;
#pragma unroll
        for (int i = 0; i < 16; ++i) S[i] = 0.f;
        HRaw R0, R1, R2, R3;
#define HL(R, c) do { if (PV != 2) h_load(R, qp, fp, ip, c); } while (0)
#define HP(R) do { if (PV != 3) h_prep(R, lds, tg, k2, v64); } while (0)
#define HM() do { if (PV != 4) h_mma(S, lds, kb, vb, r32, hh); } while (0)
#define HSTEP(cc, RF, RN) do { if ((cc) + 4 < 64) HL(RF, (cc) + 4); HM(); if ((cc) + 1 < 64) h_totals(RN, lds, tg, k2); __syncthreads(); \
        h_reduce_store(lds, op, (cc), tid); if ((cc) + 1 < 64) HP(RN); __syncthreads(); } while (0)
        h_load(R0, qp, fp, ip, 0); h_load(R1, qp, fp, ip, 1); h_load(R2, qp, fp, ip, 2); h_load(R3, qp, fp, ip, 3);
        h_totals(R0, lds, tg, k2);
        __syncthreads();
        h_prep(R0, lds, tg, k2, v64);
        __syncthreads();
        for (int c = 0; c < 64; c += 4) { HSTEP(c, R0, R1); HSTEP(c + 1, R1, R2); HSTEP(c + 2, R2, R3); HSTEP(c + 3, R3, R0); }
#undef HSTEP
#undef HL
#undef HP
#undef HM
    }
}

struct P4Row { u32x4 o[4], sg[4], x0, x1, x2; float l0, l1, l2; };
DI void p4_load(P4Row& R, const bf16_t* OH, const bf16_t* SG, const bf16_t* OG, const float* LSE, int row, int lane) {
#pragma unroll
    for (int j = 0; j < 4; ++j) { const int c0 = 512 * j + 8 * lane; R.o[j] = *(const u32x4*)(OH + (size_t)row * D + c0); R.sg[j] = *(const u32x4*)(SG + (size_t)row * D + c0); }
    const int c0 = 8 * lane, hs = lane >> 4;
    R.l0 = LSE[((size_t)0 * T + row) * 4 + hs]; R.l1 = LSE[((size_t)1 * T + row) * 4 + hs]; R.l2 = LSE[((size_t)2 * T + row) * 4 + hs];
    R.x0 = *(const u32x4*)(OG + ((size_t)0 * T + row) * 512 + c0); R.x1 = *(const u32x4*)(OG + ((size_t)1 * T + row) * 512 + c0); R.x2 = *(const u32x4*)(OG + ((size_t)2 * T + row) * 512 + c0);
}
DI void p4_store(const P4Row& R, const float* hg, bf16_t* YC, int row, int lane) {
#pragma unroll
    for (int j = 0; j < 4; ++j) {
        const int c0 = 512 * j + 8 * lane; const u32x4 o = R.o[j], sg = R.sg[j];
        float v[8] = {bflo(o.x), bfhi(o.x), bflo(o.y), bfhi(o.y), bflo(o.z), bfhi(o.z), bflo(o.w), bfhi(o.w)};
        const float s[8] = {bflo(sg.x), bfhi(sg.x), bflo(sg.y), bfhi(sg.y), bflo(sg.z), bfhi(sg.z), bflo(sg.w), bfhi(sg.w)};
        float ss = 0.f;
#pragma unroll
        for (int e = 0; e < 8; ++e) ss += v[e] * v[e];
        ss += __shfl_xor(ss, 1); ss += __shfl_xor(ss, 2); ss += __shfl_xor(ss, 4); ss += __shfl_xor(ss, 8);
        const float rinv = rsqrtf(ss * (1.0f / 128.0f) + EPS);
        const f32x4 g0 = *(const f32x4*)(hg + c0), g1 = *(const f32x4*)(hg + c0 + 4);
#pragma unroll
        for (int e = 0; e < 4; ++e) { v[e] = v[e] * rinv * g0[e] * s[e]; v[4 + e] = v[4 + e] * rinv * g1[e] * s[4 + e]; }
        u32x4 w; w.x = pk2(v[0], v[1]); w.y = pk2(v[2], v[3]); w.z = pk2(v[4], v[5]); w.w = pk2(v[6], v[7]);
        *(u32x4*)(YC + (size_t)row * KCAT + 512 + c0) = w;
    }
    {
        const int c0 = 8 * lane; const float l0 = R.l0, l1 = R.l1, l2 = R.l2; const u32x4 x0 = R.x0, x1 = R.x1, x2 = R.x2;
        const float mx = fmaxf(l0, fmaxf(l1, l2)); float a0 = __expf(l0 - mx), a1 = __expf(l1 - mx), a2 = __expf(l2 - mx);
        const float inv = 1.0f / (a0 + a1 + a2); a0 *= inv; a1 *= inv; a2 *= inv;
        u32x4 w;
        w.x = pk2(a0 * bflo(x0.x) + a1 * bflo(x1.x) + a2 * bflo(x2.x), a0 * bfhi(x0.x) + a1 * bfhi(x1.x) + a2 * bfhi(x2.x));
        w.y = pk2(a0 * bflo(x0.y) + a1 * bflo(x1.y) + a2 * bflo(x2.y), a0 * bfhi(x0.y) + a1 * bfhi(x1.y) + a2 * bfhi(x2.y));
        w.z = pk2(a0 * bflo(x0.z) + a1 * bflo(x1.z) + a2 * bflo(x2.z), a0 * bfhi(x0.z) + a1 * bfhi(x1.z) + a2 * bfhi(x2.z));
        w.w = pk2(a0 * bflo(x0.w) + a1 * bflo(x1.w) + a2 * bflo(x2.w), a0 * bfhi(x0.w) + a1 * bfhi(x1.w) + a2 * bfhi(x2.w));
        *(u32x4*)(YC + (size_t)row * KCAT + c0) = w;
    }
}
DI void p4_fixups(Frame& F, ArgsP A) {
    const int ftid = opaque_tid(), flane = ftid & 63;
    const bf16_t* OH = (const bf16_t*)(A->ws + WS_OH); const bf16_t* SG = (const bf16_t*)(A->ws + WS_SG); const float* hg = A->in[4];
    const bf16_t* OG = (const bf16_t*)(A->ws + WS_OG); const float* LSE = (const float*)(A->ws + WS_LSE);
    bf16_t* YC = (bf16_t*)(A->ws + WS_YCAT);
    const int gw = F.vcu * NWAVES + F.wave, NGW = F.G * NWAVES, lane = flane;
    for (int row = gw; row < T; row += 2 * NGW) {
        const int row2 = row + NGW; const bool has2 = row2 < T;
        P4Row Ra, Rb;
        p4_load(Ra, OH, SG, OG, LSE, row, lane);
        if (has2) p4_load(Rb, OH, SG, OG, LSE, row2, lane);
        p4_store(Ra, hg, YC, row, lane);
        if (has2) p4_store(Rb, hg, YC, row2, lane);
    }
}

struct EpiGateCat {
    static constexpr bool PERM = true; static constexpr int MID_T = 8;
    const bf16_t* ga; const bf16_t* gb; bf16_t* outp;
    DI void mid(f32x4 (&acc)[2][2][4][2], const pg8::Unit& u, int wr, int wc, int fr, int fq) const {
        int fr_ = fr, fq_ = fq; asm volatile("" : "+v"(fr_), "+v"(fq_));
        const int row0 = u.pm * 256 + wr * 64 + fr_, col0 = u.pn * 256 + wc * 32 + 8 * fq_;
#pragma unroll
        for (int ai = 0; ai < 2; ++ai)
#pragma unroll
            for (int m = 0; m < 4; ++m)
#pragma unroll
                for (int bj = 0; bj < 2; ++bj) {
                    const size_t o = (size_t)(row0 + ai * 128 + m * 16) * D + col0 + bj * 128;
                    const u32x4 a = *(const u32x4*)(ga + o), b = *(const u32x4*)(gb + o);
                    f32x4 r0, r1;
                    r0[0] = bflo(b.x) * __builtin_amdgcn_rcpf(bflo(a.x)); r0[1] = bfhi(b.x) * __builtin_amdgcn_rcpf(bfhi(a.x)); r0[2] = bflo(b.y) * __builtin_amdgcn_rcpf(bflo(a.y)); r0[3] = bfhi(b.y) * __builtin_amdgcn_rcpf(bfhi(a.y));
                    r1[0] = bflo(b.z) * __builtin_amdgcn_rcpf(bflo(a.z)); r1[1] = bfhi(b.z) * __builtin_amdgcn_rcpf(bfhi(a.z)); r1[2] = bflo(b.w) * __builtin_amdgcn_rcpf(bflo(a.w)); r1[3] = bfhi(b.w) * __builtin_amdgcn_rcpf(bfhi(a.w));
                    acc[ai][bj][m][0] = acc[ai][bj][m][0] * r0; acc[ai][bj][m][1] = acc[ai][bj][m][1] * r1;
                    if (bj == 1) asm volatile("" ::: "memory");
                }
    }
    DI void operator()(const f32x4 (&acc)[2][2][4][2], const pg8::Unit& u, int wr, int wc, int fr, int fq) const {
        const int row0 = u.pm * 256 + wr * 64 + fr, col0 = u.pn * 256 + wc * 32 + 8 * fq;
#pragma unroll
        for (int ai = 0; ai < 2; ++ai)
#pragma unroll
            for (int m = 0; m < 4; ++m)
#pragma unroll
                for (int bj = 0; bj < 2; ++bj) {
                    const size_t o = (size_t)(row0 + ai * 128 + m * 16) * D + col0 + bj * 128;
                    const u32x4 gt = *(const u32x4*)(ga + o);
                    float v[8];
#pragma unroll
                    for (int e = 0; e < 4; ++e) { v[e] = acc[ai][bj][m][0][e]; v[4 + e] = acc[ai][bj][m][1][e]; }
                    v[0] *= bflo(gt.x); v[1] *= bfhi(gt.x); v[2] *= bflo(gt.y); v[3] *= bfhi(gt.y); v[4] *= bflo(gt.z); v[5] *= bfhi(gt.z); v[6] *= bflo(gt.w); v[7] *= bfhi(gt.w);
                    u32x4 w; w.x = pg8::cvt_pk_bf16(v[0], v[1]); w.y = pg8::cvt_pk_bf16(v[2], v[3]); w.z = pg8::cvt_pk_bf16(v[4], v[5]); w.w = pg8::cvt_pk_bf16(v[6], v[7]);
                    *(u32x4*)(outp + o) = w;
                }
    }
};
struct EpiOut {
    static constexpr bool PERM = true; static constexpr int MID_T = -1;
    const float* x; float* x1; bf16_t* x1b;
    DI void operator()(const f32x4 (&acc)[2][2][4][2], const pg8::Unit& u, int wr, int wc, int fr, int fq) const {
        const int row0 = u.pm * 256 + wr * 64 + fr, col0 = u.pn * 256 + wc * 32 + 8 * fq;
#pragma unroll
        for (int ai = 0; ai < 2; ++ai)
#pragma unroll
            for (int m = 0; m < 4; ++m)
#pragma unroll
                for (int bj = 0; bj < 2; ++bj) {
                    const size_t o = (size_t)(row0 + ai * 128 + m * 16) * D + col0 + bj * 128;
                    const f32x4 a0 = *(const f32x4*)(x + o) + acc[ai][bj][m][0], a1 = *(const f32x4*)(x + o + 4) + acc[ai][bj][m][1];
                    u32x4 w; w.x = pg8::cvt_pk_bf16(a0[0], a0[1]); w.y = pg8::cvt_pk_bf16(a0[2], a0[3]); w.z = pg8::cvt_pk_bf16(a1[0], a1[1]); w.w = pg8::cvt_pk_bf16(a1[2], a1[3]);
                    *(u32x4*)(x1b + o) = w;
                }
    }
};

template <int DUP>
DI void p7_router(Frame& F, ArgsP A) {
    const int ftid = opaque_tid(), flane = ftid & 63;
    const bf16_t* X1B = (const bf16_t*)(A->ws + WS_X1B); const float* brg = A->in[11]; const float* bre = A->in[13];
    const bf16_t* WH = (const bf16_t*)(A->ws + WS_WRT); const bf16_t* WL = WH + 96 * D;
    const size_t dofs = DUP ? (WS_YCAT - WS_EID) : 0;
    int* EID = (int*)(A->ws + WS_EID + dofs); float* GWT = (float*)(A->ws + WS_GWT + dofs); float* R2 = (float*)(A->ws + WS_R2 + dofs);
    unsigned* cnt = (unsigned*)(A->ws + WS_CTL) + CW_CNT + (DUP ? 128 : 0);
    int* rowtok = (int*)(A->ws + WS_ROWTOK + dofs); int* rowdst = (int*)(A->ws + WS_ROWDST + dofs);
    const int gw = F.vcu * NWAVES + F.wave, NGW = F.G * NWAVES, lane = flane, r32 = lane & 31, h = lane >> 5;
    for (int p = F.vcu * NTHREADS + ftid; p < PMAX; p += F.G * NTHREADS) { rowtok[p] = 0; rowdst[p] = -1; }
    LAS float* LG = (LAS float*)(F.lds) + F.wave * (32 * 100);
    LAS float* SS = (LAS float*)(F.lds) + 8 * (32 * 100) + F.wave * 32;
    const int tile = F.wave >> 2, kq = F.wave & 3;
    for (int pair = F.vcu; pair < T / 64; pair += F.G) {
        const int tok0 = (pair * 2 + tile) * 32;
        const bf16_t* xp = X1B + (size_t)(tok0 + r32) * D + 8 * h + 512 * kq;
        const bf16_t* wh = WH + (size_t)r32 * D + 8 * h + 512 * kq; const bf16_t* wl = WL + (size_t)r32 * D + 8 * h + 512 * kq;
        f32x16 acc0, acc1, acc2;
#pragma unroll
        for (int i = 0; i < 16; ++i) { acc0[i] = 0.f; acc1[i] = 0.f; acc2[i] = 0.f; }
        float ss = 0.f;
#pragma unroll 8
        for (int st = 0; st < 32; ++st) {
            const bf16x8 xb = *(const bf16x8*)(xp + 16 * st);
            const bf16x8 h0 = *(const bf16x8*)(wh + 16 * st), h1 = *(const bf16x8*)(wh + 32 * D + 16 * st), h2 = *(const bf16x8*)(wh + 64 * D + 16 * st);
            const bf16x8 l0 = *(const bf16x8*)(wl + 16 * st), l1 = *(const bf16x8*)(wl + 32 * D + 16 * st), l2 = *(const bf16x8*)(wl + 64 * D + 16 * st);
            acc0 = MFMA32(h0, xb, acc0); acc1 = MFMA32(h1, xb, acc1); acc2 = MFMA32(h2, xb, acc2);
            acc0 = MFMA32(l0, xb, acc0); acc1 = MFMA32(l1, xb, acc1); acc2 = MFMA32(l2, xb, acc2);
            const u32x4 xw = __builtin_bit_cast(u32x4, xb);
            const float t0 = bflo(xw.x), t1 = bfhi(xw.x), t2 = bflo(xw.y), t3 = bfhi(xw.y), t4 = bflo(xw.z), t5 = bfhi(xw.z), t6 = bflo(xw.w), t7 = bfhi(xw.w);
            ss += (t0 * t0 + t1 * t1) + (t2 * t2 + t3 * t3) + (t4 * t4 + t5 * t5) + (t6 * t6 + t7 * t7);
        }
        ss += __shfl_xor(ss, 32);
#pragma unroll
        for (int i = 0; i < 16; ++i) { LG[r32 * 100 + crow(i, h)] = acc0[i]; LG[r32 * 100 + 32 + crow(i, h)] = acc1[i]; LG[r32 * 100 + 64 + crow(i, h)] = acc2[i]; }
        if (h == 0) SS[r32] = ss;
        __syncthreads();
        if (ftid < 64) {
            const int tl = ftid >> 5, tk = ftid & 31;
            const LAS float* lg = (const LAS float*)(F.lds) + (tl * 4) * (32 * 100) + tk * 100;
            const LAS float* sp = (const LAS float*)(F.lds) + 8 * (32 * 100) + (tl * 4) * 32 + tk;
            const float r = rsqrtf((sp[0] + sp[32] + sp[64] + sp[96]) * (1.0f / D) + EPS);
            float a[8]; int gsel = 0; float gmax = -3.0e38f;
#pragma unroll
            for (int e = 0; e < 8; ++e) { a[e] = (lg[e] + lg[3200 + e] + lg[6400 + e] + lg[9600 + e]) * r + brg[e]; if (a[e] > gmax) { gmax = a[e]; gsel = e; } }
            float gden = 0.f;
#pragma unroll
            for (int e = 0; e < 8; ++e) gden += __expf(a[e] - gmax);
            const float pg = 1.0f / gden;
            int i1 = 0; float v1 = -3.0e38f;
#pragma unroll
            for (int e = 0; e < 8; ++e) { const int c = 8 + gsel * 8 + e; a[e] = (lg[c] + lg[3200 + c] + lg[6400 + c] + lg[9600 + c]) * r + bre[gsel * 8 + e]; if (a[e] > v1) { v1 = a[e]; i1 = e; } }
            int i2 = 0; float v2 = -3.0e38f;
#pragma unroll
            for (int e = 0; e < 8; ++e) { if (e != i1 && a[e] > v2) { v2 = a[e]; i2 = e; } }
            const float e2 = __expf(v2 - v1), p1 = 1.0f / (1.0f + e2), p2 = e2 * p1;
            const int row = (pair * 2 + tl) * 32 + tk, ea = gsel * 8 + i1, eb = gsel * 8 + i2;
            EID[row * 2] = ea; EID[row * 2 + 1] = eb; GWT[row * 2] = pg * p1; GWT[row * 2 + 1] = pg * p2; R2[row] = r;
            atomicAdd(&cnt[ea], 1u); atomicAdd(&cnt[eb], 1u);
        }
        __syncthreads();
    }
}
DI void p7_convert(Frame& F, ArgsP A) {
    const int ftid = opaque_tid(), flane = ftid & 63; const int lane = flane; const float* g2 = A->in[9];
    const int gw = F.vcu * NWAVES + F.wave, NGW = F.G * NWAVES;
    LAS unsigned* scr = (LAS unsigned*)(F.lds + F.wave * 8192);
    constexpr int I_G = (NE - GU_EARLY) * 32 * 8, I_D = 0;
    for (int it = gw; it < 2 * I_G + I_D; it += NGW) {
        int r_ = it;
        if (r_ < 2 * I_G) { const int up = r_ >= I_G; if (up) r_ -= I_G; const int e = GU_EARLY + (r_ >> 8), rem = r_ & 255;
            const float* W = (up ? A->in[15] : A->in[14]) + (size_t)e * D * FF; bf16_t* WT = wgu_ptr(A->ws, e);
            if (up) cvt_item<2>(W, FF, D, WT, g2, scr, rem >> 3, rem & 7, lane); else cvt_item<1>(W, FF, D, WT, g2, scr, rem >> 3, rem & 7, lane);
            continue; }
        r_ -= 2 * I_G; { const int e = WD_EARLY + (r_ >> 8), rem = r_ & 255;
            cvt_item<0>(A->in[16] + (size_t)e * FF * D, D, FF, (bf16_t*)(A->ws + WS_WD) + (size_t)e * D * FF, nullptr, scr, rem >> 5, rem & 31, lane); }
    }
}

DI void p7_roles(Frame& F, ArgsP A) {
    const int ftid = opaque_tid(), flane = ftid & 63;
    const int lane = flane, r32 = lane & 31, h = lane >> 5;
    { int* rowtok = (int*)(A->ws + WS_ROWTOK); int* rowdst = (int*)(A->ws + WS_ROWDST);
      for (int p = F.vcu * NTHREADS + ftid; p < PMAX; p += F.G * NTHREADS) { rowtok[p] = 0; rowdst[p] = -1; } }
    if (F.wave < 2) {
        const bf16_t* X1B = (const bf16_t*)(A->ws + WS_X1B); const float* brg = A->in[11]; const float* bre = A->in[13];
        const bf16_t* WH = (const bf16_t*)(A->ws + WS_WRT); const bf16_t* WL = WH + 96 * D;
        int* EID = (int*)(A->ws + WS_EID); float* GWT = (float*)(A->ws + WS_GWT); float* R2 = (float*)(A->ws + WS_R2);
        unsigned* cnt = (unsigned*)(A->ws + WS_CTL) + CW_CNT;
        LAS float* LG = (LAS float*)(F.lds + 65536) + F.wave * (32 * 100);
        for (int item = F.vcu * 2 + F.wave; item < T / 32; item += F.G * 2) {
            const int tok0 = item * 32;
            const bf16_t* xp = X1B + (size_t)(tok0 + r32) * D + 8 * h;
            const bf16_t* wh = WH + (size_t)r32 * D + 8 * h; const bf16_t* wl = WL + (size_t)r32 * D + 8 * h;
            f32x16 acc0, acc1, acc2;
#pragma unroll
            for (int i = 0; i < 16; ++i) { acc0[i] = 0.f; acc1[i] = 0.f; acc2[i] = 0.f; }
            float ss = 0.f;
#pragma unroll 8
            for (int st = 0; st < 128; ++st) {
                const bf16x8 xb = *(const bf16x8*)(xp + 16 * st);
                const bf16x8 h0 = *(const bf16x8*)(wh + 16 * st), h1 = *(const bf16x8*)(wh + 32 * D + 16 * st), h2 = *(const bf16x8*)(wh + 64 * D + 16 * st);
                const bf16x8 l0 = *(const bf16x8*)(wl + 16 * st), l1 = *(const bf16x8*)(wl + 32 * D + 16 * st), l2 = *(const bf16x8*)(wl + 64 * D + 16 * st);
                acc0 = MFMA32(h0, xb, acc0); acc1 = MFMA32(h1, xb, acc1); acc2 = MFMA32(h2, xb, acc2);
                acc0 = MFMA32(l0, xb, acc0); acc1 = MFMA32(l1, xb, acc1); acc2 = MFMA32(l2, xb, acc2);
                const u32x4 xw = __builtin_bit_cast(u32x4, xb);
                const float t0 = bflo(xw.x), t1 = bfhi(xw.x), t2 = bflo(xw.y), t3 = bfhi(xw.y), t4 = bflo(xw.z), t5 = bfhi(xw.z), t6 = bflo(xw.w), t7 = bfhi(xw.w);
                ss += (t0 * t0 + t1 * t1) + (t2 * t2 + t3 * t3) + (t4 * t4 + t5 * t5) + (t6 * t6 + t7 * t7);
            }
            ss += __shfl_xor(ss, 32);
            const float r = rsqrtf(ss * (1.0f / D) + EPS);
#pragma unroll
            for (int i = 0; i < 16; ++i) { LG[r32 * 100 + crow(i, h)] = acc0[i] * r; LG[r32 * 100 + 32 + crow(i, h)] = acc1[i] * r; LG[r32 * 100 + 64 + crow(i, h)] = acc2[i] * r; }
            LDS_WAIT(); asm volatile("" ::: "memory");
            if (lane < 32) {
                const LAS float* lg = LG + lane * 100;
                float a[8]; int gsel = 0; float gmax = -3.0e38f;
#pragma unroll
                for (int e = 0; e < 8; ++e) { a[e] = lg[e] + brg[e]; if (a[e] > gmax) { gmax = a[e]; gsel = e; } }
                float gden = 0.f;
#pragma unroll
                for (int e = 0; e < 8; ++e) gden += __expf(a[e] - gmax);
                const float pg = 1.0f / gden;
                int i1 = 0; float v1 = -3.0e38f;
#pragma unroll
                for (int e = 0; e < 8; ++e) { a[e] = lg[8 + gsel * 8 + e] + bre[gsel * 8 + e]; if (a[e] > v1) { v1 = a[e]; i1 = e; } }
                int i2 = 0; float v2 = -3.0e38f;
#pragma unroll
                for (int e = 0; e < 8; ++e) { if (e != i1 && a[e] > v2) { v2 = a[e]; i2 = e; } }
                const float e2 = __expf(v2 - v1), p1 = 1.0f / (1.0f + e2), p2 = e2 * p1;
                const int row = tok0 + lane, ea = gsel * 8 + i1, eb = gsel * 8 + i2;
                EID[row * 2] = ea; EID[row * 2 + 1] = eb; GWT[row * 2] = pg * p1; GWT[row * 2 + 1] = pg * p2; R2[row] = r;
                atomicAdd(&cnt[ea], 1u); atomicAdd(&cnt[eb], 1u);
            }
            LDS_WAIT(); asm volatile("" ::: "memory");
        }
    } else {
        LAS unsigned* scr = (LAS unsigned*)(F.lds + (F.wave - 2) * 8192);
        constexpr int I_G = (NE - GU_EARLY) * 32 * 8;
        for (int it = F.vcu * 6 + (F.wave - 2); it < 2 * I_G; it += F.G * 6) {
            int r_ = it; const int up = r_ >= I_G; if (up) r_ -= I_G; const int e = GU_EARLY + (r_ >> 8), rem = r_ & 255;
            const float* W = (up ? A->in[15] : A->in[14]) + (size_t)e * D * FF; bf16_t* WT = wgu_ptr(A->ws, e);
            if (up) cvt_item<2>(W, FF, D, WT, A->in[9], scr, rem >> 3, rem & 7, lane); else cvt_item<1>(W, FF, D, WT, A->in[9], scr, rem >> 3, rem & 7, lane);
        }
    }
    __syncthreads();
}

DI int moe_tables(Frame& F, ArgsP A, LAS int* rbe, LAS int* bstart) {
    const int ftid = opaque_tid();
    const unsigned* cnt = (const unsigned*)(A->ws + WS_CTL) + CW_CNT;
    __syncthreads();
    if (ftid == 0) {
        int acc = 0;
        for (int e = 0; e < NE; ++e) { const int c = (int)__hip_atomic_load(cnt + e, __ATOMIC_RELAXED, __HIP_MEMORY_SCOPE_AGENT); const int nb = (c + 255) >> 8; bstart[e] = acc; for (int k = 0; k < nb; ++k) rbe[acc + k] = e; acc += nb; }
        bstart[NE] = acc;
    }
    __syncthreads();
    return bstart[NE];
}

template <int DUP>
DI void p8_scatter(Frame& F, ArgsP A) {
    const int ftid = opaque_tid(), flane = ftid & 63;
    LAS int* rbe = (LAS int*)(F.lds + LDSCTL_OFF); LAS int* bstart = (LAS int*)(F.lds);
    (void)moe_tables(F, A, rbe, bstart);
    const int* EID = (const int*)(A->ws + WS_EID); const float* GWT = (const float*)(A->ws + WS_GWT); const float* R2 = (const float*)(A->ws + WS_R2);
    const size_t dofs = DUP ? (WS_YCAT - WS_EID) : 0;
    unsigned* fill = (unsigned*)(A->ws + WS_CTL) + CW_FILL + (DUP ? 128 : 0);
    int* rowtok = (int*)(A->ws + WS_ROWTOK + dofs); int* rowdst = (int*)(A->ws + WS_ROWDST + dofs); float* roww = (float*)(A->ws + WS_ROWW + dofs); float* rowr2 = (float*)(A->ws + WS_ROWR2 + dofs);
    for (int a = F.vcu * NTHREADS + ftid; a < 2 * T; a += F.G * NTHREADS) {
        const int e = EID[a]; const unsigned k = atomicAdd(&fill[e], 1u); const int p = bstart[e] * 256 + (int)k;
        rowtok[p] = a >> 1; rowdst[p] = a; roww[p] = GWT[a]; rowr2[p] = R2[a >> 1];
    }
    __syncthreads();
}

DI void p9_tail_convert(Frame& F, ArgsP A, int nunits) {
    const int ftid = opaque_tid(), flane = ftid & 63;
    LAS unsigned* scr = (LAS unsigned*)(F.lds + F.wave * 8192);
    constexpr int NIT = (NE - WD_EARLY) * 256, QUOTA = 96;
    const int r = nunits % F.G, nidle = (r == 0) ? 0 : F.G - r;
    const int n_early = (nidle * QUOTA < NIT) ? nidle * QUOTA : NIT;
    if (r != 0 && F.vcu >= r) {
        const int rank = F.vcu - r, lo = rank * QUOTA, hi = (lo + QUOTA < n_early) ? lo + QUOTA : n_early;
        for (int it = lo + F.wave; it < hi; it += NWAVES) { const int e = WD_EARLY + (it >> 8), rem = it & 255;
            cvt_item<0>(A->in[16] + (size_t)e * FF * D, D, FF, (bf16_t*)(A->ws + WS_WD) + (size_t)e * D * FF, nullptr, scr, rem >> 5, rem & 31, flane); }
    }
    for (int it = n_early + F.vcu * NWAVES + F.wave; it < NIT; it += F.G * NWAVES) { const int e = WD_EARLY + (it >> 8), rem = it & 255;
        cvt_item<0>(A->in[16] + (size_t)e * FF * D, D, FF, (bf16_t*)(A->ws + WS_WD) + (size_t)e * D * FF, nullptr, scr, rem >> 5, rem & 31, flane); }
}
struct EpiGU {
    static constexpr bool PERM = true; static constexpr int MID_T = -1;
    const float* rowr2; bf16_t* U;
    DI void operator()(const f32x4 (&acc)[2][2][4][2], const pg8::Unit& u, int wr, int wc, int fr, int fq) const {
        const int row0 = u.pm * 256 + wr * 64 + fr, pnr = u.pn & 3;
#pragma unroll
        for (int ai = 0; ai < 2; ++ai)
#pragma unroll
            for (int m = 0; m < 4; ++m) {
                const int p = row0 + ai * 128 + m * 16; const float r = rowr2[p];
#pragma unroll
                for (int bj = 0; bj < 2; ++bj) {
                    const int f0 = 128 * pnr + 64 * bj + 16 * wc + 4 * fq;
                    float o[4];
#pragma unroll
                    for (int e = 0; e < 4; ++e) { const float g = acc[ai][bj][m][0][e] * r, up = acc[ai][bj][m][1][e] * r; o[e] = g * sigmoidf_(g) * up; }
                    u32x2 w; w.x = pg8::cvt_pk_bf16(o[0], o[1]); w.y = pg8::cvt_pk_bf16(o[2], o[3]);
                    *(u32x2*)(U + (size_t)p * FF + f0) = w;
                }
            }
    }
};
struct EpiDown {
    static constexpr bool PERM = true; static constexpr int MID_T = -1;
    const int* rowdst; const float* roww; bf16_t* YK;
    DI void operator()(const f32x4 (&acc)[2][2][4][2], const pg8::Unit& u, int wr, int wc, int fr, int fq) const {
        const int row0 = u.pm * 256 + wr * 64 + fr, col0 = (u.pn & 7) * 256 + wc * 32 + 8 * fq;
#pragma unroll
        for (int ai = 0; ai < 2; ++ai)
#pragma unroll
            for (int m = 0; m < 4; ++m) {
                const int p = row0 + ai * 128 + m * 16; const int dst = rowdst[p]; const float w = roww[p];
                if (dst >= 0) {
#pragma unroll
                    for (int bj = 0; bj < 2; ++bj) {
                        const f32x4 a0 = acc[ai][bj][m][0] * w, a1 = acc[ai][bj][m][1] * w;
                        u32x4 o; o.x = pg8::cvt_pk_bf16(a0[0], a0[1]); o.y = pg8::cvt_pk_bf16(a0[2], a0[3]); o.z = pg8::cvt_pk_bf16(a1[0], a1[1]); o.w = pg8::cvt_pk_bf16(a1[2], a1[3]);
                        *(u32x4*)(YK + (size_t)dst * D + col0 + bj * 128) = o;
                    }
                }
            }
    }
};

DI void p11_load(const bf16_t* X1B, const bf16_t* YK, int row, int lane, float (&v)[32]) {
#pragma unroll
    for (int j = 0; j < 4; ++j) {
        const int c0 = 512 * j + 8 * lane;
        const u32x4 xw = *(const u32x4*)(X1B + (size_t)row * D + c0);
        const f32x4 a0 = {bflo(xw.x), bfhi(xw.x), bflo(xw.y), bfhi(xw.y)}, a1 = {bflo(xw.z), bfhi(xw.z), bflo(xw.w), bfhi(xw.w)};
        const u32x4 y0 = *(const u32x4*)(YK + (size_t)(2 * row) * D + c0), y1 = *(const u32x4*)(YK + (size_t)(2 * row + 1) * D + c0);
        v[8 * j + 0] = a0[0] + (bflo(y0.x) + bflo(y1.x)); v[8 * j + 1] = a0[1] + (bfhi(y0.x) + bfhi(y1.x)); v[8 * j + 2] = a0[2] + (bflo(y0.y) + bflo(y1.y)); v[8 * j + 3] = a0[3] + (bfhi(y0.y) + bfhi(y1.y));
        v[8 * j + 4] = a1[0] + (bflo(y0.z) + bflo(y1.z)); v[8 * j + 5] = a1[1] + (bfhi(y0.z) + bfhi(y1.z)); v[8 * j + 6] = a1[2] + (bflo(y0.w) + bflo(y1.w)); v[8 * j + 7] = a1[3] + (bfhi(y0.w) + bfhi(y1.w));
    }
}
DI void p11_store(float* out, const float* gf, int row, int lane, const float (&v)[32]) {
    float ss = 0.f;
#pragma unroll
    for (int e = 0; e < 32; ++e) ss += v[e] * v[e];
    const float r = rsqrtf(wave_sum(ss) * (1.0f / D) + EPS);
#pragma unroll
    for (int j = 0; j < 4; ++j) {
        const int c0 = 512 * j + 8 * lane;
        const f32x4 g0 = *(const f32x4*)(gf + c0), g1 = *(const f32x4*)(gf + c0 + 4);
        *(f32x4*)(out + (size_t)row * D + c0) = (f32x4){v[8 * j] * r * g0[0], v[8 * j + 1] * r * g0[1], v[8 * j + 2] * r * g0[2], v[8 * j + 3] * r * g0[3]};
        *(f32x4*)(out + (size_t)row * D + c0 + 4) = (f32x4){v[8 * j + 4] * r * g1[0], v[8 * j + 5] * r * g1[1], v[8 * j + 6] * r * g1[2], v[8 * j + 7] * r * g1[3]};
    }
}
DI void p11_final(Frame& F, ArgsP A) {
    const int ftid = opaque_tid(), flane = ftid & 63;
    const bf16_t* X1 = (const bf16_t*)(A->ws + WS_X1B); const bf16_t* YK = (const bf16_t*)(A->ws + WS_YK); const float* gf = A->in[17];
    const int gw = F.vcu * NWAVES + F.wave, NGW = F.G * NWAVES, lane = flane;
    for (int row = gw; row < T; row += 2 * NGW) {
        float va[32], vb[32];
        const int row2 = row + NGW; const bool has2 = row2 < T;
        p11_load(X1, YK, row, lane, va);
        if (has2) p11_load(X1, YK, row2, lane, vb);
        p11_store(A->out, gf, row, lane, va);
        if (has2) p11_store(A->out, gf, row2, lane, vb);
    }
}

constexpr int N_PHASES = 12;
__global__ void __launch_bounds__(NTHREADS, 2) fwd(Args args) {
    extern __shared__ __attribute__((aligned(16))) unsigned char lds_raw[];
    Frame F;
    F.lds = (LAS unsigned char*)lds_raw;
    F.wave = __builtin_amdgcn_readfirstlane(threadIdx.x >> 6);
    F.G = gridDim.x; { const int bx = blockIdx.x; F.vcu = (F.G % 8 == 0) ? (bx % 8) * (F.G / 8) + bx / 8 : bx; }
    volatile LAS unsigned* MISC = (volatile LAS unsigned*)(F.lds + MISC_OFF);
    for (int u = threadIdx.x; u < (LDS_BYTES - LDSCTL_OFF) / 4; u += NTHREADS) ((LAS unsigned*)(F.lds + LDSCTL_OFF))[u] = 0u;
    __syncthreads();
    const bool one_launch = (MK_N_LAUNCHES == 1);
    if (one_launch) (void)xcd_barrier_post((unsigned*)(ka_ptr()->ws + WS_CTL) + CW_BAR, MISC + 8);
#define GRID_BAR() do { if (one_launch) { XcdBarrier b_; unsigned char* w_ = ka_ptr()->ws; asm volatile("" : "+s"(w_)); b_.bar = (unsigned*)(w_ + WS_CTL) + CW_BAR; b_.x = xb_xcc_id(); b_.st = (volatile LAS unsigned*)(F.lds + MISC_OFF) + 8; xcd_barrier(b_); } } while (0)
    const int lo = ka_ptr()->ph_lo, hi = ka_ptr()->ph_hi;
#ifndef PHASE_MASK
#define PHASE_MASK 0xFFF
#endif
#define IN(k) (((PHASE_MASK >> (k)) & 1) && lo <= (k) && (k) < hi)
#define BOTH(k) (IN(k) && IN((k) + 1))
#ifndef REPEAT_MASK
#define REPEAT_MASK 0
#endif
#define RUN(k, ...) do { __VA_ARGS__; if constexpr (((REPEAT_MASK >> (k)) & 1) != 0) { __syncthreads(); __VA_ARGS__; } } while (0)

    if (IN(0)) { RUN(0, p0_prologue(F, ka_ptr())); if (BOTH(0)) GRID_BAR(); }
    if (IN(1)) {
        pg8::Gemm g{(const bf16_t*)(ka_ptr()->ws + WS_H), (const bf16_t*)(ka_ptr()->ws + WS_WIN), D, nullptr}; pg8::StaticOrder S; S.init(T, INW, F.G, (int)blockIdx.x);
        EpiProj E{ka_ptr()->ws, ka_ptr()->in[3]};
#ifdef P1_STAGGER_TICKS
        if ((blockIdx.x & 1) != 0) { const unsigned long long t0 = __builtin_amdgcn_s_memrealtime(); while (__builtin_amdgcn_s_memrealtime() - t0 < (unsigned long long)(P1_STAGGER_TICKS)) __builtin_amdgcn_s_sleep(16); }
#endif
        RUN(1, pg8::gemm_phase<EpiProj, pg8::StaticOrder, true, true, false>(F.lds, g, S, E));
        __syncthreads();
        if (F.G == 256) { if (blockIdx.x >= 128) p1_tail_convert(F, ka_ptr(), (int)blockIdx.x - 128, 128); }
        else p1_tail_convert(F, ka_ptr(), (int)blockIdx.x, F.G);
#ifdef PROBE_NOSTORE_EPI
        { __syncthreads(); EpiProjT<1> EQ{ka_ptr()->ws, ka_ptr()->in[3]}; pg8::gemm_phase<EpiProjT<1>, pg8::StaticOrder, true, true, false>(F.lds, g, S, EQ); }
#endif
#ifdef PROBE_PLAIN_EPI
        { __syncthreads(); EpiPlainScratch EP{(bf16_t*)(ka_ptr()->ws + WS_YCAT)}; pg8::gemm_phase<EpiPlainScratch, pg8::StaticOrder, true, true, false>(F.lds, g, S, EP); }
#endif
#ifdef PROBE_NULL_EPI
        { __syncthreads(); EpiNull EN; pg8::gemm_phase<EpiNull, pg8::StaticOrder, true, true, false>(F.lds, g, S, EN); }
#endif
        if (BOTH(1)) GRID_BAR();
    }
    if (IN(2)) { RUN(2, p2_hgrn_mfma<0>(F, ka_ptr()));
#ifdef PROBE_P2
        __syncthreads(); p2_hgrn_mfma<PROBE_P2>(F, ka_ptr());
#endif
    }
    if (IN(3)) { RUN(3, p3_attn_mfma(F, ka_ptr())); if (BOTH(3)) GRID_BAR(); }
    if (IN(4)) { RUN(4, p4_fixups(F, ka_ptr())); if (BOTH(4)) GRID_BAR();
#ifdef PROBE_BAR
        GRID_BAR(); GRID_BAR(); GRID_BAR(); GRID_BAR();
#endif
    }
    if (IN(5)) {
        pg8::Gemm g{(const bf16_t*)(ka_ptr()->ws + WS_YCAT), (const bf16_t*)(ka_ptr()->ws + WS_WCAT), KCAT, nullptr}; pg8::StaticOrder S; S.init(T, D, F.G, (int)blockIdx.x);
        EpiGateCat E{(const bf16_t*)(ka_ptr()->ws + WS_GA), (const bf16_t*)(ka_ptr()->ws + WS_GB), (bf16_t*)(ka_ptr()->ws + WS_MERGED)};
        RUN(5, pg8::gemm_phase<EpiGateCat, pg8::StaticOrder, true, true, false>(F.lds, g, S, E));
        if (BOTH(5)) GRID_BAR();
    }
    if (IN(6)) {
        pg8::Gemm g{(const bf16_t*)(ka_ptr()->ws + WS_MERGED), (const bf16_t*)(ka_ptr()->ws + WS_WOUT), D, nullptr}; pg8::StaticOrder S; S.init(T, D, F.G, (int)blockIdx.x);
        EpiOut E{ka_ptr()->in[0], (float*)(ka_ptr()->ws + WS_X1), (bf16_t*)(ka_ptr()->ws + WS_X1B)};
        RUN(6, pg8::gemm_phase<EpiOut, pg8::StaticOrder, true, true, false>(F.lds, g, S, E));
        if (BOTH(6)) GRID_BAR();
    }
    if (IN(7)) {
#ifdef P7_SEQUENTIAL
        p7_router<0>(F, ka_ptr()); RUN(7, p7_convert(F, ka_ptr()));
#else
        p7_roles(F, ka_ptr());
#endif
        if (BOTH(7)) GRID_BAR(); }
    if (IN(8)) { p8_scatter<0>(F, ka_ptr());
#ifdef PROBE_SCATTER
        __syncthreads(); p8_scatter<1>(F, ka_ptr());
#endif
        if (BOTH(8)) GRID_BAR(); }
    if (IN(9)) {
        LAS int* rbe = (LAS int*)(F.lds + LDSCTL_OFF); LAS int* bstart = (LAS int*)(F.lds + LDSCTL_OFF + 768 + 256 + 64);
        const int nrb = moe_tables(F, ka_ptr(), rbe, bstart);
        pg8::Gemm g{(const bf16_t*)(ka_ptr()->ws + WS_X1B), (const bf16_t*)(ka_ptr()->ws + WS_WGU), D, (const int*)(ka_ptr()->ws + WS_ROWTOK)};
        pg8::MoeOrder S{rbe, nrb, 4, F.G, F.vcu, GU_EARLY, (int)((WS_WGU_E - WS_WGU) / MiB)};
        EpiGU E{(const float*)(ka_ptr()->ws + WS_ROWR2), (bf16_t*)(ka_ptr()->ws + WS_U)};
        RUN(9, pg8::gemm_phase<EpiGU, pg8::MoeOrder, true, true, true>(F.lds, g, S, E));
        __syncthreads();
        p9_tail_convert(F, ka_ptr(), nrb * 4);
        if (BOTH(9)) GRID_BAR();
    }
    if (IN(10)) {
        LAS int* rbe = (LAS int*)(F.lds + LDSCTL_OFF); LAS int* bstart = (LAS int*)(F.lds + LDSCTL_OFF + 768 + 256 + 64);
        const int nrb = moe_tables(F, ka_ptr(), rbe, bstart);
        pg8::Gemm g{(const bf16_t*)(ka_ptr()->ws + WS_U), (const bf16_t*)(ka_ptr()->ws + WS_WD), FF, nullptr};
        pg8::MoeOrder S{rbe, nrb, 8, F.G, F.vcu, 0, 0};
        EpiDown E{(const int*)(ka_ptr()->ws + WS_ROWDST), (const float*)(ka_ptr()->ws + WS_ROWW), (bf16_t*)(ka_ptr()->ws + WS_YK)};
        RUN(10, pg8::gemm_phase<EpiDown, pg8::MoeOrder, true, true, false>(F.lds, g, S, E));
        if (BOTH(10)) GRID_BAR();
    }
    if (IN(11)) { RUN(11, p11_final(F, ka_ptr())); }
#undef IN
#undef BOTH
}

extern "C" void kernel_launch(void* const* d_in, const int* in_sizes, int n_in, void* d_out, int out_size, void* d_ws, size_t ws_size, hipStream_t stream) {
    static int grid = 0;
    if (grid == 0) {
        if (n_in != 18 || in_sizes[0] != T * D || out_size != T * D || ws_size < WS_END) { fprintf(stderr, "kernel_launch: unexpected shapes: n_in %d in0 %d out %d ws %zu (need %zu)\n", n_in, n_in > 0 ? in_sizes[0] : -1, out_size, ws_size, (size_t)WS_END); grid = -1; return; }
        int dev = 0, cus = 0, per_cu = 0;
        if (hipGetDevice(&dev) != hipSuccess || hipDeviceGetAttribute(&cus, hipDeviceAttributeMultiprocessorCount, dev) != hipSuccess) { grid = -1; return; }
        if (hipFuncSetAttribute((const void*)fwd, hipFuncAttributeMaxDynamicSharedMemorySize, LDS_BYTES) != hipSuccess) { fprintf(stderr, "kernel_launch: hipFuncSetAttribute failed\n"); grid = -1; return; }
        if (hipOccupancyMaxActiveBlocksPerMultiprocessor(&per_cu, (const void*)fwd, NTHREADS, LDS_BYTES) != hipSuccess || per_cu < 1) fprintf(stderr, "kernel_launch: occupancy query reports %d\n", per_cu);
        (void)hipGetLastError();
        grid = cus;
        fprintf(stderr, "kernel_launch: grid %d, occupancy query %d, ws %zu\n", grid, per_cu, ws_size);
    }
    if (grid < 0) return;
    if (hipMemsetAsync((char*)d_ws + WS_CTL, 0, CTL_ZERO_BYTES, stream) != hipSuccess) return;
    Args a{};
    for (int i = 0; i < 18; ++i) a.in[i] = (const float*)d_in[i];
    a.out = (float*)d_out; a.ws = (unsigned char*)d_ws;
    const int nl = MK_N_LAUNCHES;
    for (int li = 0; li < nl; ++li) {
        a.ph_lo = (nl == 1) ? 0 : li; a.ph_hi = (nl == 1) ? N_PHASES : li + 1; a.li = li; a.pad = 0;
        hipLaunchKernelGGL(fwd, dim3(grid), dim3(NTHREADS), LDS_BYTES, stream, a);
        const hipError_t le = hipPeekAtLastError();
        if (le != hipSuccess) { fprintf(stderr, "kernel_launch: launch %d failed: %s\n", li, hipGetErrorName(le)); break; }
    }
}
```

```cpp
#include <hip/hip_runtime.h>
#include <cstdio>
#include <cstdint>

#ifndef MK_N_LAUNCHES
#define MK_N_LAUNCHES 1
#endif

#define DI __device__ __forceinline__
#define GAS __attribute__((address_space(1)))
#define LAS __attribute__((address_space(3)))
typedef unsigned short bf16_t;
typedef short bf16x8 __attribute__((ext_vector_type(8)));
typedef float f32x4 __attribute__((ext_vector_type(4)));
typedef unsigned u32x4 __attribute__((ext_vector_type(4)));
typedef unsigned u32x2 __attribute__((ext_vector_type(2)));

constexpr int NB = 8, SEQ = 2048, T = NB * SEQ, D = 2048;
constexpr int INW = 16896;
constexpr int NE = 64, FF = 512;
constexpr int PMAX = 49152;
constexpr int WD_EARLY = 16;
constexpr int GU_EARLY = 12;
constexpr float EPS = 1e-6f;
constexpr int NWAVES = 8, NTHREADS = 512;

constexpr size_t MiB = 1u << 20;
constexpr size_t WS_CTL = 0, CTL_ZERO_BYTES = 1 * MiB;
constexpr size_t WS_EID = 1 * MiB, WS_GWT = WS_EID + 256 * 1024, WS_R2 = WS_GWT + 256 * 1024;
constexpr size_t WS_ROWTOK = 2 * MiB, WS_ROWDST = WS_ROWTOK + 256 * 1024, WS_ROWW = WS_ROWDST + 256 * 1024, WS_ROWR2 = WS_ROWW + 256 * 1024;
constexpr size_t WS_WRT = 4 * MiB;
constexpr size_t WS_LSE = 3 * MiB;
constexpr size_t WS_WCAT = 8 * MiB, WS_WOUT = 18 * MiB;
constexpr size_t WS_WIN = 32 * MiB, WS_H = 98 * MiB;
constexpr size_t WS_QA = 162 * MiB, WS_LF = 226 * MiB, WS_IA = 290 * MiB, WS_SG = 354 * MiB;
constexpr size_t WS_QB = 418 * MiB, WS_KB = 466 * MiB, WS_VT = 514 * MiB, WS_GA = 562 * MiB, WS_GB = 626 * MiB;
constexpr size_t WS_OH = 690 * MiB, WS_OG = 754 * MiB;
constexpr size_t WS_YCAT = 803 * MiB, WS_MERGED = 98 * MiB  , WS_WD = 883 * MiB  , WS_WGU_E = 1014 * MiB  , WS_END = 1062 * MiB;
constexpr int KCAT = 2560;
constexpr size_t WS_X1 = 162 * MiB, WS_X1B = 290 * MiB, WS_WGU = 354 * MiB, WS_U = 738 * MiB, WS_YK = 32 * MiB;
static_assert(WS_U + (size_t)PMAX * FF * 2 <= WS_YCAT, "ws map");
constexpr int CW_BAR = 4096;
constexpr int CW_CNT = 16384;
constexpr int CW_FILL = 16384 + 64;

constexpr int RING_BYTES = 131072;
constexpr int LDSCTL_OFF = RING_BYTES;
constexpr int MISC_OFF = LDSCTL_OFF + 1024;
constexpr int LDS_BYTES = 147456;

DI unsigned f2bf(float f) { unsigned u = __builtin_bit_cast(unsigned, f); return (u + 0x7fffu + ((u >> 16) & 1u)) >> 16; }
typedef __bf16 bf16x2_t __attribute__((ext_vector_type(2)));
typedef float f32x2_t __attribute__((ext_vector_type(2)));
DI unsigned cvtpk_s(float lo, float hi) { f32x2_t v = {lo, hi}; bf16x2_t b = __builtin_convertvector(v, bf16x2_t); return __builtin_bit_cast(unsigned, b); }
DI unsigned pk2(float lo, float hi) { return cvtpk_s(lo, hi); }
DI float bflo(unsigned w) { return __builtin_bit_cast(float, w << 16); }
DI float bfhi(unsigned w) { return __builtin_bit_cast(float, w & 0xffff0000u); }
DI float bf1(bf16_t b) { return __builtin_bit_cast(float, (unsigned)b << 16); }
DI float sigmoidf_(float x) { return __builtin_amdgcn_rcpf(1.0f + __expf(-x)); }
#ifndef EPI_SC1
#define EPI_SC1 0
#endif
DI void st16_stream(void* p, u32x4 v) {
#if EPI_SC1
    asm volatile("global_store_dwordx4 %0, %1, off sc1\n\ts_nop 1" :: "v"(p), "v"(v) : "memory");
#else
    *(u32x4*)p = v;
#endif
}
#define LDS_WAIT() asm volatile("s_waitcnt lgkmcnt(0)" ::: "memory")
#define VM_WAIT() asm volatile("s_waitcnt vmcnt(0)" ::: "memory")

namespace pg8 {
constexpr int BM = 256, BK = 64, HALF = 128, HTB = HALF * BK * 2, STAGE_BYTES = 8 * HTB, NXCD = 8, WGM = 8;
__host__ __device__ __forceinline__ int lds_byte(int r, int c) { const int st = (r >> 4) * 2 + (c >> 5), rr = r & 15, cc = c & 31, ob = rr * 64 + cc * 2; return st * 1024 + (ob ^ (((ob >> 9) & 1) << 5)); }
__host__ __device__ __forceinline__ void stage_rc(int b, int& R, int& C) { const int st = b / 1024, sb = b % 1024, swz = sb ^ (((sb >> 9) & 1) << 5); R = (st >> 1) * 16 + swz / 64; C = (st & 1) * 32 + (swz % 64) / 2; }
__host__ __device__ __forceinline__ int perm32(int rho) { const int n = rho >> 4, i = rho & 15; return 8 * (i >> 2) + 4 * n + (i & 3); }

struct Unit { int pm, pn; };
struct Gemm { const bf16_t* A; const bf16_t* Bt; int K; const int* rowtok; };

struct StaticOrder {
    int nM, nN, nwg, G, c;
    __host__ __device__ void init(int M, int N, int G_, int c_) { nM = M / BM; nN = N / BM; nwg = nM * nN; G = G_; c = c_; }
    __host__ __device__ bool next(int i, Unit& u) const {
        const long L = (long)i * G + c; if (L >= nwg) return false;
        int wgid = (int)L; { const int q = nwg / NXCD, r = nwg % NXCD, xcd = wgid % NXCD, off = wgid / NXCD; wgid = (xcd < r ? xcd * (q + 1) : r * (q + 1) + (xcd - r) * q) + off; }
        const int nig = WGM * nN, gid = wgid / nig, fm = gid * WGM, gsz = (nM - fm) < WGM ? (nM - fm) : WGM;
        u.pm = fm + ((wgid % nig) % gsz); u.pn = (wgid % nig) / gsz; return true;
    }
};
struct MoeOrder {
    const LAS int* rbe; int nrb, NT, G, vcu, n_early, early_off;
    DI bool next(int i, Unit& u) const {
        const int L = i * G + vcu; if (L >= nrb * NT) return false;
        const int rb = L / NT, pnr = L - rb * NT; const int e = rbe[rb]; u.pm = rb; u.pn = e * NT + pnr + (e < n_early ? early_off : 0); return true;
    }
};

DI unsigned cvt_pk_bf16(float lo, float hi) { unsigned r; asm volatile("v_cvt_pk_bf16_f32 %0, %1, %2" : "=v"(r) : "v"(lo), "v"(hi)); return r; }

template <class Epi, class Sched, bool ALIGN_EPI, bool SP2, bool GATHER>
DI void gemm_phase(LAS unsigned char* lds, const Gemm g, const Sched& S, const Epi& E) {
    const int tid = threadIdx.x, wid = __builtin_amdgcn_readfirstlane(tid >> 6), lane = tid & 63, wr = wid >> 2, wc = wid & 3, fr = lane & 15, fq = lane >> 4;
    const int K = g.K, nt = K / BK;
    unsigned voffA[2], voffB[2]; int RA[2], CA[2];
#pragma unroll
    for (int i = 0; i < 2; ++i) { int R, C; stage_rc(tid * 16 + i * 8192, R, C); const int Rb = Epi::PERM ? ((R & ~31) + perm32(R & 31)) : R;
        voffA[i] = (unsigned)(R * K + C) * 2u; voffB[i] = (unsigned)(Rb * K + C) * 2u; RA[i] = R; CA[i] = C; }
    const size_t kstep = (size_t)(BK * 2);
    const size_t hstep = (size_t)HALF * K * 2;
    const size_t tstep = 2 * hstep;
    const size_t hstepA = GATHER ? 0 : hstep;
    const unsigned ldsw = (unsigned)wid * 1024u;
    const int aoff = lds_byte(wr * 64 + fr, fq * 8), boff = lds_byte(wc * 32 + fr, fq * 8);
#define PG8_SA(b, h) (((b) * 2 + (h)) * HTB)
#define PG8_SB(b, h) ((4 + (b) * 2 + (h)) * HTB)
#define PG8_STAGE2(bufoff, gbase, v0, v1) do { \
        __builtin_amdgcn_global_load_lds((const unsigned*)((const char*)(gbase) + (v0)), (LAS unsigned*)(lds + (bufoff) + ldsw), 16, 0, 0); \
        __builtin_amdgcn_global_load_lds((const unsigned*)((const char*)(gbase) + (v1)), (LAS unsigned*)(lds + (bufoff) + ldsw + 8192), 16, 0, 0); } while (0)
#define PG8_STAGE(bufoff, gbase, voff) PG8_STAGE2(bufoff, gbase, (voff)[0], (voff)[1])
#define PG8_LDA(dst, b, h) do { _Pragma("unroll") for (int m = 0; m < 4; ++m) _Pragma("unroll") for (int k = 0; k < 2; ++k) dst[m][k] = *(const LAS bf16x8*)(lds + PG8_SA(b, h) + aoff + m * 2048 + k * 1024); } while (0)
#define PG8_LDB(dst, b, h) do { _Pragma("unroll") for (int n = 0; n < 2; ++n) _Pragma("unroll") for (int k = 0; k < 2; ++k) dst[n][k] = *(const LAS bf16x8*)(lds + PG8_SB(b, h) + boff + n * 2048 + k * 1024); } while (0)
#define PG8_MMA(ai, bj, At, Bt) do { __builtin_amdgcn_s_setprio(1); _Pragma("unroll") for (int m = 0; m < 4; ++m) _Pragma("unroll") for (int n = 0; n < 2; ++n) _Pragma("unroll") for (int k = 0; k < 2; ++k) \
        acc[ai][bj][m][n] = __builtin_amdgcn_mfma_f32_16x16x32_bf16(Bt[n][k], At[m][k], acc[ai][bj][m][n], 0, 0, 0); __builtin_amdgcn_s_setprio(0); } while (0)
#define PG8_WAIT_V(n) asm volatile("s_waitcnt vmcnt(" #n ")" ::: "memory")
#define PG8_WAIT_L(n) asm volatile("s_waitcnt lgkmcnt(" #n ")" ::: "memory")
#define PG8_BAR __builtin_amdgcn_s_barrier()
#define PG8_SCHED __builtin_amdgcn_sched_barrier(0)
#define PG8_GATHER(u, dst) do { _Pragma("unroll") for (int _h = 0; _h < 2; ++_h) _Pragma("unroll") for (int _i = 0; _i < 2; ++_i) { \
        const int _tok = g.rowtok[(u).pm * BM + _h * HALF + RA[_i]]; dst[_h][_i] = (unsigned)(_tok * K + CA[_i]) * 2u; } } while (0)
    Unit cur, nxt; int ui = 0;
    if (!S.next(0, cur)) return;
    f32x4 acc[2][2][4][2];
#pragma unroll
    for (int a = 0; a < 2; ++a)
#pragma unroll
        for (int b = 0; b < 2; ++b)
#pragma unroll
            for (int m = 0; m < 4; ++m)
#pragma unroll
                for (int n = 0; n < 2; ++n) acc[a][b][m][n] = (f32x4){0.f, 0.f, 0.f, 0.f};
    bf16x8 At[4][2], B0[2][2], B1[2][2];
    unsigned gC[2][2], gN[2][2];
    if constexpr (GATHER) { PG8_GATHER(cur, gC); } else { gC[0][0] = voffA[0]; gC[0][1] = voffA[1]; gC[1][0] = voffA[0]; gC[1][1] = voffA[1]; }
#pragma unroll
    for (int h = 0; h < 2; ++h) { gN[h][0] = gC[h][0]; gN[h][1] = gC[h][1]; }
    const char* cA = (const char*)g.A + (GATHER ? 0 : (size_t)cur.pm * tstep); const char* cB = (const char*)g.Bt + (size_t)cur.pn * tstep;
    static_assert(SP2, "only the SP2 loop is kept in this file");
    PG8_STAGE(PG8_SB(0, 0), cB, voffB); PG8_STAGE(PG8_SB(0, 1), cB + hstep, voffB); PG8_STAGE2(PG8_SA(0, 0), cA, gC[0][0], gC[0][1]); PG8_STAGE2(PG8_SA(0, 1), cA + hstepA, gC[1][0], gC[1][1]);
    if (wr == 1) PG8_BAR;
    PG8_WAIT_V(2); PG8_BAR;
    PG8_STAGE(PG8_SB(1, 0), cB + kstep, voffB); PG8_STAGE2(PG8_SA(1, 0), cA + kstep, gC[0][0], gC[0][1]); PG8_STAGE(PG8_SB(1, 1), cB + hstep + kstep, voffB);
    PG8_WAIT_V(6); PG8_BAR;
    for (;;) {
        const bool has_next = S.next(ui + 1, nxt);
        const char* nA = (has_next && !GATHER) ? (const char*)g.A + (size_t)nxt.pm * tstep : cA; const char* nB = has_next ? (const char*)g.Bt + (size_t)nxt.pn * tstep : cB;
        if constexpr (GATHER) { if (has_next) { PG8_GATHER(nxt, gN); } else {
#pragma unroll
            for (int h = 0; h < 2; ++h) { gN[h][0] = gC[h][0]; gN[h][1] = gC[h][1]; } } }
        for (int t = 0; t < nt; t += 2) {
            if constexpr (Epi::MID_T >= 0) { if (t == Epi::MID_T) { E.mid(acc, cur, wr, wc, fr, fq); PG8_SCHED; } }
            const bool last = (t == nt - 2);
            const char* a1 = cA + (size_t)(t + 1) * kstep;
            const char* a2 = last ? nA : cA + (size_t)(t + 2) * kstep; const char* b2 = last ? nB : cB + (size_t)(t + 2) * kstep;
            const char* a3 = a2 + kstep; const char* b3 = b2 + kstep;
            unsigned x00 = gC[0][0], x01 = gC[0][1], x10 = gC[1][0], x11 = gC[1][1];
            if constexpr (GATHER) { if (last) { x00 = gN[0][0]; x01 = gN[0][1]; x10 = gN[1][0]; x11 = gN[1][1]; } }
            PG8_LDB(B0, 0, 0); PG8_LDB(B1, 0, 1); PG8_SCHED; PG8_LDA(At, 0, 0); PG8_STAGE2(PG8_SA(1, 1), a1 + hstepA, gC[1][0], gC[1][1]);
            PG8_WAIT_V(8); PG8_WAIT_L(0); PG8_BAR; PG8_MMA(0, 0, At, B0); PG8_MMA(0, 1, At, B1); PG8_BAR; PG8_SCHED;
            PG8_LDA(At, 0, 1); PG8_STAGE(PG8_SB(0, 0), b2, voffB); PG8_STAGE(PG8_SB(0, 1), b2 + hstep, voffB); PG8_STAGE2(PG8_SA(0, 0), a2, x00, x01);
            PG8_WAIT_V(8); PG8_WAIT_L(0); PG8_BAR; PG8_MMA(1, 0, At, B0); PG8_MMA(1, 1, At, B1); PG8_BAR; PG8_SCHED;
            PG8_LDB(B0, 1, 0); PG8_LDB(B1, 1, 1); PG8_SCHED; PG8_LDA(At, 1, 0); PG8_STAGE2(PG8_SA(0, 1), a2 + hstepA, x10, x11);
            PG8_WAIT_V(8); PG8_WAIT_L(0); PG8_BAR; PG8_MMA(0, 0, At, B0); PG8_MMA(0, 1, At, B1); PG8_BAR; PG8_SCHED;
            PG8_LDA(At, 1, 1); PG8_STAGE(PG8_SB(1, 0), b3, voffB); PG8_STAGE(PG8_SB(1, 1), b3 + hstep, voffB); PG8_STAGE2(PG8_SA(1, 0), a3, x00, x01);
            PG8_WAIT_V(8); PG8_WAIT_L(0); PG8_BAR; PG8_MMA(1, 0, At, B0); PG8_MMA(1, 1, At, B1); PG8_BAR; PG8_SCHED;
        }
        if constexpr (ALIGN_EPI) { if (wr == 0) PG8_BAR; }
        E(acc, cur, wr, wc, fr, fq);
        if (!has_next) break;
#pragma unroll
        for (int a = 0; a < 2; ++a)
#pragma unroll
            for (int b = 0; b < 2; ++b)
#pragma unroll
                for (int m = 0; m < 4; ++m)
#pragma unroll
                    for (int n = 0; n < 2; ++n) acc[a][b][m][n] = (f32x4){0.f, 0.f, 0.f, 0.f};
        cur = nxt; cA = nA; cB = nB; ++ui;
#pragma unroll
        for (int h = 0; h < 2; ++h) { gC[h][0] = gN[h][0]; gC[h][1] = gN[h][1]; }
        if constexpr (ALIGN_EPI) { if (wr == 1) PG8_BAR; }
    }
    PG8_WAIT_V(0);
    if constexpr (!ALIGN_EPI) { if (wr == 0) PG8_BAR; }
    PG8_BAR;
#undef PG8_SA
#undef PG8_SB
#undef PG8_STAGE
#undef PG8_STAGE2
#undef PG8_LDA
#undef PG8_LDB
#undef PG8_MMA
#undef PG8_WAIT_V
#undef PG8_WAIT_L
#undef PG8_BAR
#undef PG8_SCHED
#undef PG8_GATHER
}
}

DI int opaque_tid() { int t = threadIdx.x; asm volatile("" : "+v"(t)); return t; }
#define XB_TMO      128
#define XB_XCNT(j)  (256  + 64 * (j))
#define XB_XSUB(j)  (1280 + 64 * (j))
#define XB_XGEN(j)  (2304 + 64 * (j))
#define XB_TOP      3328
#define XB_TOPGEN   3392
#define XCD_BAR_WORDS 3456
#define XB_SPIN_CAP (1u << 18)
__device__ __forceinline__ unsigned xb_ld(unsigned* p)              { return __hip_atomic_load(p, __ATOMIC_RELAXED, __HIP_MEMORY_SCOPE_AGENT); }
__device__ __forceinline__ unsigned xb_add(unsigned* p, unsigned v) { return __hip_atomic_fetch_add(p, v, __ATOMIC_RELAXED, __HIP_MEMORY_SCOPE_AGENT); }
__device__ __forceinline__ unsigned xb_xcc_id() { return (unsigned)__builtin_amdgcn_s_getreg((3 << 11) | 20) & 0xFu; }
#define XB_SPIN(cond, bar) do { unsigned _sp = 0; while (cond) { __builtin_amdgcn_s_sleep(1); \
    if ((++_sp & 255u) == 0u) { if (xb_ld(&(bar)[XB_TMO])) break; if (_sp > XB_SPIN_CAP) { atomicAdd(&(bar)[XB_TMO], 1u); break; } } } } while (0)
struct XcdBarrier { unsigned* bar; unsigned x; volatile LAS unsigned* st; };
__device__ __forceinline__ XcdBarrier xcd_barrier_post(unsigned* bar, volatile LAS unsigned* st) {
    XcdBarrier b; b.bar = bar; b.x = xb_xcc_id(); b.st = st;
    if (threadIdx.x == 0) (void)xb_add(&bar[XB_XCNT(b.x)], 1u);
    return b;
}
__device__ __forceinline__ void xcd_barrier_complete(unsigned* bar, unsigned x, unsigned& nloc, unsigned& nx) {
    const unsigned G = gridDim.x * gridDim.y * gridDim.z;
    unsigned sum, cnt, mine, sp = 0u;
    for (;;) {
        sum = 0u; cnt = 0u; mine = 0u;
#pragma unroll
        for (unsigned j = 0; j < 16; ++j) { const unsigned c = xb_ld(&bar[XB_XCNT(j)]); sum += c; cnt += (c > 0u) ? 1u : 0u; mine = (j == x) ? c : mine; }
        if (sum == G) break;
        __builtin_amdgcn_s_sleep(1);
        if ((++sp & 255u) == 0u) { if (xb_ld(&bar[XB_TMO])) break; if (sp > XB_SPIN_CAP) { atomicAdd(&bar[XB_TMO], 1u); break; } }
    }
    nloc = mine > 0u ? mine : 1u; nx = cnt > 0u ? cnt : 1u;
}
__device__ __forceinline__ void xcd_barrier(const XcdBarrier& b) {
    asm volatile("s_waitcnt vmcnt(0)" ::: "memory");
    __syncthreads();
    if (opaque_tid() == 0) {
        unsigned* bar = b.bar;
        __builtin_amdgcn_s_waitcnt(0);
        unsigned nloc = b.st[0], nx = b.st[1];
        if (nloc == 0u) { xcd_barrier_complete(bar, b.x, nloc, nx); b.st[0] = nloc; b.st[1] = nx; }
        const unsigned old = xb_add(&bar[XB_XSUB(b.x)], 1u);
        const unsigned gen = old / nloc;
        if (old + 1u == (gen + 1u) * nloc) {
            __builtin_amdgcn_fence(__ATOMIC_RELEASE, "agent");
            asm volatile("s_waitcnt vmcnt(0)" ::: "memory");
            const unsigned og = xb_add(&bar[XB_TOP], 1u);
            const unsigned tg = og / nx;
            if (og + 1u == (tg + 1u) * nx) xb_add(&bar[XB_TOPGEN], 1u);
            else XB_SPIN(xb_ld(&bar[XB_TOPGEN]) == tg, bar);
            __builtin_amdgcn_fence(__ATOMIC_ACQUIRE, "agent");
            xb_add(&bar[XB_XGEN(b.x)], 1u);
            asm volatile("s_waitcnt vmcnt(0)" ::: "memory");
        } else {
            XB_SPIN(xb_ld(&bar[XB_XGEN(b.x)]) == gen, bar);
            __builtin_amdgcn_fence(__ATOMIC_ACQUIRE, "agent");
            asm volatile("s_waitcnt vmcnt(0)" ::: "memory");
        }
    }
    __syncthreads();
}

struct Frame {
    LAS unsigned char* lds;
    int wave, vcu, G;
};
struct Args { const float* in[18]; float* out; unsigned char* ws; int ph_lo, ph_hi, li, pad; };
typedef const __attribute__((address_space(4))) Args* ArgsP;
DI ArgsP ka_ptr() { ArgsP p = (ArgsP)__builtin_amdgcn_kernarg_segment_ptr(); asm volatile("" : "+s"(p)); return p; }
DI float wave_sum(float v) {
#pragma unroll
    for (int o = 1; o < 64; o <<= 1) v += __shfl_xor(v, o);
    return v;
}
DI float wave_max(float v) {
#pragma unroll
    for (int o = 1; o < 64; o <<= 1) v = fmaxf(v, __shfl_xor(v, o));
    return v;
}

template <int MAP>
DI void cvt_item(const float* W, int N, int ldk, bf16_t* WT, const float* gain, LAS unsigned* scr, int kb, int nb, int lane) {
    const int nq = lane & 15, kr = lane >> 4, k0 = kb * 64, n0 = nb * 64;
    f32x4 v[8][2];
#pragma unroll
    for (int j = 0; j < 8; ++j)
#pragma unroll
        for (int e = 0; e < 2; ++e) v[j][e] = __builtin_nontemporal_load((const f32x4*)(W + (size_t)(k0 + 8 * j + 2 * kr + e) * N + n0 + 4 * nq));
    if (gain) {
#pragma unroll
        for (int j = 0; j < 8; ++j) { const float g0 = gain[k0 + 8 * j + 2 * kr], g1 = gain[k0 + 8 * j + 2 * kr + 1]; v[j][0] = v[j][0] * g0; v[j][1] = v[j][1] * g1; }
    }
#pragma unroll
    for (int j = 0; j < 8; ++j)
#pragma unroll
        for (int i = 0; i < 4; ++i) scr[(4 * nq + i) * 32 + ((j ^ (nq & 7)) << 2) + kr] = pk2(v[j][0][i], v[j][1][i]);
    LDS_WAIT(); asm volatile("" ::: "memory");
#pragma unroll
    for (int jj = 0; jj < 8; ++jj) {
        const int nl = (lane >> 3) + 8 * jj, c = lane & 7;
        const u32x4 o = *(const LAS u32x4*)(scr + nl * 32 + ((c ^ ((nl >> 2) & 7)) << 2));
        const int n = n0 + nl;
        const int row = (MAP == 0) ? n : ((n >> 2) * 8 + (MAP == 2 ? 4 : 0) + (n & 3));
        *(u32x4*)(WT + (size_t)row * ldk + k0 + 8 * c) = o;
    }
    LDS_WAIT(); asm volatile("" ::: "memory");
}

DI void p0_prologue(Frame& F, ArgsP A) {
    const int ftid = opaque_tid(), flane = ftid & 63;
    LAS unsigned* scr = (LAS unsigned*)(F.lds + F.wave * 8192);
    const int gw = F.vcu * NWAVES + F.wave, NGW = F.G * NWAVES;
    constexpr int I_IN = 32 * 264;
    for (int it = gw; it < I_IN; it += NGW) cvt_item<0>(A->in[2], INW, D, (bf16_t*)(A->ws + WS_WIN), nullptr, scr, it / 264, it % 264, flane);
    { bf16_t* WH = (bf16_t*)(A->ws + WS_WRT); bf16_t* WL = WH + 96 * D; const float* g2 = A->in[9]; const float* wrg = A->in[10]; const float* wre = A->in[12];
      for (int idx = F.vcu * NTHREADS + ftid; idx < 96 * D; idx += F.G * NTHREADS) {
          const int j = idx >> 11, k = idx & 2047;
          float w = 0.f; if (j < 8) w = wrg[k * 8 + j]; else if (j < 72) w = wre[k * 64 + (j - 8)];
          w *= g2[k];
          const unsigned hi = cvtpk_s(w, 0.f) & 0xffffu; const float rem = w - __builtin_bit_cast(float, hi << 16);
          WH[idx] = (bf16_t)hi; WL[idx] = (bf16_t)(cvtpk_s(rem, 0.f) & 0xffffu); } }
    const float* x = A->in[0]; const float* g1 = A->in[1]; bf16_t* H = (bf16_t*)(A->ws + WS_H);
    for (int row = gw; row < T; row += 2 * NGW) {
        const int row2 = row + NGW; const bool has2 = row2 < T;
        const f32x4* xr = (const f32x4*)(x + (size_t)row * D) + flane; const f32x4* xr2 = (const f32x4*)(x + (size_t)(has2 ? row2 : row) * D) + flane;
        f32x4 v[8], v2[8]; float ss = 0.f, ss2 = 0.f;
#pragma unroll
        for (int j = 0; j < 8; ++j) { v[j] = __builtin_nontemporal_load(xr + 64 * j); v2[j] = __builtin_nontemporal_load(xr2 + 64 * j); }
#pragma unroll
        for (int j = 0; j < 8; ++j) { ss += (v[j][0] * v[j][0] + v[j][1] * v[j][1]) + (v[j][2] * v[j][2] + v[j][3] * v[j][3]); ss2 += (v2[j][0] * v2[j][0] + v2[j][1] * v2[j][1]) + (v2[j][2] * v2[j][2] + v2[j][3] * v2[j][3]); }
        const float r = rsqrtf(wave_sum(ss) * (1.0f / D) + EPS), r2 = rsqrtf(wave_sum(ss2) * (1.0f / D) + EPS);
        u32x2* o = (u32x2*)(H + (size_t)row * D) + flane; u32x2* o2 = (u32x2*)(H + (size_t)row2 * D) + flane;
#pragma unroll
        for (int j = 0; j < 8; ++j) { const f32x4 g = ((const f32x4*)g1)[flane + 64 * j];
            u32x2 w; w.x = pk2(v[j][0] * r * g[0], v[j][1] * r * g[1]); w.y = pk2(v[j][2] * r * g[2], v[j][3] * r * g[3]); o[64 * j] = w;
            if (has2) { u32x2 w2; w2.x = pk2(v2[j][0] * r2 * g[0], v2[j][1] * r2 * g[1]); w2.y = pk2(v2[j][2] * r2 * g[2], v2[j][3] * r2 * g[3]); o2[64 * j] = w2; } }
    }
}

DI bf16_t* wgu_ptr(unsigned char* ws, int e) { return (bf16_t*)(ws + (e < GU_EARLY ? WS_WGU_E : WS_WGU)) + (size_t)e * 1024 * D; }
DI void p1_tail_convert(Frame& F, ArgsP A, int rank, int nranks) {
    const int ftid = opaque_tid(), flane = ftid & 63;
    LAS unsigned* scr = (LAS unsigned*)(F.lds + F.wave * 8192);
    const int gw = rank * NWAVES + F.wave, NGW = nranks * NWAVES;
    constexpr int I_A = 32 * 32, I_B = 8 * 32, I_O = 32 * 32, I_D = WD_EARLY * 256, I_GU = GU_EARLY * 512;
    for (int it = gw; it < I_A + I_B + I_O + I_D + I_GU; it += NGW) {
        int r = it;
        if (r < I_A) { cvt_item<0>(A->in[6], D, KCAT, (bf16_t*)(A->ws + WS_WCAT) + 512, nullptr, scr, r / 32, r % 32, flane); continue; } r -= I_A;
        if (r < I_B) { cvt_item<0>(A->in[7], D, KCAT, (bf16_t*)(A->ws + WS_WCAT), nullptr, scr, r / 32, r % 32, flane); continue; } r -= I_B;
        if (r < I_O) { cvt_item<0>(A->in[8], D, D, (bf16_t*)(A->ws + WS_WOUT), nullptr, scr, r / 32, r % 32, flane); continue; } r -= I_O;
        if (r < I_D) { const int e = r >> 8, rem = r & 255;
          cvt_item<0>(A->in[16] + (size_t)e * FF * D, D, FF, (bf16_t*)(A->ws + WS_WD) + (size_t)e * D * FF, nullptr, scr, rem >> 5, rem & 31, flane); continue; } r -= I_D;
        { const int e = r >> 9, up = (r >> 8) & 1, rem = r & 255;
          const float* W = (up ? A->in[15] : A->in[14]) + (size_t)e * D * FF;
          if (up) cvt_item<2>(W, FF, D, wgu_ptr(A->ws, e), A->in[9], scr, rem >> 3, rem & 7, flane); else cvt_item<1>(W, FF, D, wgu_ptr(A->ws, e), A->in[9], scr, rem >> 3, rem & 7, flane); }
    }
}
template <int NOSTORE> struct EpiProjT {
    static constexpr bool PERM = true; static constexpr int MID_T = -1;
    unsigned char* ws; const float* lbl;
    DI void operator()(const f32x4 (&acc)[2][2][4][2], const pg8::Unit& u, int wr, int wc, int fr, int fq) const {
        const int pn = u.pn, row0 = u.pm * 256 + wr * 64 + fr, cw = wc * 32 + 8 * fq;
        if (pn < 32 || pn >= 50) {
            size_t off; int tile, mode;
            if (pn < 8) { off = WS_QA; tile = pn; mode = 0; } else if (pn < 16) { off = WS_LF; tile = pn - 8; mode = 1; } else if (pn < 24) { off = WS_IA; tile = pn - 16; mode = 0; }
            else if (pn < 32) { off = WS_SG; tile = pn - 24; mode = 2; } else if (pn < 58) { off = WS_GA; tile = pn - 50; mode = 2; } else { off = WS_GB; tile = pn - 58; mode = 2; }
            bf16_t* base = (bf16_t*)(ws + off);
#pragma unroll
            for (int bj = 0; bj < 2; ++bj) {
                const int col = tile * 256 + bj * 128 + cw;
                float lb[8];
                if (mode == 1) {
#pragma unroll
                    for (int e = 0; e < 8; ++e) lb[e] = 1.0f / (1.0f + __expf(lbl[2048 + col + e] - lbl[col + e]));
                }
#pragma unroll
                for (int ai = 0; ai < 2; ++ai)
#pragma unroll
                    for (int m = 0; m < 4; ++m) {
                        const int row = row0 + ai * 128 + m * 16;
                        float v[8];
#pragma unroll
                        for (int e = 0; e < 4; ++e) { v[e] = acc[ai][bj][m][0][e]; v[4 + e] = acc[ai][bj][m][1][e]; }
                        if (mode == 1) {
#pragma unroll
                            for (int e = 0; e < 8; ++e) v[e] = __logf(lb[e] + (1.0f - lb[e]) * sigmoidf_(v[e]));
                        } else if (mode == 2) {
#pragma unroll
                            for (int e = 0; e < 8; ++e) v[e] = sigmoidf_(v[e]);
                        }
                        u32x4 w; w.x = pg8::cvt_pk_bf16(v[0], v[1]); w.y = pg8::cvt_pk_bf16(v[2], v[3]); w.z = pg8::cvt_pk_bf16(v[4], v[5]); w.w = pg8::cvt_pk_bf16(v[6], v[7]);
                        if (NOSTORE) asm volatile("" :: "v"(w)); else st16_stream(base + (size_t)row * D + col, w);
                    }
            }
        } else {
            const int a = pn - 32, kind = a / 6, ht = a - kind * 6;
#pragma unroll
            for (int bj = 0; bj < 2; ++bj) {
                const int head = ht * 2 + bj, sh = 2 * (head >> 2);
#pragma unroll
                for (int ai = 0; ai < 2; ++ai)
#pragma unroll
                    for (int m = 0; m < 4; ++m) {
                        const int row = row0 + ai * 128 + m * 16, b = row >> 11, s = row & 2047;
                        const int pos = ((s & ((1 << sh) - 1)) << (11 - sh)) + (s >> sh);
                        float v[8];
#pragma unroll
                        for (int e = 0; e < 4; ++e) { v[e] = acc[ai][bj][m][0][e]; v[4 + e] = acc[ai][bj][m][1][e]; }
                        if (kind < 2) {
                            const float sc = (kind == 0) ? 0.08838834764831845f : 1.0f;
                            u32x4 w; w.x = pg8::cvt_pk_bf16(v[0] * sc, v[1] * sc); w.y = pg8::cvt_pk_bf16(v[2] * sc, v[3] * sc); w.z = pg8::cvt_pk_bf16(v[4] * sc, v[5] * sc); w.w = pg8::cvt_pk_bf16(v[6] * sc, v[7] * sc);
                            bf16_t* base = (bf16_t*)(ws + (kind == 0 ? WS_QB : WS_KB));
                            const size_t o = ((size_t)((b * 12 + head) * 64 + (pos >> 5)) * 8 + (cw >> 4)) * 512 + (size_t)(((pos & 31) + 32 * ((cw >> 3) & 1)) * 8);
                            if (NOSTORE) asm volatile("" :: "v"(w)); else st16_stream(base + o, w);
                        } else {
                            const int kk = pos & 15, hh = (kk >> 2) & 1, j = 4 * (kk >> 3) + (kk & 3);
                            bf16_t* base = (bf16_t*)(ws + WS_VT) + ((((size_t)((b * 12 + head) * 64 + (pos >> 5)) * 2 + ((pos >> 4) & 1)) * 4 + (cw >> 5)) * 64 + (size_t)((cw & 31) + 32 * hh)) * 8 + j;
#pragma unroll
                            for (int e = 0; e < 8; ++e) { if (NOSTORE) asm volatile("" :: "v"(v[e])); else base[e * 8] = (bf16_t)f2bf(v[e]); }
                        }
                    }
            }
        }
    }
};

struct EpiPlainScratch {
    static constexpr bool PERM = true; static constexpr int MID_T = -1;
    bf16_t* base;
    DI void operator()(const f32x4 (&acc)[2][2][4][2], const pg8::Unit& u, int wr, int wc, int fr, int fq) const {
        const int row0 = (u.pm & 15) * 256 + wr * 64 + fr, col0 = (u.pn & 7) * 256 + wc * 32 + 8 * fq;
#pragma unroll
        for (int ai = 0; ai < 2; ++ai)
#pragma unroll
            for (int m = 0; m < 4; ++m)
#pragma unroll
                for (int bj = 0; bj < 2; ++bj) {
                    const f32x4 a0 = acc[ai][bj][m][0], a1 = acc[ai][bj][m][1];
                    u32x4 w; w.x = pg8::cvt_pk_bf16(a0[0], a0[1]); w.y = pg8::cvt_pk_bf16(a0[2], a0[3]); w.z = pg8::cvt_pk_bf16(a1[0], a1[1]); w.w = pg8::cvt_pk_bf16(a1[2], a1[3]);
                    *(u32x4*)(base + (size_t)(row0 + ai * 128 + m * 16) * D + col0 + bj * 128) = w;
                }
    }
};
struct EpiNull {
    static constexpr bool PERM = true; static constexpr int MID_T = -1;
    DI void operator()(const f32x4 (&acc)[2][2][4][2], const pg8::Unit& u, int wr, int wc, int fr, int fq) const {
#pragma unroll
        for (int ai = 0; ai < 2; ++ai)
#pragma unroll
            for (int bj = 0; bj < 2; ++bj)
#pragma unroll
                for (int m = 0; m < 4; ++m)
#pragma unroll
                    for (int n = 0; n < 2; ++n) asm volatile("" :: "v"(acc[ai][bj][m][n]));
    }
};
typedef EpiProjT<0> EpiProj;
DI void p2_hgrn_simple(Frame& F, ArgsP A) {
    const int ftid = opaque_tid(), flane = ftid & 63;
    LAS float* qs = (LAS float*)F.lds; LAS float* fs = qs + 16 * 128; LAS float* is = fs + 16 * 128; LAS float* red = is + 16 * 128;
    const bf16_t* QA = (const bf16_t*)(A->ws + WS_QA); const bf16_t* LF = (const bf16_t*)(A->ws + WS_LF); const bf16_t* IA = (const bf16_t*)(A->ws + WS_IA); bf16_t* OH = (bf16_t*)(A->ws + WS_OH);
    const int tid = ftid, v = tid & 127, kq = __builtin_amdgcn_readfirstlane(tid >> 7), lt = tid >> 5, c4 = tid & 31;
    for (int item = F.vcu; item < 128; item += F.G) {
        const int b = item >> 4, h = item & 15;
        float S[32];
#pragma unroll
        for (int k = 0; k < 32; ++k) S[k] = 0.f;
        for (int t0 = 0; t0 < SEQ; t0 += 16) {
            {
                const size_t g = ((size_t)(b * SEQ + t0 + lt)) * D + h * 128 + 4 * c4;
                const u32x2 q2 = *(const u32x2*)(QA + g), f2 = *(const u32x2*)(LF + g), i2 = *(const u32x2*)(IA + g);
                *(LAS f32x4*)(qs + lt * 128 + 4 * c4) = (f32x4){bflo(q2.x), bfhi(q2.x), bflo(q2.y), bfhi(q2.y)};
                *(LAS f32x4*)(fs + lt * 128 + 4 * c4) = (f32x4){__expf(bflo(f2.x)), __expf(bfhi(f2.x)), __expf(bflo(f2.y)), __expf(bfhi(f2.y))};
                *(LAS f32x4*)(is + lt * 128 + 4 * c4) = (f32x4){bflo(i2.x), bfhi(i2.x), bflo(i2.y), bfhi(i2.y)};
            }
            __syncthreads();
#pragma unroll 2
            for (int t = 0; t < 16; ++t) {
                const float iv = is[t * 128 + v]; float o = 0.f;
#pragma unroll
                for (int k4 = 0; k4 < 8; ++k4) {
                    const f32x4 f = *(const LAS f32x4*)(fs + t * 128 + kq * 32 + 4 * k4), q = *(const LAS f32x4*)(qs + t * 128 + kq * 32 + 4 * k4);
#pragma unroll
                    for (int e = 0; e < 4; ++e) { float s = S[4 * k4 + e]; s = iv + f[e] * (s - iv); S[4 * k4 + e] = s; o += s * q[e]; }
                }
                red[(kq * 16 + t) * 128 + v] = o;
            }
            __syncthreads();
            {
                f32x4 s = *(const LAS f32x4*)(red + (0 * 16 + lt) * 128 + 4 * c4);
#pragma unroll
                for (int q = 1; q < 4; ++q) s = s + *(const LAS f32x4*)(red + (q * 16 + lt) * 128 + 4 * c4);
                u32x2 w; w.x = pk2(s[0], s[1]); w.y = pk2(s[2], s[3]);
                *(u32x2*)(OH + ((size_t)(b * SEQ + t0 + lt)) * D + h * 128 + 4 * c4) = w;
            }
        }
        __syncthreads();
    }
}

DI int t5_bucket(int dist) {
    if (dist < 16) return dist;
    int b = 16;
    b += (dist >= 22); b += (dist >= 30); b += (dist >= 40); b += (dist >= 54); b += (dist >= 73); b += (dist >= 99); b += (dist >= 134); b += (dist >= 182);
    b += (dist >= 246); b += (dist >= 332); b += (dist >= 450); b += (dist >= 609); b += (dist >= 825); b += (dist >= 1117); b += (dist >= 1513);
    return b;
}
DI void p3_attn_simple(Frame& F, ArgsP A) {
    const int ftid = opaque_tid(), flane = ftid & 63;
    const bf16_t* QB = (const bf16_t*)(A->ws + WS_QB); const bf16_t* KB = (const bf16_t*)(A->ws + WS_KB); const bf16_t* VT = (const bf16_t*)(A->ws + WS_VT);
    bf16_t* OG = (bf16_t*)(A->ws + WS_OG); float* LSE = (float*)(A->ws + WS_LSE); const float* relb = A->in[5];
    LAS float* pb = (LAS float*)F.lds + F.wave * 320; LAS float* qf = pb + 192;
    const int gw = F.vcu * NWAVES + F.wave, NGW = F.G * NWAVES, lane = flane;
    for (int idx = gw; idx < NB * 12 * SEQ; idx += NGW) {
        const int pos = idx & 2047, bh = idx >> 11, head = bh % 12, b = bh / 12, g = head >> 2, sh = 2 * g;
        const int r = pos >> (11 - sh), l = pos & ((2048 >> sh) - 1), s = (l << sh) + r;
        { const unsigned qw = *(const unsigned*)(QB + (size_t)idx * 128 + 2 * lane); qf[2 * lane] = bflo(qw); qf[2 * lane + 1] = bfhi(qw); }
        LDS_WAIT(); asm volatile("" ::: "memory");
        float mx = -3.0e38f;
#pragma unroll 1
        for (int rr = 0; rr < 3; ++rr) {
            const int j = rr * 64 + lane; const bool valid = (j <= 128) && (j <= l);
            const bf16_t* kp = KB + (size_t)(valid ? idx - j : idx) * 128;
            float d = 0.f;
#pragma unroll
            for (int i = 0; i < 16; ++i) { const u32x4 k = *(const u32x4*)(kp + 8 * i); const f32x4 qa = *(const LAS f32x4*)(qf + 8 * i), qb = *(const LAS f32x4*)(qf + 8 * i + 4);
                d += qa[0] * bflo(k.x) + qa[1] * bfhi(k.x) + qa[2] * bflo(k.y) + qa[3] * bfhi(k.y)
                   + qb[0] * bflo(k.z) + qb[1] * bfhi(k.z) + qb[2] * bflo(k.w) + qb[3] * bfhi(k.w); }
            const float bias = relb[t5_bucket((valid ? j : 0) << sh) * 12 + head];
            const float lgv = valid ? d + bias : -3.0e38f;
            pb[rr * 64 + lane] = lgv;
            mx = fmaxf(mx, lgv);
        }
        mx = wave_max(mx);
        float den = 0.f;
#pragma unroll 1
        for (int rr = 0; rr < 3; ++rr) { const float lgv = pb[rr * 64 + lane]; const float p = (lgv > -1.0e38f) ? __expf(lgv - mx) : 0.f; den += p; pb[rr * 64 + lane] = p; }
        den = wave_sum(den);
        LDS_WAIT(); asm volatile("" ::: "memory");
        const int nk = (l < 128 ? l : 128) + 1;
        const bf16_t* v0 = VT + ((size_t)(b * 12 + head) * 128 + lane) * 2048 + pos;
        const bf16_t* v1 = v0 + (size_t)64 * 2048;
        float o0 = 0.f, o1 = 0.f;
        for (int j = 0; j < nk; ++j) { const float p = pb[j]; o0 += p * bf1(*(v0 - j)); o1 += p * bf1(*(v1 - j)); }
        const float inv = 1.0f / den;
        const size_t orow = (size_t)g * T + (size_t)b * SEQ + s;
        OG[orow * 512 + (head & 3) * 128 + lane] = (bf16_t)f2bf(o0 * inv);
        OG[orow * 512 + (head & 3) * 128 + 64 + lane] = (bf16_t)f2bf(o1 * inv);
        if (lane == 0) LSE[orow * 4 + (head & 3)] = mx + __logf(den);
        LDS_WAIT(); asm volatile("" ::: "memory");
    }
}

typedef float f32x16 __attribute__((ext_vector_type(16)));
DI int crow(int reg, int h) { return (reg & 3) + 8 * (reg >> 2) + 4 * h; }
DI bf16x8 pack_step(const f32x16& x, int s) {
    u32x4 p; p.x = cvtpk_s(x[8 * s], x[8 * s + 1]); p.y = cvtpk_s(x[8 * s + 2], x[8 * s + 3]); p.z = cvtpk_s(x[8 * s + 4], x[8 * s + 5]); p.w = cvtpk_s(x[8 * s + 6], x[8 * s + 7]);
    return __builtin_bit_cast(bf16x8, p);
}
#define MFMA32(a, b, c) __builtin_amdgcn_mfma_f32_32x32x16_bf16((a), (b), (c), 0, 0, 0)
DI void p3_attn_mfma(Frame& F, ArgsP A) {
    const int ftid = opaque_tid(), flane = ftid & 63;
    const bf16_t* QB = (const bf16_t*)(A->ws + WS_QB); const bf16_t* KB = (const bf16_t*)(A->ws + WS_KB); const bf16_t* VT = (const bf16_t*)(A->ws + WS_VT);
    bf16_t* OG = (bf16_t*)(A->ws + WS_OG); float* LSE = (float*)(A->ws + WS_LSE); const float* relb = A->in[5];
    LAS float* tb = (LAS float*)F.lds + F.wave * 256;
    const int gw = F.vcu * NWAVES + F.wave, NGW = F.G * NWAVES, lane = flane, r32 = lane & 31, h = lane >> 5;
    for (int u = gw; u < NB * 12 * 64; u += NGW) {
        const int bh = u >> 6, qt = u & 63, head = bh % 12, b = bh / 12, g = head >> 2, sh = 2 * g;
        const int pos0 = qt * 32, r = pos0 >> (11 - sh), l0 = pos0 & ((2048 >> sh) - 1), cbase = pos0 - l0;
        const int tlo = (l0 >= 128) ? 0 : (4 - (l0 >> 5));
        const long kt0 = (long)bh * 64 + ((cbase + l0 - 128) >> 5);
        const GAS char* kb_u = (const GAS char*)KB + kt0 * 8192; asm volatile("" : "+s"(kb_u));
        const GAS char* vb_u = (const GAS char*)VT + kt0 * 8192; asm volatile("" : "+s"(vb_u));
        unsigned voff = (unsigned)lane * 16u; asm volatile("" : "+v"(voff));
        bf16x8 qf[8], kf[2][8];
#define P3_LOADK(buf, t_) do { const GAS char* kp_ = kb_u + (long)(t_) * 8192; _Pragma("unroll") for (int st = 0; st < 8; ++st) kf[buf][st] = *(const GAS bf16x8*)(kp_ + 1024 * st + voff); } while (0)
        { const GAS char* qp = (const GAS char*)QB + (long)(bh * 64 + (pos0 >> 5)) * 8192; asm volatile("" : "+s"(qp));
#pragma unroll
          for (int st = 0; st < 8; ++st) qf[st] = *(const GAS bf16x8*)(qp + 1024 * st + voff); }
#pragma unroll
        for (int k = 0; k < 3; ++k) { const int j = lane + 64 * k; tb[32 + j] = (j <= 128) ? relb[t5_bucket(j << sh) * 12 + head] : 0.f; }
        if (lane < 32) tb[lane] = 0.f;
        LDS_WAIT(); asm volatile("" ::: "memory");
        f32x16 S[5];
        float mx = -3.0e38f;
        int rq = r32; asm volatile("" : "+v"(rq));
#pragma unroll
        for (int t = 0; t < 5; ++t) {
            if (t >= tlo) {
                P3_LOADK(t & 1, t);
                f32x16 acc;
#pragma unroll
                for (int i = 0; i < 16; ++i) acc[i] = tb[32 + (128 - 32 * t + rq - crow(i, h))];
                LDS_WAIT(); __builtin_amdgcn_sched_barrier(0);
#pragma unroll
                for (int st = 0; st < 8; ++st) acc = MFMA32(kf[t & 1][st], qf[st], acc);
                __builtin_amdgcn_sched_barrier(0);
#pragma unroll
                for (int i = 0; i < 16; ++i) {
                    const int key = crow(i, h);
                    const float v = acc[i];
                    const bool valid = (t == 0) ? (key >= rq) : ((t == 4) ? (key <= rq) : true);
                    S[t][i] = valid ? v : -3.0e38f; mx = fmaxf(mx, S[t][i]);
                }
            }
            __builtin_amdgcn_sched_barrier(0);
        }
#undef P3_LOADK
        u32x4 vf[2][4][2];
#define P3_LOADV(buf, t_) do { const GAS char* vp_ = vb_u + (long)(t_) * 8192; _Pragma("unroll") for (int s2 = 0; s2 < 2; ++s2) _Pragma("unroll") for (int db = 0; db < 4; ++db) vf[buf][db][s2] = *(const GAS u32x4*)(vp_ + (s2 * 4 + db) * 1024 + voff); } while (0)
        __builtin_amdgcn_sched_barrier(0);
        mx = fmaxf(mx, __shfl_xor(mx, 32));
        float den = 0.f;
#pragma unroll
        for (int t = 0; t < 5; ++t) {
            if (t >= tlo) {
#pragma unroll
                for (int i = 0; i < 16; ++i) { const float p = (S[t][i] > -1.0e38f) ? __expf(S[t][i] - mx) : 0.f; S[t][i] = p; den += p; }
            }
        }
        den += __shfl_xor(den, 32);
        const float inv = 1.0f / den;
        u32x4 Pp[5][2];
#pragma unroll
        for (int t = 0; t < 5; ++t) {
            if (t >= tlo) {
#pragma unroll
                for (int s2 = 0; s2 < 2; ++s2) {
                    Pp[t][s2].x = cvtpk_s(S[t][8 * s2] * inv, S[t][8 * s2 + 1] * inv); Pp[t][s2].y = cvtpk_s(S[t][8 * s2 + 2] * inv, S[t][8 * s2 + 3] * inv);
                    Pp[t][s2].z = cvtpk_s(S[t][8 * s2 + 4] * inv, S[t][8 * s2 + 5] * inv); Pp[t][s2].w = cvtpk_s(S[t][8 * s2 + 6] * inv, S[t][8 * s2 + 7] * inv);
                }
            }
        }
        __builtin_amdgcn_sched_barrier(0);
        f32x16 O[4];
#pragma unroll
        for (int db = 0; db < 4; ++db) {
#pragma unroll
            for (int i = 0; i < 16; ++i) O[db][i] = 0.f; }
#pragma unroll
        for (int t = 0; t < 5; ++t) {
            if (t >= tlo) {
                P3_LOADV(t & 1, t);
#pragma unroll
                for (int s2 = 0; s2 < 2; ++s2) {
                    const bf16x8 pa = __builtin_bit_cast(bf16x8, Pp[t][s2]);
#pragma unroll
                    for (int db = 0; db < 4; ++db) O[db] = MFMA32(pa, __builtin_bit_cast(bf16x8, vf[t & 1][db][s2]), O[db]);
                }
            }
            __builtin_amdgcn_sched_barrier(0);
        }
#undef P3_LOADV
        const size_t obase = (size_t)g * T + (size_t)b * SEQ;
        GAS bf16_t* og_u = (GAS bf16_t*)OG + obase * 512 + (head & 3) * 128; asm volatile("" : "+s"(og_u));
        int r32s = r32, hs = h; asm volatile("" : "+v"(r32s), "+v"(hs));
#pragma unroll
        for (int i = 0; i < 16; ++i) {
            const int l = l0 + crow(i, hs); const unsigned eo = (unsigned)(((l << sh) + r) * 512 + r32s);
#pragma unroll
            for (int db = 0; db < 4; ++db) og_u[eo + db * 32] = (bf16_t)f2bf(O[db][i]);
        }
        if (hs == 0) { const int tok = ((l0 + r32s) << sh) + r; LSE[(obase + tok) * 4 + (head & 3)] = mx + __logf(den); }
        LDS_WAIT(); asm volatile("" ::: "memory");
    }
}

constexpr int H_QI = 0, H_QS = 8704, H_KS = 17408, H_KU = 26112, H_VT = 36352, H_DEC = 41472, H_TOT = 41984, H_RED = 46080;
struct HRaw { unsigned q[4], f[4]; unsigned i[4]; };
DI void h_load(HRaw& R, const bf16_t* qp, const bf16_t* fp, const bf16_t* ip, int c) {
#pragma unroll
    for (int j = 0; j < 4; ++j) { const size_t ro = (size_t)(32 * c + j) * D; R.q[j] = *(const unsigned*)(qp + ro); R.f[j] = *(const unsigned*)(fp + ro); R.i[j] = ip[ro]; }
}
DI void h_totals(const HRaw& R, LAS unsigned char* lds, int tg, int k2) {
    float lo = 0.f, hi = 0.f;
#pragma unroll
    for (int j = 0; j < 4; ++j) { lo += bflo(R.f[j]); hi += bfhi(R.f[j]); }
    *(LAS f32x2_t*)(lds + H_TOT + (tg * 128 + 2 * k2) * 4) = (f32x2_t){lo, hi};
}
DI void h_prep(const HRaw& R, LAS unsigned char* lds, int tg, int k2, int v64) {
    float base0 = 0.f, base1 = 0.f, bm0 = 0.f, bm1 = 0.f, bl0 = 0.f, bl1 = 0.f;
#pragma unroll
    for (int g = 0; g < 8; ++g) { const f32x2_t tt = *(const LAS f32x2_t*)(lds + H_TOT + (g * 128 + 2 * k2) * 4);
        if (g < tg) { base0 += tt[0]; base1 += tt[1]; } if (g < 4) { bm0 += tt[0]; bm1 += tt[1]; } bl0 += tt[0]; bl1 += tt[1]; }
    const float ebm0 = __expf(bm0), ebm1 = __expf(bm1), elm0 = __expf(bl0 - bm0), elm1 = __expf(bl1 - bm1);
    float b0 = base0, b1 = base1; float ku0[4], ku1[4];
#pragma unroll
    for (int j = 0; j < 4; ++j) {
        const float lf0 = bflo(R.f[j]), lf1 = bfhi(R.f[j]), q0 = bflo(R.q[j]), q1 = bfhi(R.q[j]);
        b0 += lf0; b1 += lf1;
        const float e20 = __expf(b0 - bm0), e21 = __expf(b1 - bm1), e30 = __builtin_amdgcn_rcpf(e20), e31 = __builtin_amdgcn_rcpf(e21);
        const float kk0 = 1.0f - __expf(lf0), kk1 = 1.0f - __expf(lf1);
        const int t = 4 * tg + j;
        *(LAS unsigned*)(lds + H_QS + t * 272 + 4 * k2) = pk2(q0 * e20, q1 * e21);
        *(LAS unsigned*)(lds + H_QI + t * 272 + 4 * k2) = pk2(q0 * e20 * ebm0, q1 * e21 * ebm1);
        *(LAS unsigned*)(lds + H_KS + t * 272 + 4 * k2) = pk2(kk0 * e30, kk1 * e31);
        ku0[j] = kk0 * e30 * elm0; ku1[j] = kk1 * e31 * elm1;
    }
    { u32x2 w; w.x = pk2(ku0[0], ku0[1]); w.y = pk2(ku0[2], ku0[3]); *(LAS u32x2*)(lds + H_KU + (2 * k2) * 80 + 8 * tg) = w;
      w.x = pk2(ku1[0], ku1[1]); w.y = pk2(ku1[2], ku1[3]); *(LAS u32x2*)(lds + H_KU + (2 * k2 + 1) * 80 + 8 * tg) = w; }
    if (tg == 0) *(LAS f32x2_t*)(lds + H_DEC + 8 * k2) = (f32x2_t){__expf(bl0), __expf(bl1)};
    { u32x2 w; w.x = (R.i[0] & 0xffffu) | (R.i[1] << 16); w.y = (R.i[2] & 0xffffu) | (R.i[3] << 16); *(LAS u32x2*)(lds + H_VT + v64 * 80 + 8 * tg) = w; }
}
DI void h_mma(f32x16& S, LAS unsigned char* lds, int kb, int vb, int r32, int hh) {
    f32x16 X, O;
    int rq = r32; asm volatile("" : "+v"(rq));
    bf16x8 ka[2], qb[2], ku[2], vt[2]; u32x4 vv[2], qq[2]; f32x4 dec[4];
#pragma unroll
    for (int st = 0; st < 2; ++st) {
        ka[st] = *(const LAS bf16x8*)(lds + H_KS + r32 * 272 + (kb * 32 + 16 * st + 8 * hh) * 2);
        qb[st] = *(const LAS bf16x8*)(lds + H_QS + r32 * 272 + (kb * 32 + 16 * st + 8 * hh) * 2);
        ku[st] = *(const LAS bf16x8*)(lds + H_KU + (kb * 32 + r32) * 80 + (16 * st + 8 * hh) * 2);
        vt[st] = *(const LAS bf16x8*)(lds + H_VT + (vb * 32 + r32) * 80 + (16 * st + 8 * hh) * 2);
    }
#pragma unroll
    for (int s2 = 0; s2 < 2; ++s2) {
        const LAS unsigned char* vp = lds + H_VT + (vb * 32 + r32) * 80 + (16 * s2 + 4 * hh) * 2;
        const u32x2 v0 = *(const LAS u32x2*)vp, v1 = *(const LAS u32x2*)(vp + 16);
        vv[s2].x = v0.x; vv[s2].y = v0.y; vv[s2].z = v1.x; vv[s2].w = v1.y;
        const LAS unsigned char* qp = lds + H_QI + r32 * 272 + (kb * 32 + 16 * s2 + 4 * hh) * 2;
        const u32x2 q0 = *(const LAS u32x2*)qp, q1 = *(const LAS u32x2*)(qp + 16);
        qq[s2].x = q0.x; qq[s2].y = q0.y; qq[s2].z = q1.x; qq[s2].w = q1.y;
    }
#pragma unroll
    for (int g = 0; g < 4; ++g) dec[g] = *(const LAS f32x4*)(lds + H_DEC + (kb * 32 + 8 * g + 4 * hh) * 4);
#pragma unroll
    for (int i = 0; i < 16; ++i) { X[i] = 0.f; O[i] = 0.f; }
    LDS_WAIT(); __builtin_amdgcn_sched_barrier(0);
#pragma unroll
    for (int st = 0; st < 2; ++st) X = MFMA32(ka[st], qb[st], X);
#pragma unroll
    for (int i = 0; i < 16; ++i) X[i] = (crow(i, hh) <= rq) ? X[i] : 0.f;
    const bf16x8 sp0 = pack_step(S, 0), sp1 = pack_step(S, 1);
    O = MFMA32(pack_step(X, 0), __builtin_bit_cast(bf16x8, vv[0]), O);
    O = MFMA32(__builtin_bit_cast(bf16x8, qq[0]), sp0, O);
    O = MFMA32(pack_step(X, 1), __builtin_bit_cast(bf16x8, vv[1]), O);
    O = MFMA32(__builtin_bit_cast(bf16x8, qq[1]), sp1, O);
#pragma unroll
    for (int g = 0; g < 4; ++g) {
#pragma unroll
        for (int e = 0; e < 4; ++e) S[4 * g + e] *= dec[g][e]; }
#pragma unroll
    for (int st = 0; st < 2; ++st) S = MFMA32(ku[st], vt[st], S);
    __builtin_amdgcn_sched_barrier(0);
#pragma unroll
    for (int i = 0; i < 16; ++i) *(LAS float*)(lds + H_RED + ((kb * 32 + crow(i, hh)) * 64 + vb * 32 + r32) * 4) = O[i];
    { float s_ = S[15]; asm volatile("v_mov_b32 %0, %0" : "+v"(s_)); asm volatile("" :: "v"(s_)); }
    asm volatile("" :: "v"(ka[0]), "v"(ka[1]), "v"(qb[0]), "v"(qb[1]), "v"(ku[0]), "v"(ku[1]), "v"(vt[0]), "v"(vt[1]));
    asm volatile("" :: "v"(vv[0]), "v"(vv[1]), "v"(qq[0]), "v"(qq[1]), "v"(sp0), "v"(sp1));
}
DI void h_reduce_store(LAS unsigned char* lds, bf16_t* op, int c, int tid) {
    const int t = tid >> 4, c4 = tid & 15;
    f32x4 s = *(const LAS f32x4*)(lds + H_RED + ((0 * 32 + t) * 64 + 4 * c4) * 4);
#pragma unroll
    for (int q = 1; q < 4; ++q) s = s + *(const LAS f32x4*)(lds + H_RED + ((q * 32 + t) * 64 + 4 * c4) * 4);
    u32x2 w; w.x = pk2(s[0], s[1]); w.y = pk2(s[2], s[3]);
    *(u32x2*)(op + (size_t)(32 * c + t) * D + 4 * c4) = w;
}
template <int PV>
DI void p2_hgrn_mfma(Frame& F, ArgsP A) {
    const int ftid = opaque_tid(), flane = ftid & 63;
    const bf16_t* QA = (const bf16_t*)(A->ws + WS_QA); const bf16_t* LF = (const bf16_t*)(A->ws + WS_LF); const bf16_t* IA = (const bf16_t*)(A->ws + WS_IA); bf16_t* OH = (bf16_t*)(A->ws + (PV ? WS_YCAT : WS_OH));
    LAS unsigned char* lds = F.lds;
    const int tid = ftid, k2 = tid & 63, tg = F.wave, v64 = tid & 63, r32 = flane & 31, hh = flane >> 5, kb = F.wave >> 1, vb = F.wave & 1;
    for (int item = F.vcu; item < 256; item += F.G) {
        const int bh = item >> 1, vhalf = item & 1, b = bh >> 4, h = bh & 15;
        const size_t rb = (size_t)b * SEQ * D;
        const bf16_t* qp = QA + rb + (size_t)(4 * tg) * D + h * 128 + 2 * k2;
        const bf16_t* fp = LF + rb + (size_t)(4 * tg) * D + h * 128 + 2 * k2;
        const bf16_t* ip = IA + rb + (size_t)(4 * tg) * D + h * 128 + vhalf * 64 + v64;
        bf16_t* op = OH + rb + h * 128 + vhalf * 64;
        f32x16 S;
#pragma unroll
        for (int i = 0; i < 16; ++i) S[i] = 0.f;
        HRaw R0, R1, R2, R3;
#define HL(R, c) do { if (PV != 2) h_load(R, qp, fp, ip, c); } while (0)
#define HP(R) do { if (PV != 3) h_prep(R, lds, tg, k2, v64); } while (0)
#define HM() do { if (PV != 4) h_mma(S, lds, kb, vb, r32, hh); } while (0)
#define HSTEP(cc, RF, RN) do { if ((cc) + 4 < 64) HL(RF, (cc) + 4); HM(); if ((cc) + 1 < 64) h_totals(RN, lds, tg, k2); __syncthreads(); \
        h_reduce_store(lds, op, (cc), tid); if ((cc) + 1 < 64) HP(RN); __syncthreads(); } while (0)
        h_load(R0, qp, fp, ip, 0); h_load(R1, qp, fp, ip, 1); h_load(R2, qp, fp, ip, 2); h_load(R3, qp, fp, ip, 3);
        h_totals(R0, lds, tg, k2);
        __syncthreads();
        h_prep(R0, lds, tg, k2, v64);
        __syncthreads();
        for (int c = 0; c < 64; c += 4) { HSTEP(c, R0, R1); HSTEP(c + 1, R1, R2); HSTEP(c + 2, R2, R3); HSTEP(c + 3, R3, R0); }
#undef HSTEP
#undef HL
#undef HP
#undef HM
    }
}

struct P4Row { u32x4 o[4], sg[4], x0, x1, x2; float l0, l1, l2; };
DI void p4_load(P4Row& R, const bf16_t* OH, const bf16_t* SG, const bf16_t* OG, const float* LSE, int row, int lane) {
#pragma unroll
    for (int j = 0; j < 4; ++j) { const int c0 = 512 * j + 8 * lane; R.o[j] = *(const u32x4*)(OH + (size_t)row * D + c0); R.sg[j] = *(const u32x4*)(SG + (size_t)row * D + c0); }
    const int c0 = 8 * lane, hs = lane >> 4;
    R.l0 = LSE[((size_t)0 * T + row) * 4 + hs]; R.l1 = LSE[((size_t)1 * T + row) * 4 + hs]; R.l2 = LSE[((size_t)2 * T + row) * 4 + hs];
    R.x0 = *(const u32x4*)(OG + ((size_t)0 * T + row) * 512 + c0); R.x1 = *(const u32x4*)(OG + ((size_t)1 * T + row) * 512 + c0); R.x2 = *(const u32x4*)(OG + ((size_t)2 * T + row) * 512 + c0);
}
DI void p4_store(const P4Row& R, const float* hg, bf16_t* YC, int row, int lane) {
#pragma unroll
    for (int j = 0; j < 4; ++j) {
        const int c0 = 512 * j + 8 * lane; const u32x4 o = R.o[j], sg = R.sg[j];
        float v[8] = {bflo(o.x), bfhi(o.x), bflo(o.y), bfhi(o.y), bflo(o.z), bfhi(o.z), bflo(o.w), bfhi(o.w)};
        const float s[8] = {bflo(sg.x), bfhi(sg.x), bflo(sg.y), bfhi(sg.y), bflo(sg.z), bfhi(sg.z), bflo(sg.w), bfhi(sg.w)};
        float ss = 0.f;
#pragma unroll
        for (int e = 0; e < 8; ++e) ss += v[e] * v[e];
        ss += __shfl_xor(ss, 1); ss += __shfl_xor(ss, 2); ss += __shfl_xor(ss, 4); ss += __shfl_xor(ss, 8);
        const float rinv = rsqrtf(ss * (1.0f / 128.0f) + EPS);
        const f32x4 g0 = *(const f32x4*)(hg + c0), g1 = *(const f32x4*)(hg + c0 + 4);
#pragma unroll
        for (int e = 0; e < 4; ++e) { v[e] = v[e] * rinv * g0[e] * s[e]; v[4 + e] = v[4 + e] * rinv * g1[e] * s[4 + e]; }
        u32x4 w; w.x = pk2(v[0], v[1]); w.y = pk2(v[2], v[3]); w.z = pk2(v[4], v[5]); w.w = pk2(v[6], v[7]);
        *(u32x4*)(YC + (size_t)row * KCAT + 512 + c0) = w;
    }
    {
        const int c0 = 8 * lane; const float l0 = R.l0, l1 = R.l1, l2 = R.l2; const u32x4 x0 = R.x0, x1 = R.x1, x2 = R.x2;
        const float mx = fmaxf(l0, fmaxf(l1, l2)); float a0 = __expf(l0 - mx), a1 = __expf(l1 - mx), a2 = __expf(l2 - mx);
        const float inv = 1.0f / (a0 + a1 + a2); a0 *= inv; a1 *= inv; a2 *= inv;
        u32x4 w;
        w.x = pk2(a0 * bflo(x0.x) + a1 * bflo(x1.x) + a2 * bflo(x2.x), a0 * bfhi(x0.x) + a1 * bfhi(x1.x) + a2 * bfhi(x2.x));
        w.y = pk2(a0 * bflo(x0.y) + a1 * bflo(x1.y) + a2 * bflo(x2.y), a0 * bfhi(x0.y) + a1 * bfhi(x1.y) + a2 * bfhi(x2.y));
        w.z = pk2(a0 * bflo(x0.z) + a1 * bflo(x1.z) + a2 * bflo(x2.z), a0 * bfhi(x0.z) + a1 * bfhi(x1.z) + a2 * bfhi(x2.z));
        w.w = pk2(a0 * bflo(x0.w) + a1 * bflo(x1.w) + a2 * bflo(x2.w), a0 * bfhi(x0.w) + a1 * bfhi(x1.w) + a2 * bfhi(x2.w));
        *(u32x4*)(YC + (size_t)row * KCAT + c0) = w;
    }
}
DI void p4_fixups(Frame& F, ArgsP A) {
    const int ftid = opaque_tid(), flane = ftid & 63;
    const bf16_t* OH = (const bf16_t*)(A->ws + WS_OH); const bf16_t* SG = (const bf16_t*)(A->ws + WS_SG); const float* hg = A->in[4];
    const bf16_t* OG = (const bf16_t*)(A->ws + WS_OG); const float* LSE = (const float*)(A->ws + WS_LSE);
    bf16_t* YC = (bf16_t*)(A->ws + WS_YCAT);
    const int gw = F.vcu * NWAVES + F.wave, NGW = F.G * NWAVES, lane = flane;
    for (int row = gw; row < T; row += 2 * NGW) {
        const int row2 = row + NGW; const bool has2 = row2 < T;
        P4Row Ra, Rb;
        p4_load(Ra, OH, SG, OG, LSE, row, lane);
        if (has2) p4_load(Rb, OH, SG, OG, LSE, row2, lane);
        p4_store(Ra, hg, YC, row, lane);
        if (has2) p4_store(Rb, hg, YC, row2, lane);
    }
}

struct EpiGateCat {
    static constexpr bool PERM = true; static constexpr int MID_T = 8;
    const bf16_t* ga; const bf16_t* gb; bf16_t* outp;
    DI void mid(f32x4 (&acc)[2][2][4][2], const pg8::Unit& u, int wr, int wc, int fr, int fq) const {
        int fr_ = fr, fq_ = fq; asm volatile("" : "+v"(fr_), "+v"(fq_));
        const int row0 = u.pm * 256 + wr * 64 + fr_, col0 = u.pn * 256 + wc * 32 + 8 * fq_;
#pragma unroll
        for (int ai = 0; ai < 2; ++ai)
#pragma unroll
            for (int m = 0; m < 4; ++m)
#pragma unroll
                for (int bj = 0; bj < 2; ++bj) {
                    const size_t o = (size_t)(row0 + ai * 128 + m * 16) * D + col0 + bj * 128;
                    const u32x4 a = *(const u32x4*)(ga + o), b = *(const u32x4*)(gb + o);
                    f32x4 r0, r1;
                    r0[0] = bflo(b.x) * __builtin_amdgcn_rcpf(bflo(a.x)); r0[1] = bfhi(b.x) * __builtin_amdgcn_rcpf(bfhi(a.x)); r0[2] = bflo(b.y) * __builtin_amdgcn_rcpf(bflo(a.y)); r0[3] = bfhi(b.y) * __builtin_amdgcn_rcpf(bfhi(a.y));
                    r1[0] = bflo(b.z) * __builtin_amdgcn_rcpf(bflo(a.z)); r1[1] = bfhi(b.z) * __builtin_amdgcn_rcpf(bfhi(a.z)); r1[2] = bflo(b.w) * __builtin_amdgcn_rcpf(bflo(a.w)); r1[3] = bfhi(b.w) * __builtin_amdgcn_rcpf(bfhi(a.w));
                    acc[ai][bj][m][0] = acc[ai][bj][m][0] * r0; acc[ai][bj][m][1] = acc[ai][bj][m][1] * r1;
                    if (bj == 1) asm volatile("" ::: "memory");
                }
    }
    DI void operator()(const f32x4 (&acc)[2][2][4][2], const pg8::Unit& u, int wr, int wc, int fr, int fq) const {
        const int row0 = u.pm * 256 + wr * 64 + fr, col0 = u.pn * 256 + wc * 32 + 8 * fq;
#pragma unroll
        for (int ai = 0; ai < 2; ++ai)
#pragma unroll
            for (int m = 0; m < 4; ++m)
#pragma unroll
                for (int bj = 0; bj < 2; ++bj) {
                    const size_t o = (size_t)(row0 + ai * 128 + m * 16) * D + col0 + bj * 128;
                    const u32x4 gt = *(const u32x4*)(ga + o);
                    float v[8];
#pragma unroll
                    for (int e = 0; e < 4; ++e) { v[e] = acc[ai][bj][m][0][e]; v[4 + e] = acc[ai][bj][m][1][e]; }
                    v[0] *= bflo(gt.x); v[1] *= bfhi(gt.x); v[2] *= bflo(gt.y); v[3] *= bfhi(gt.y); v[4] *= bflo(gt.z); v[5] *= bfhi(gt.z); v[6] *= bflo(gt.w); v[7] *= bfhi(gt.w);
                    u32x4 w; w.x = pg8::cvt_pk_bf16(v[0], v[1]); w.y = pg8::cvt_pk_bf16(v[2], v[3]); w.z = pg8::cvt_pk_bf16(v[4], v[5]); w.w = pg8::cvt_pk_bf16(v[6], v[7]);
                    *(u32x4*)(outp + o) = w;
                }
    }
};
struct EpiOut {
    static constexpr bool PERM = true; static constexpr int MID_T = -1;
    const float* x; float* x1; bf16_t* x1b;
    DI void operator()(const f32x4 (&acc)[2][2][4][2], const pg8::Unit& u, int wr, int wc, int fr, int fq) const {
        const int row0 = u.pm * 256 + wr * 64 + fr, col0 = u.pn * 256 + wc * 32 + 8 * fq;
#pragma unroll
        for (int ai = 0; ai < 2; ++ai)
#pragma unroll
            for (int m = 0; m < 4; ++m)
#pragma unroll
                for (int bj = 0; bj < 2; ++bj) {
                    const size_t o = (size_t)(row0 + ai * 128 + m * 16) * D + col0 + bj * 128;
                    const f32x4 a0 = *(const f32x4*)(x + o) + acc[ai][bj][m][0], a1 = *(const f32x4*)(x + o + 4) + acc[ai][bj][m][1];
                    u32x4 w; w.x = pg8::cvt_pk_bf16(a0[0], a0[1]); w.y = pg8::cvt_pk_bf16(a0[2], a0[3]); w.z = pg8::cvt_pk_bf16(a1[0], a1[1]); w.w = pg8::cvt_pk_bf16(a1[2], a1[3]);
                    *(u32x4*)(x1b + o) = w;
                }
    }
};

template <int DUP>
DI void p7_router(Frame& F, ArgsP A) {
    const int ftid = opaque_tid(), flane = ftid & 63;
    const bf16_t* X1B = (const bf16_t*)(A->ws + WS_X1B); const float* brg = A->in[11]; const float* bre = A->in[13];
    const bf16_t* WH = (const bf16_t*)(A->ws + WS_WRT); const bf16_t* WL = WH + 96 * D;
    const size_t dofs = DUP ? (WS_YCAT - WS_EID) : 0;
    int* EID = (int*)(A->ws + WS_EID + dofs); float* GWT = (float*)(A->ws + WS_GWT + dofs); float* R2 = (float*)(A->ws + WS_R2 + dofs);
    unsigned* cnt = (unsigned*)(A->ws + WS_CTL) + CW_CNT + (DUP ? 128 : 0);
    int* rowtok = (int*)(A->ws + WS_ROWTOK + dofs); int* rowdst = (int*)(A->ws + WS_ROWDST + dofs);
    const int gw = F.vcu * NWAVES + F.wave, NGW = F.G * NWAVES, lane = flane, r32 = lane & 31, h = lane >> 5;
    for (int p = F.vcu * NTHREADS + ftid; p < PMAX; p += F.G * NTHREADS) { rowtok[p] = 0; rowdst[p] = -1; }
    LAS float* LG = (LAS float*)(F.lds) + F.wave * (32 * 100);
    LAS float* SS = (LAS float*)(F.lds) + 8 * (32 * 100) + F.wave * 32;
    const int tile = F.wave >> 2, kq = F.wave & 3;
    for (int pair = F.vcu; pair < T / 64; pair += F.G) {
        const int tok0 = (pair * 2 + tile) * 32;
        const bf16_t* xp = X1B + (size_t)(tok0 + r32) * D + 8 * h + 512 * kq;
        const bf16_t* wh = WH + (size_t)r32 * D + 8 * h + 512 * kq; const bf16_t* wl = WL + (size_t)r32 * D + 8 * h + 512 * kq;
        f32x16 acc0, acc1, acc2;
#pragma unroll
        for (int i = 0; i < 16; ++i) { acc0[i] = 0.f; acc1[i] = 0.f; acc2[i] = 0.f; }
        float ss = 0.f;
#pragma unroll 8
        for (int st = 0; st < 32; ++st) {
            const bf16x8 xb = *(const bf16x8*)(xp + 16 * st);
            const bf16x8 h0 = *(const bf16x8*)(wh + 16 * st), h1 = *(const bf16x8*)(wh + 32 * D + 16 * st), h2 = *(const bf16x8*)(wh + 64 * D + 16 * st);
            const bf16x8 l0 = *(const bf16x8*)(wl + 16 * st), l1 = *(const bf16x8*)(wl + 32 * D + 16 * st), l2 = *(const bf16x8*)(wl + 64 * D + 16 * st);
            acc0 = MFMA32(h0, xb, acc0); acc1 = MFMA32(h1, xb, acc1); acc2 = MFMA32(h2, xb, acc2);
            acc0 = MFMA32(l0, xb, acc0); acc1 = MFMA32(l1, xb, acc1); acc2 = MFMA32(l2, xb, acc2);
            const u32x4 xw = __builtin_bit_cast(u32x4, xb);
            const float t0 = bflo(xw.x), t1 = bfhi(xw.x), t2 = bflo(xw.y), t3 = bfhi(xw.y), t4 = bflo(xw.z), t5 = bfhi(xw.z), t6 = bflo(xw.w), t7 = bfhi(xw.w);
            ss += (t0 * t0 + t1 * t1) + (t2 * t2 + t3 * t3) + (t4 * t4 + t5 * t5) + (t6 * t6 + t7 * t7);
        }
        ss += __shfl_xor(ss, 32);
#pragma unroll
        for (int i = 0; i < 16; ++i) { LG[r32 * 100 + crow(i, h)] = acc0[i]; LG[r32 * 100 + 32 + crow(i, h)] = acc1[i]; LG[r32 * 100 + 64 + crow(i, h)] = acc2[i]; }
        if (h == 0) SS[r32] = ss;
        __syncthreads();
        if (ftid < 64) {
            const int tl = ftid >> 5, tk = ftid & 31;
            const LAS float* lg = (const LAS float*)(F.lds) + (tl * 4) * (32 * 100) + tk * 100;
            const LAS float* sp = (const LAS float*)(F.lds) + 8 * (32 * 100) + (tl * 4) * 32 + tk;
            const float r = rsqrtf((sp[0] + sp[32] + sp[64] + sp[96]) * (1.0f / D) + EPS);
            float a[8]; int gsel = 0; float gmax = -3.0e38f;
#pragma unroll
            for (int e = 0; e < 8; ++e) { a[e] = (lg[e] + lg[3200 + e] + lg[6400 + e] + lg[9600 + e]) * r + brg[e]; if (a[e] > gmax) { gmax = a[e]; gsel = e; } }
            float gden = 0.f;
#pragma unroll
            for (int e = 0; e < 8; ++e) gden += __expf(a[e] - gmax);
            const float pg = 1.0f / gden;
            int i1 = 0; float v1 = -3.0e38f;
#pragma unroll
            for (int e = 0; e < 8; ++e) { const int c = 8 + gsel * 8 + e; a[e] = (lg[c] + lg[3200 + c] + lg[6400 + c] + lg[9600 + c]) * r + bre[gsel * 8 + e]; if (a[e] > v1) { v1 = a[e]; i1 = e; } }
            int i2 = 0; float v2 = -3.0e38f;
#pragma unroll
            for (int e = 0; e < 8; ++e) { if (e != i1 && a[e] > v2) { v2 = a[e]; i2 = e; } }
            const float e2 = __expf(v2 - v1), p1 = 1.0f / (1.0f + e2), p2 = e2 * p1;
            const int row = (pair * 2 + tl) * 32 + tk, ea = gsel * 8 + i1, eb = gsel * 8 + i2;
            EID[row * 2] = ea; EID[row * 2 + 1] = eb; GWT[row * 2] = pg * p1; GWT[row * 2 + 1] = pg * p2; R2[row] = r;
            atomicAdd(&cnt[ea], 1u); atomicAdd(&cnt[eb], 1u);
        }
        __syncthreads();
    }
}
DI void p7_convert(Frame& F, ArgsP A) {
    const int ftid = opaque_tid(), flane = ftid & 63; const int lane = flane; const float* g2 = A->in[9];
    const int gw = F.vcu * NWAVES + F.wave, NGW = F.G * NWAVES;
    LAS unsigned* scr = (LAS unsigned*)(F.lds + F.wave * 8192);
    constexpr int I_G = (NE - GU_EARLY) * 32 * 8, I_D = 0;
    for (int it = gw; it < 2 * I_G + I_D; it += NGW) {
        int r_ = it;
        if (r_ < 2 * I_G) { const int up = r_ >= I_G; if (up) r_ -= I_G; const int e = GU_EARLY + (r_ >> 8), rem = r_ & 255;
            const float* W = (up ? A->in[15] : A->in[14]) + (size_t)e * D * FF; bf16_t* WT = wgu_ptr(A->ws, e);
            if (up) cvt_item<2>(W, FF, D, WT, g2, scr, rem >> 3, rem & 7, lane); else cvt_item<1>(W, FF, D, WT, g2, scr, rem >> 3, rem & 7, lane);
            continue; }
        r_ -= 2 * I_G; { const int e = WD_EARLY + (r_ >> 8), rem = r_ & 255;
            cvt_item<0>(A->in[16] + (size_t)e * FF * D, D, FF, (bf16_t*)(A->ws + WS_WD) + (size_t)e * D * FF, nullptr, scr, rem >> 5, rem & 31, lane); }
    }
}

DI void p7_roles(Frame& F, ArgsP A) {
    const int ftid = opaque_tid(), flane = ftid & 63;
    const int lane = flane, r32 = lane & 31, h = lane >> 5;
    { int* rowtok = (int*)(A->ws + WS_ROWTOK); int* rowdst = (int*)(A->ws + WS_ROWDST);
      for (int p = F.vcu * NTHREADS + ftid; p < PMAX; p += F.G * NTHREADS) { rowtok[p] = 0; rowdst[p] = -1; } }
    if (F.wave < 2) {
        const bf16_t* X1B = (const bf16_t*)(A->ws + WS_X1B); const float* brg = A->in[11]; const float* bre = A->in[13];
        const bf16_t* WH = (const bf16_t*)(A->ws + WS_WRT); const bf16_t* WL = WH + 96 * D;
        int* EID = (int*)(A->ws + WS_EID); float* GWT = (float*)(A->ws + WS_GWT); float* R2 = (float*)(A->ws + WS_R2);
        unsigned* cnt = (unsigned*)(A->ws + WS_CTL) + CW_CNT;
        LAS float* LG = (LAS float*)(F.lds + 65536) + F.wave * (32 * 100);
        for (int item = F.vcu * 2 + F.wave; item < T / 32; item += F.G * 2) {
            const int tok0 = item * 32;
            const bf16_t* xp = X1B + (size_t)(tok0 + r32) * D + 8 * h;
            const bf16_t* wh = WH + (size_t)r32 * D + 8 * h; const bf16_t* wl = WL + (size_t)r32 * D + 8 * h;
            f32x16 acc0, acc1, acc2;
#pragma unroll
            for (int i = 0; i < 16; ++i) { acc0[i] = 0.f; acc1[i] = 0.f; acc2[i] = 0.f; }
            float ss = 0.f;
#pragma unroll 8
            for (int st = 0; st < 128; ++st) {
                const bf16x8 xb = *(const bf16x8*)(xp + 16 * st);
                const bf16x8 h0 = *(const bf16x8*)(wh + 16 * st), h1 = *(const bf16x8*)(wh + 32 * D + 16 * st), h2 = *(const bf16x8*)(wh + 64 * D + 16 * st);
                const bf16x8 l0 = *(const bf16x8*)(wl + 16 * st), l1 = *(const bf16x8*)(wl + 32 * D + 16 * st), l2 = *(const bf16x8*)(wl + 64 * D + 16 * st);
                acc0 = MFMA32(h0, xb, acc0); acc1 = MFMA32(h1, xb, acc1); acc2 = MFMA32(h2, xb, acc2);
                acc0 = MFMA32(l0, xb, acc0); acc1 = MFMA32(l1, xb, acc1); acc2 = MFMA32(l2, xb, acc2);
                const u32x4 xw = __builtin_bit_cast(u32x4, xb);
                const float t0 = bflo(xw.x), t1 = bfhi(xw.x), t2 = bflo(xw.y), t3 = bfhi(xw.y), t4 = bflo(xw.z), t5 = bfhi(xw.z), t6 = bflo(xw.w), t7 = bfhi(xw.w);
                ss += (t0 * t0 + t1 * t1) + (t2 * t2 + t3 * t3) + (t4 * t4 + t5 * t5) + (t6 * t6 + t7 * t7);
            }
            ss += __shfl_xor(ss, 32);
            const float r = rsqrtf(ss * (1.0f / D) + EPS);
#pragma unroll
            for (int i = 0; i < 16; ++i) { LG[r32 * 100 + crow(i, h)] = acc0[i] * r; LG[r32 * 100 + 32 + crow(i, h)] = acc1[i] * r; LG[r32 * 100 + 64 + crow(i, h)] = acc2[i] * r; }
            LDS_WAIT(); asm volatile("" ::: "memory");
            if (lane < 32) {
                const LAS float* lg = LG + lane * 100;
                float a[8]; int gsel = 0; float gmax = -3.0e38f;
#pragma unroll
                for (int e = 0; e < 8; ++e) { a[e] = lg[e] + brg[e]; if (a[e] > gmax) { gmax = a[e]; gsel = e; } }
                float gden = 0.f;
#pragma unroll
                for (int e = 0; e < 8; ++e) gden += __expf(a[e] - gmax);
                const float pg = 1.0f / gden;
                int i1 = 0; float v1 = -3.0e38f;
#pragma unroll
                for (int e = 0; e < 8; ++e) { a[e] = lg[8 + gsel * 8 + e] + bre[gsel * 8 + e]; if (a[e] > v1) { v1 = a[e]; i1 = e; } }
                int i2 = 0; float v2 = -3.0e38f;
#pragma unroll
                for (int e = 0; e < 8; ++e) { if (e != i1 && a[e] > v2) { v2 = a[e]; i2 = e; } }
                const float e2 = __expf(v2 - v1), p1 = 1.0f / (1.0f + e2), p2 = e2 * p1;
                const int row = tok0 + lane, ea = gsel * 8 + i1, eb = gsel * 8 + i2;
                EID[row * 2] = ea; EID[row * 2 + 1] = eb; GWT[row * 2] = pg * p1; GWT[row * 2 + 1] = pg * p2; R2[row] = r;
                atomicAdd(&cnt[ea], 1u); atomicAdd(&cnt[eb], 1u);
            }
            LDS_WAIT(); asm volatile("" ::: "memory");
        }
    } else {
        LAS unsigned* scr = (LAS unsigned*)(F.lds + (F.wave - 2) * 8192);
        constexpr int I_G = (NE - GU_EARLY) * 32 * 8;
        for (int it = F.vcu * 6 + (F.wave - 2); it < 2 * I_G; it += F.G * 6) {
            int r_ = it; const int up = r_ >= I_G; if (up) r_ -= I_G; const int e = GU_EARLY + (r_ >> 8), rem = r_ & 255;
            const float* W = (up ? A->in[15] : A->in[14]) + (size_t)e * D * FF; bf16_t* WT = wgu_ptr(A->ws, e);
            if (up) cvt_item<2>(W, FF, D, WT, A->in[9], scr, rem >> 3, rem & 7, lane); else cvt_item<1>(W, FF, D, WT, A->in[9], scr, rem >> 3, rem & 7, lane);
        }
    }
    __syncthreads();
}

DI int moe_tables(Frame& F, ArgsP A, LAS int* rbe, LAS int* bstart) {
    const int ftid = opaque_tid();
    const unsigned* cnt = (const unsigned*)(A->ws + WS_CTL) + CW_CNT;
    __syncthreads();
    if (ftid == 0) {
        int acc = 0;
        for (int e = 0; e < NE; ++e) { const int c = (int)__hip_atomic_load(cnt + e, __ATOMIC_RELAXED, __HIP_MEMORY_SCOPE_AGENT); const int nb = (c + 255) >> 8; bstart[e] = acc; for (int k = 0; k < nb; ++k) rbe[acc + k] = e; acc += nb; }
        bstart[NE] = acc;
    }
    __syncthreads();
    return bstart[NE];
}

template <int DUP>
DI void p8_scatter(Frame& F, ArgsP A) {
    const int ftid = opaque_tid(), flane = ftid & 63;
    LAS int* rbe = (LAS int*)(F.lds + LDSCTL_OFF); LAS int* bstart = (LAS int*)(F.lds);
    (void)moe_tables(F, A, rbe, bstart);
    const int* EID = (const int*)(A->ws + WS_EID); const float* GWT = (const float*)(A->ws + WS_GWT); const float* R2 = (const float*)(A->ws + WS_R2);
    const size_t dofs = DUP ? (WS_YCAT - WS_EID) : 0;
    unsigned* fill = (unsigned*)(A->ws + WS_CTL) + CW_FILL + (DUP ? 128 : 0);
    int* rowtok = (int*)(A->ws + WS_ROWTOK + dofs); int* rowdst = (int*)(A->ws + WS_ROWDST + dofs); float* roww = (float*)(A->ws + WS_ROWW + dofs); float* rowr2 = (float*)(A->ws + WS_ROWR2 + dofs);
    for (int a = F.vcu * NTHREADS + ftid; a < 2 * T; a += F.G * NTHREADS) {
        const int e = EID[a]; const unsigned k = atomicAdd(&fill[e], 1u); const int p = bstart[e] * 256 + (int)k;
        rowtok[p] = a >> 1; rowdst[p] = a; roww[p] = GWT[a]; rowr2[p] = R2[a >> 1];
    }
    __syncthreads();
}

DI void p9_tail_convert(Frame& F, ArgsP A, int nunits) {
    const int ftid = opaque_tid(), flane = ftid & 63;
    LAS unsigned* scr = (LAS unsigned*)(F.lds + F.wave * 8192);
    constexpr int NIT = (NE - WD_EARLY) * 256, QUOTA = 96;
    const int r = nunits % F.G, nidle = (r == 0) ? 0 : F.G - r;
    const int n_early = (nidle * QUOTA < NIT) ? nidle * QUOTA : NIT;
    if (r != 0 && F.vcu >= r) {
        const int rank = F.vcu - r, lo = rank * QUOTA, hi = (lo + QUOTA < n_early) ? lo + QUOTA : n_early;
        for (int it = lo + F.wave; it < hi; it += NWAVES) { const int e = WD_EARLY + (it >> 8), rem = it & 255;
            cvt_item<0>(A->in[16] + (size_t)e * FF * D, D, FF, (bf16_t*)(A->ws + WS_WD) + (size_t)e * D * FF, nullptr, scr, rem >> 5, rem & 31, flane); }
    }
    for (int it = n_early + F.vcu * NWAVES + F.wave; it < NIT; it += F.G * NWAVES) { const int e = WD_EARLY + (it >> 8), rem = it & 255;
        cvt_item<0>(A->in[16] + (size_t)e * FF * D, D, FF, (bf16_t*)(A->ws + WS_WD) + (size_t)e * D * FF, nullptr, scr, rem >> 5, rem & 31, flane); }
}
struct EpiGU {
    static constexpr bool PERM = true; static constexpr int MID_T = -1;
    const float* rowr2; bf16_t* U;
    DI void operator()(const f32x4 (&acc)[2][2][4][2], const pg8::Unit& u, int wr, int wc, int fr, int fq) const {
        const int row0 = u.pm * 256 + wr * 64 + fr, pnr = u.pn & 3;
#pragma unroll
        for (int ai = 0; ai < 2; ++ai)
#pragma unroll
            for (int m = 0; m < 4; ++m) {
                const int p = row0 + ai * 128 + m * 16; const float r = rowr2[p];
#pragma unroll
                for (int bj = 0; bj < 2; ++bj) {
                    const int f0 = 128 * pnr + 64 * bj + 16 * wc + 4 * fq;
                    float o[4];
#pragma unroll
                    for (int e = 0; e < 4; ++e) { const float g = acc[ai][bj][m][0][e] * r, up = acc[ai][bj][m][1][e] * r; o[e] = g * sigmoidf_(g) * up; }
                    u32x2 w; w.x = pg8::cvt_pk_bf16(o[0], o[1]); w.y = pg8::cvt_pk_bf16(o[2], o[3]);
                    *(u32x2*)(U + (size_t)p * FF + f0) = w;
                }
            }
    }
};
struct EpiDown {
    static constexpr bool PERM = true; static constexpr int MID_T = -1;
    const int* rowdst; const float* roww; bf16_t* YK;
    DI void operator()(const f32x4 (&acc)[2][2][4][2], const pg8::Unit& u, int wr, int wc, int fr, int fq) const {
        const int row0 = u.pm * 256 + wr * 64 + fr, col0 = (u.pn & 7) * 256 + wc * 32 + 8 * fq;
#pragma unroll
        for (int ai = 0; ai < 2; ++ai)
#pragma unroll
            for (int m = 0; m < 4; ++m) {
                const int p = row0 + ai * 128 + m * 16; const int dst = rowdst[p]; const float w = roww[p];
                if (dst >= 0) {
#pragma unroll
                    for (int bj = 0; bj < 2; ++bj) {
                        const f32x4 a0 = acc[ai][bj][m][0] * w, a1 = acc[ai][bj][m][1] * w;
                        u32x4 o; o.x = pg8::cvt_pk_bf16(a0[0], a0[1]); o.y = pg8::cvt_pk_bf16(a0[2], a0[3]); o.z = pg8::cvt_pk_bf16(a1[0], a1[1]); o.w = pg8::cvt_pk_bf16(a1[2], a1[3]);
                        *(u32x4*)(YK + (size_t)dst * D + col0 + bj * 128) = o;
                    }
                }
            }
    }
};

DI void p11_load(const bf16_t* X1B, const bf16_t* YK, int row, int lane, float (&v)[32]) {
#pragma unroll
    for (int j = 0; j < 4; ++j) {
        const int c0 = 512 * j + 8 * lane;
        const u32x4 xw = *(const u32x4*)(X1B + (size_t)row * D + c0);
        const f32x4 a0 = {bflo(xw.x), bfhi(xw.x), bflo(xw.y), bfhi(xw.y)}, a1 = {bflo(xw.z), bfhi(xw.z), bflo(xw.w), bfhi(xw.w)};
        const u32x4 y0 = *(const u32x4*)(YK + (size_t)(2 * row) * D + c0), y1 = *(const u32x4*)(YK + (size_t)(2 * row + 1) * D + c0);
        v[8 * j + 0] = a0[0] + (bflo(y0.x) + bflo(y1.x)); v[8 * j + 1] = a0[1] + (bfhi(y0.x) + bfhi(y1.x)); v[8 * j + 2] = a0[2] + (bflo(y0.y) + bflo(y1.y)); v[8 * j + 3] = a0[3] + (bfhi(y0.y) + bfhi(y1.y));
        v[8 * j + 4] = a1[0] + (bflo(y0.z) + bflo(y1.z)); v[8 * j + 5] = a1[1] + (bfhi(y0.z) + bfhi(y1.z)); v[8 * j + 6] = a1[2] + (bflo(y0.w) + bflo(y1.w)); v[8 * j + 7] = a1[3] + (bfhi(y0.w) + bfhi(y1.w));
    }
}
DI void p11_store(float* out, const float* gf, int row, int lane, const float (&v)[32]) {
    float ss = 0.f;
#pragma unroll
    for (int e = 0; e < 32; ++e) ss += v[e] * v[e];
    const float r = rsqrtf(wave_sum(ss) * (1.0f / D) + EPS);
#pragma unroll
    for (int j = 0; j < 4; ++j) {
        const int c0 = 512 * j + 8 * lane;
        const f32x4 g0 = *(const f32x4*)(gf + c0), g1 = *(const f32x4*)(gf + c0 + 4);
        *(f32x4*)(out + (size_t)row * D + c0) = (f32x4){v[8 * j] * r * g0[0], v[8 * j + 1] * r * g0[1], v[8 * j + 2] * r * g0[2], v[8 * j + 3] * r * g0[3]};
        *(f32x4*)(out + (size_t)row * D + c0 + 4) = (f32x4){v[8 * j + 4] * r * g1[0], v[8 * j + 5] * r * g1[1], v[8 * j + 6] * r * g1[2], v[8 * j + 7] * r * g1[3]};
    }
}
DI void p11_final(Frame& F, ArgsP A) {
    const int ftid = opaque_tid(), flane = ftid & 63;
    const bf16_t* X1 = (const bf16_t*)(A->ws + WS_X1B); const bf16_t* YK = (const bf16_t*)(A->ws + WS_YK); const float* gf = A->in[17];
    const int gw = F.vcu * NWAVES + F.wave, NGW = F.G * NWAVES, lane = flane;
    for (int row = gw; row < T; row += 2 * NGW) {
        float va[32], vb[32];
        const int row2 = row + NGW; const bool has2 = row2 < T;
        p11_load(X1, YK, row, lane, va);
        if (has2) p11_load(X1, YK, row2, lane, vb);
        p11_store(A->out, gf, row, lane, va);
        if (has2) p11_store(A->out, gf, row2, lane, vb);
    }
}

constexpr int N_PHASES = 12;
__global__ void __launch_bounds__(NTHREADS, 2) fwd(Args args) {
    extern __shared__ __attribute__((aligned(16))) unsigned char lds_raw[];
    Frame F;
    F.lds = (LAS unsigned char*)lds_raw;
    F.wave = __builtin_amdgcn_readfirstlane(threadIdx.x >> 6);
    F.G = gridDim.x; { const int bx = blockIdx.x; F.vcu = (F.G % 8 == 0) ? (bx % 8) * (F.G / 8) + bx / 8 : bx; }
    volatile LAS unsigned* MISC = (volatile LAS unsigned*)(F.lds + MISC_OFF);
    for (int u = threadIdx.x; u < (LDS_BYTES - LDSCTL_OFF) / 4; u += NTHREADS) ((LAS unsigned*)(F.lds + LDSCTL_OFF))[u] = 0u;
    __syncthreads();
    const bool one_launch = (MK_N_LAUNCHES == 1);
    if (one_launch) (void)xcd_barrier_post((unsigned*)(ka_ptr()->ws + WS_CTL) + CW_BAR, MISC + 8);
#define GRID_BAR() do { if (one_launch) { XcdBarrier b_; unsigned char* w_ = ka_ptr()->ws; asm volatile("" : "+s"(w_)); b_.bar = (unsigned*)(w_ + WS_CTL) + CW_BAR; b_.x = xb_xcc_id(); b_.st = (volatile LAS unsigned*)(F.lds + MISC_OFF) + 8; xcd_barrier(b_); } } while (0)
    const int lo = ka_ptr()->ph_lo, hi = ka_ptr()->ph_hi;
#ifndef PHASE_MASK
#define PHASE_MASK 0xFFF
#endif
#define IN(k) (((PHASE_MASK >> (k)) & 1) && lo <= (k) && (k) < hi)
#define BOTH(k) (IN(k) && IN((k) + 1))
#ifndef REPEAT_MASK
#define REPEAT_MASK 0
#endif
#define RUN(k, ...) do { __VA_ARGS__; if constexpr (((REPEAT_MASK >> (k)) & 1) != 0) { __syncthreads(); __VA_ARGS__; } } while (0)

    if (IN(0)) { RUN(0, p0_prologue(F, ka_ptr())); if (BOTH(0)) GRID_BAR(); }
    if (IN(1)) {
        pg8::Gemm g{(const bf16_t*)(ka_ptr()->ws + WS_H), (const bf16_t*)(ka_ptr()->ws + WS_WIN), D, nullptr}; pg8::StaticOrder S; S.init(T, INW, F.G, (int)blockIdx.x);
        EpiProj E{ka_ptr()->ws, ka_ptr()->in[3]};
#ifdef P1_STAGGER_TICKS
        if ((blockIdx.x & 1) != 0) { const unsigned long long t0 = __builtin_amdgcn_s_memrealtime(); while (__builtin_amdgcn_s_memrealtime() - t0 < (unsigned long long)(P1_STAGGER_TICKS)) __builtin_amdgcn_s_sleep(16); }
#endif
        RUN(1, pg8::gemm_phase<EpiProj, pg8::StaticOrder, true, true, false>(F.lds, g, S, E));
        __syncthreads();
        if (F.G == 256) { if (blockIdx.x >= 128) p1_tail_convert(F, ka_ptr(), (int)blockIdx.x - 128, 128); }
        else p1_tail_convert(F, ka_ptr(), (int)blockIdx.x, F.G);
#ifdef PROBE_NOSTORE_EPI
        { __syncthreads(); EpiProjT<1> EQ{ka_ptr()->ws, ka_ptr()->in[3]}; pg8::gemm_phase<EpiProjT<1>, pg8::StaticOrder, true, true, false>(F.lds, g, S, EQ); }
#endif
#ifdef PROBE_PLAIN_EPI
        { __syncthreads(); EpiPlainScratch EP{(bf16_t*)(ka_ptr()->ws + WS_YCAT)}; pg8::gemm_phase<EpiPlainScratch, pg8::StaticOrder, true, true, false>(F.lds, g, S, EP); }
#endif
#ifdef PROBE_NULL_EPI
        { __syncthreads(); EpiNull EN; pg8::gemm_phase<EpiNull, pg8::StaticOrder, true, true, false>(F.lds, g, S, EN); }
#endif
        if (BOTH(1)) GRID_BAR();
    }
    if (IN(2)) { RUN(2, p2_hgrn_mfma<0>(F, ka_ptr()));
#ifdef PROBE_P2
        __syncthreads(); p2_hgrn_mfma<PROBE_P2>(F, ka_ptr());
#endif
    }
    if (IN(3)) { RUN(3, p3_attn_mfma(F, ka_ptr())); if (BOTH(3)) GRID_BAR(); }
    if (IN(4)) { RUN(4, p4_fixups(F, ka_ptr())); if (BOTH(4)) GRID_BAR();
#ifdef PROBE_BAR
        GRID_BAR(); GRID_BAR(); GRID_BAR(); GRID_BAR();
#endif
    }
    if (IN(5)) {
        pg8::Gemm g{(const bf16_t*)(ka_ptr()->ws + WS_YCAT), (const bf16_t*)(ka_ptr()->ws + WS_WCAT), KCAT, nullptr}; pg8::StaticOrder S; S.init(T, D, F.G, (int)blockIdx.x);
        EpiGateCat E{(const bf16_t*)(ka_ptr()->ws + WS_GA), (const bf16_t*)(ka_ptr()->ws + WS_GB), (bf16_t*)(ka_ptr()->ws + WS_MERGED)};
        RUN(5, pg8::gemm_phase<EpiGateCat, pg8::StaticOrder, true, true, false>(F.lds, g, S, E));
        if (BOTH(5)) GRID_BAR();
    }
    if (IN(6)) {
        pg8::Gemm g{(const bf16_t*)(ka_ptr()->ws + WS_MERGED), (const bf16_t*)(ka_ptr()->ws + WS_WOUT), D, nullptr}; pg8::StaticOrder S; S.init(T, D, F.G, (int)blockIdx.x);
        EpiOut E{ka_ptr()->in[0], (float*)(ka_ptr()->ws + WS_X1), (bf16_t*)(ka_ptr()->ws + WS_X1B)};
        RUN(6, pg8::gemm_phase<EpiOut, pg8::StaticOrder, true, true, false>(F.lds, g, S, E));
        if (BOTH(6)) GRID_BAR();
    }
    if (IN(7)) {
#ifdef P7_SEQUENTIAL
        p7_router<0>(F, ka_ptr()); RUN(7, p7_convert(F, ka_ptr()));
#else
        p7_roles(F, ka_ptr());
#endif
        if (BOTH(7)) GRID_BAR(); }
    if (IN(8)) { p8_scatter<0>(F, ka_ptr());
#ifdef PROBE_SCATTER
        __syncthreads(); p8_scatter<1>(F, ka_ptr());
#endif
        if (BOTH(8)) GRID_BAR(); }
    if (IN(9)) {
        LAS int* rbe = (LAS int*)(F.lds + LDSCTL_OFF); LAS int* bstart = (LAS int*)(F.lds + LDSCTL_OFF + 768 + 256 + 64);
        const int nrb = moe_tables(F, ka_ptr(), rbe, bstart);
        pg8::Gemm g{(const bf16_t*)(ka_ptr()->ws + WS_X1B), (const bf16_t*)(ka_ptr()->ws + WS_WGU), D, (const int*)(ka_ptr()->ws + WS_ROWTOK)};
        pg8::MoeOrder S{rbe, nrb, 4, F.G, F.vcu, GU_EARLY, (int)((WS_WGU_E - WS_WGU) / MiB)};
        EpiGU E{(const float*)(ka_ptr()->ws + WS_ROWR2), (bf16_t*)(ka_ptr()->ws + WS_U)};
        RUN(9, pg8::gemm_phase<EpiGU, pg8::MoeOrder, true, true, true>(F.lds, g, S, E));
        __syncthreads();
        p9_tail_convert(F, ka_ptr(), nrb * 4);
        if (BOTH(9)) GRID_BAR();
    }
    if (IN(10)) {
        LAS int* rbe = (LAS int*)(F.lds + LDSCTL_OFF); LAS int* bstart = (LAS int*)(F.lds + LDSCTL_OFF + 768 + 256 + 64);
        const int nrb = moe_tables(F, ka_ptr(), rbe, bstart);
        pg8::Gemm g{(const bf16_t*)(ka_ptr()->ws + WS_U), (const bf16_t*)(ka_ptr()->ws + WS_WD), FF, nullptr};
        pg8::MoeOrder S{rbe, nrb, 8, F.G, F.vcu, 0, 0};
        EpiDown E{(const int*)(ka_ptr()->ws + WS_ROWDST), (const float*)(ka_ptr()->ws + WS_ROWW), (bf16_t*)(ka_ptr()->ws + WS_YK)};
        RUN(10, pg8::gemm_phase<EpiDown, pg8::MoeOrder, true, true, false>(F.lds, g, S, E));
        if (BOTH(10)) GRID_BAR();
    }
    if (IN(11)) { RUN(11, p11_final(F, ka_ptr())); }
#undef IN
#undef BOTH
}

extern "C" void kernel_launch(void* const* d_in, const int* in_sizes, int n_in, void* d_out, int out_size, void* d_ws, size_t ws_size, hipStream_t stream) {
    static int grid = 0;
    if (grid == 0) {
        if (n_in != 18 || in_sizes[0] != T * D || out_size != T * D || ws_size < WS_END) { fprintf(stderr, "kernel_launch: unexpected shapes: n_in %d in0 %d out %d ws %zu (need %zu)\n", n_in, n_in > 0 ? in_sizes[0] : -1, out_size, ws_size, (size_t)WS_END); grid = -1; return; }
        int dev = 0, cus = 0, per_cu = 0;
        if (hipGetDevice(&dev) != hipSuccess || hipDeviceGetAttribute(&cus, hipDeviceAttributeMultiprocessorCount, dev) != hipSuccess) { grid = -1; return; }
        if (hipFuncSetAttribute((const void*)fwd, hipFuncAttributeMaxDynamicSharedMemorySize, LDS_BYTES) != hipSuccess) { fprintf(stderr, "kernel_launch: hipFuncSetAttribute failed\n"); grid = -1; return; }
        if (hipOccupancyMaxActiveBlocksPerMultiprocessor(&per_cu, (const void*)fwd, NTHREADS, LDS_BYTES) != hipSuccess || per_cu < 1) fprintf(stderr, "kernel_launch: occupancy query reports %d\n", per_cu);
        (void)hipGetLastError();
        grid = cus;
        fprintf(stderr, "kernel_launch: grid %d, occupancy query %d, ws %zu\n", grid, per_cu, ws_size);
    }
    if (grid < 0) return;
    if (hipMemsetAsync((char*)d_ws + WS_CTL, 0, CTL_ZERO_BYTES, stream) != hipSuccess) return;
    Args a{};
    for (int i = 0; i < 18; ++i) a.in[i] = (const float*)d_in[i];
    a.out = (float*)d_out; a.ws = (unsigned char*)d_ws;
    const int nl = MK_N_LAUNCHES;
    for (int li = 0; li < nl; ++li) {
        a.ph_lo = (nl == 1) ? 0 : li; a.ph_hi = (nl == 1) ? N_PHASES : li + 1; a.li = li; a.pad = 0;
        hipLaunchKernelGGL(fwd, dim3(grid), dim3(NTHREADS), LDS_BYTES, stream, a);
        const hipError_t le = hipPeekAtLastError();
        if (le != hipSuccess) { fprintf(stderr, "kernel_launch: launch %d failed: %s\n", li, hipGetErrorName(le)); break; }
    }
}
```
